# Optimizing an MI355X kernel written in HIP

```python
import math
import jax, jax.numpy as jnp
from jax import lax
import numpy as np

D_MODEL = 2048
BATCH = 2
SEQ = 8192
DEPTH = 1

HEAD_DIM = 64
SWA_Q_HEADS = 16
SWA_KV_HEADS = 4
SWA_WINDOW = 128
SWA_WIDTH = SWA_Q_HEADS * HEAD_DIM
SWA_KV_WIDTH = SWA_KV_HEADS * HEAD_DIM
DIFF_HEADS = 8
DIFF_WIDTH = DIFF_HEADS * 2 * HEAD_DIM
N_BRANCH = 2
BRANCH_WIDTH = 1024
IN_SPLIT_SIZES = [SWA_WIDTH, SWA_KV_WIDTH, SWA_KV_WIDTH, DIFF_WIDTH, DIFF_WIDTH, DIFF_WIDTH, N_BRANCH * D_MODEL]
IN_WIDTH = int(sum(IN_SPLIT_SIZES))
IN_SPLIT_IDX = [int(v) for v in np.cumsum(IN_SPLIT_SIZES)[:-1]]
MEM_LEN = 256
X_HEADS = 4
X_HEAD_DIM = 128
X_WIDTH = X_HEADS * X_HEAD_DIM
N_EXPERTS = 32
TOP_K = 4
D_FF = 2048
SWIGLU_LIMIT = 7.0
SWIGLU_ALPHA = 1.702
BLOCK = 128
RMS_EPS = 1e-5

kernel_name = "hybrid_swa_sink_diffattn_alibi_memxattn_moe"


def rms_norm(x, g):
    xf = x.astype(jnp.float32)
    y = xf * lax.rsqrt(jnp.mean(xf * xf, axis=-1, keepdims=True) + RMS_EPS)
    return (y * g.astype(jnp.float32)).astype(x.dtype)


def alibi_slopes(n_heads):
    return 2.0 ** (-8.0 * jnp.arange(1, n_heads + 1, dtype=jnp.float32) / n_heads)


def lambda_init_fn(layer_idx):
    return 0.8 - 0.6 * math.exp(-0.3 * layer_idx)


def sliding_window_attention(q, k, v, sinks):
    B, S, Hq, d = q.shape
    Hkv = k.shape[2]
    G = Hq // Hkv
    nb = S // BLOCK
    qb = q.reshape(B, nb, BLOCK, Hkv, G, d)

    def band(t):
        tb = t.reshape(B, nb, BLOCK, Hkv, d)
        prev = jnp.pad(tb, ((0, 0), (1, 0), (0, 0), (0, 0), (0, 0)))[:, :-1]
        return jnp.concatenate([prev, tb], axis=2)

    kb, vb = band(k), band(v)
    scores = jnp.einsum('bnqhgd,bnkhd->bnhgqk', qb, kb).astype(jnp.float32) * (d ** -0.5)
    q_pos = jnp.arange(BLOCK)[:, None] + BLOCK
    k_pos = jnp.arange(2 * BLOCK)[None, :]
    dist = q_pos - k_pos
    allowed = (dist >= 0) & (dist < SWA_WINDOW)
    blk = jnp.arange(nb)[:, None, None]
    valid = allowed[None] & ((k_pos[None] >= BLOCK) | (blk > 0))
    slopes = alibi_slopes(Hq).reshape(Hkv, G)
    bias = -slopes[:, :, None, None] * dist.astype(jnp.float32)[None, None]
    scores = jnp.where(valid[None, :, None, None], scores + bias[None, None], -jnp.inf)
    sink = sinks.astype(jnp.float32).reshape(1, 1, Hkv, G, 1, 1)
    m = jnp.maximum(jnp.max(scores, axis=-1, keepdims=True), sink)
    p = jnp.exp(scores - m)
    p = p / (jnp.sum(p, axis=-1, keepdims=True) + jnp.exp(sink - m))
    out = jnp.einsum('bnhgqk,bnkhd->bnqhgd', p.astype(v.dtype), vb)
    return out.reshape(B, S, Hq * d)


def differential_attention(q, k, v, lam, subln_g, lam_init):
    B, S, H, _, d = q.shape
    nb = S // BLOCK
    slopes = alibi_slopes(H)
    k_pos = jnp.arange(S)

    def query_block(i):
        q_blk = lax.dynamic_slice_in_dim(q, i * BLOCK, BLOCK, axis=1)
        s = jnp.einsum('bqhcd,bkhcd->bhcqk', q_blk, k).astype(jnp.float32) * (d ** -0.5)
        q_pos = i * BLOCK + jnp.arange(BLOCK)
        dist = q_pos[:, None] - k_pos[None, :]
        bias = -slopes[:, None, None, None] * dist.astype(jnp.float32)[None, None]
        s = jnp.where(dist >= 0, s + bias, -jnp.inf)
        a = jax.nn.softmax(s, axis=-1)
        a = a[:, :, 0] - lam * a[:, :, 1]
        return jnp.einsum('bhqk,bkhe->bqhe', a.astype(v.dtype), v)

    out = lax.map(query_block, jnp.arange(nb))
    out = jnp.moveaxis(out, 0, 1).reshape(B, S, H, 2 * d)
    out = rms_norm(out, subln_g) * (1.0 - lam_init)
    return out.reshape(B, S, H * 2 * d)


def memory_cross_attention(hn, mem_n, w_cq, w_ckv, w_co):
    B, S, _ = hn.shape
    M = mem_n.shape[1]
    q = (hn @ w_cq).reshape(B, S, X_HEADS, X_HEAD_DIM)
    k, v = jnp.split(mem_n @ w_ckv, 2, axis=-1)
    k = k.reshape(B, M, X_HEADS, X_HEAD_DIM)
    v = v.reshape(B, M, X_HEADS, X_HEAD_DIM)
    s = jnp.einsum('bqhd,bkhd->bhqk', q, k).astype(jnp.float32) * (X_HEAD_DIM ** -0.5)
    p = jax.nn.softmax(s, axis=-1)
    o = jnp.einsum('bhqk,bkhd->bqhd', p.astype(v.dtype), v).reshape(B, S, X_WIDTH)
    return o @ w_co


def moe_ffn(xn, w_router, b_router, w_gate_up, b_gate_up, w_down, b_down):
    B, S, D = xn.shape
    T = B * S
    xt = xn.reshape(T, D)
    logits = (xt @ w_router + b_router).astype(jnp.float32)
    top_val, top_idx = lax.top_k(logits, TOP_K)
    gates = jax.nn.softmax(top_val, axis=-1)
    flat_e = top_idx.reshape(-1)
    flat_tok = jnp.arange(T * TOP_K, dtype=jnp.int32) // TOP_K
    flat_w = gates.reshape(-1)
    order = jnp.argsort(flat_e)
    sorted_e = flat_e[order]
    counts = jnp.bincount(flat_e, length=N_EXPERTS)
    padded = (counts + BLOCK - 1) // BLOCK * BLOCK
    start = jnp.cumsum(counts) - counts
    pstart = jnp.cumsum(padded) - padded
    dest = pstart[sorted_e] + (jnp.arange(T * TOP_K) - start[sorted_e])
    n_rows = T * TOP_K + N_EXPERTS * BLOCK
    n_blocks = n_rows // BLOCK
    row_tok = jnp.zeros((n_rows,), jnp.int32).at[dest].set(flat_tok[order])
    row_w = jnp.zeros((n_rows,), jnp.float32).at[dest].set(flat_w[order])
    block_e = jnp.minimum(
        jnp.searchsorted(jnp.cumsum(padded), jnp.arange(n_blocks) * BLOCK, side='right'),
        N_EXPERTS - 1)

    def expert_block(args):
        e, toks = args
        xb = xt[toks]
        hgu = xb @ w_gate_up[e] + b_gate_up[e]
        glu, lin = jnp.split(hgu, 2, axis=-1)
        glu = jnp.minimum(glu, SWIGLU_LIMIT)
        lin = jnp.clip(lin, -SWIGLU_LIMIT, SWIGLU_LIMIT)
        act = glu * jax.nn.sigmoid(SWIGLU_ALPHA * glu) * (lin + 1.0)
        return act @ w_down[e] + b_down[e]

    out = lax.map(expert_block, (block_e, row_tok.reshape(n_blocks, BLOCK)))
    out = out.reshape(n_rows, D) * row_w[:, None].astype(out.dtype)
    y = jnp.zeros((T, D), out.dtype).at[row_tok].add(out)
    return y.reshape(B, S, D)


def setup_inputs(seed: int = 0) -> dict:
    key = jax.random.key(seed)
    ks = jax.random.split(key, 32)
    L, D = DEPTH, D_MODEL

    def nrm(k, shape, scale):
        return jax.random.normal(k, shape, jnp.float32) * scale

    def gain(k, shape):
        return 1.0 + nrm(k, shape, 0.02)

    return {
        "x": nrm(ks[0], (BATCH, SEQ, D), 1.0),
        "mem": nrm(ks[1], (BATCH, MEM_LEN, D), 1.0),
        "norm_mix_g": gain(ks[2], (L, D)),
        "w_in": nrm(ks[3], (L, D, IN_WIDTH), D ** -0.5),
        "sinks": nrm(ks[4], (L, SWA_Q_HEADS), 0.5),
        "lambda_q1": nrm(ks[5], (L, HEAD_DIM), 0.1),
        "lambda_k1": nrm(ks[6], (L, HEAD_DIM), 0.1),
        "lambda_q2": nrm(ks[7], (L, HEAD_DIM), 0.1),
        "lambda_k2": nrm(ks[8], (L, HEAD_DIM), 0.1),
        "diff_subln_g": gain(ks[9], (L, 2 * HEAD_DIM)),
        "w_branch": nrm(ks[10], (L, N_BRANCH, BRANCH_WIDTH, D), BRANCH_WIDTH ** -0.5),
        "w_o": nrm(ks[11], (L, D, D), D ** -0.5),
        "norm_cross_g": gain(ks[12], (L, D)),
        "norm_mem_g": gain(ks[13], (L, D)),
        "w_cq": nrm(ks[14], (L, D, X_WIDTH), D ** -0.5),
        "w_ckv": nrm(ks[15], (L, D, 2 * X_WIDTH), D ** -0.5),
        "w_co": nrm(ks[16], (L, X_WIDTH, D), X_WIDTH ** -0.5),
        "norm_ffn_g": gain(ks[17], (L, D)),
        "w_router": nrm(ks[18], (L, D, N_EXPERTS), D ** -0.5),
        "b_router": nrm(ks[19], (L, N_EXPERTS), 0.01),
        "w_gate_up": nrm(ks[20], (L, N_EXPERTS, D, 2 * D_FF), D ** -0.5),
        "b_gate_up": nrm(ks[21], (L, N_EXPERTS, 2 * D_FF), 0.01),
        "w_down": nrm(ks[22], (L, N_EXPERTS, D_FF, D), D_FF ** -0.5),
        "b_down": nrm(ks[23], (L, N_EXPERTS, D), 0.01),
        "norm_final_g": gain(ks[24], (D,)),
    }


def reference(x, mem, norm_mix_g, w_in, sinks, lambda_q1, lambda_k1, lambda_q2, lambda_k2,
              diff_subln_g, w_branch, w_o, norm_cross_g, norm_mem_g, w_cq, w_ckv, w_co,
              norm_ffn_g, w_router, b_router, w_gate_up, b_gate_up, w_down, b_down, norm_final_g):
    B, S, D = x.shape
    h = x
    for l in range(DEPTH):
        xn = rms_norm(h, norm_mix_g[l])
        proj = xn @ w_in[l]
        qa, ka, va, qd, kd, vd, g = jnp.split(proj, IN_SPLIT_IDX, axis=-1)
        ya = sliding_window_attention(
            qa.reshape(B, S, SWA_Q_HEADS, HEAD_DIM),
            ka.reshape(B, S, SWA_KV_HEADS, HEAD_DIM),
            va.reshape(B, S, SWA_KV_HEADS, HEAD_DIM),
            sinks[l])
        lam_init = lambda_init_fn(l)
        lam = (jnp.exp(jnp.sum(lambda_q1[l].astype(jnp.float32) * lambda_k1[l].astype(jnp.float32)))
               - jnp.exp(jnp.sum(lambda_q2[l].astype(jnp.float32) * lambda_k2[l].astype(jnp.float32)))
               + lam_init)
        yd = differential_attention(
            qd.reshape(B, S, DIFF_HEADS, 2, HEAD_DIM),
            kd.reshape(B, S, DIFF_HEADS, 2, HEAD_DIM),
            vd.reshape(B, S, DIFF_HEADS, 2 * HEAD_DIM),
            lam, diff_subln_g[l], lam_init)
        branch_gates = jax.nn.sigmoid(g.reshape(B, S, N_BRANCH, D))
        branches = jnp.stack([ya, yd], axis=2)
        up = jnp.einsum('bsnw,nwd->bsnd', branches, w_branch[l])
        merged = jnp.sum(branch_gates * up, axis=2)
        h = h + merged @ w_o[l]
        h = h + memory_cross_attention(rms_norm(h, norm_cross_g[l]), rms_norm(mem, norm_mem_g[l]),
                                       w_cq[l], w_ckv[l], w_co[l])
        h = h + moe_ffn(rms_norm(h, norm_ffn_g[l]), w_router[l], b_router[l],
                        w_gate_up[l], b_gate_up[l], w_down[l], b_down[l])
    return rms_norm(h, norm_final_g)
```

```cpp
#include <hip/hip_runtime.h>
#include <cstdio>
#include <cstdint>

#define LAS __attribute__((address_space(3)))
#define GAS __attribute__((address_space(1)))
typedef unsigned short bf16_t;
typedef short bf16x8 __attribute__((ext_vector_type(8)));
typedef float f32x4 __attribute__((ext_vector_type(4)));
typedef float f32x2 __attribute__((ext_vector_type(2)));
typedef float f32x16 __attribute__((ext_vector_type(16)));
typedef unsigned u32x4 __attribute__((ext_vector_type(4)));
typedef unsigned u32x2 __attribute__((ext_vector_type(2)));

constexpr int BATCH = 2, SEQ = 8192, T = BATCH * SEQ, DM = 2048;
constexpr int NPROJ = 7424;
constexpr int PC_QA = 0, PC_KA = 1024, PC_QD = 1280, PC_KD = 2304, PC_G = 3328;
constexpr int NVT = 1280;
constexpr int NE = 32, TOPK = 4, DFF = 2048;
constexpr int XROWS = 73728;
constexpr int MAXTILES = XROWS / 256;
constexpr float RMS_EPS = 1e-5f;
constexpr float LOG2E = 1.4426950408889634f;
constexpr float C2_64 = 0.125f * LOG2E;
constexpr float C2_128 = 0.08838834764831845f * LOG2E;

constexpr size_t MiB = 1u << 20;
constexpr size_t WS_CTL = 0, CTL_ZERO_BYTES = 1 * MiB;
constexpr size_t WS_WIN = 2 * MiB;
constexpr size_t WS_WB = WS_WIN + 34 * MiB;
constexpr size_t WS_WO = WS_WB + 8 * MiB;
constexpr size_t WS_WCQ = WS_WO + 8 * MiB;
constexpr size_t WS_WCKV = WS_WCQ + 2 * MiB;
constexpr size_t WS_WCO = WS_WCKV + 4 * MiB;
constexpr size_t WS_WGU = WS_WCO + 2 * MiB;
constexpr size_t WS_WD = WS_WGU + 512 * MiB;
constexpr size_t WS_XN = WS_WD + 256 * MiB;
constexpr size_t WS_PROJ = WS_XN + 64 * MiB;
constexpr size_t WS_VT = WS_PROJ + 232 * MiB;
constexpr size_t WS_YA = WS_VT + 40 * MiB;
constexpr size_t WS_YD = WS_YA + 32 * MiB;
constexpr size_t WS_MERGED = WS_YD + 32 * MiB;
constexpr size_t WS_H = WS_MERGED + 64 * MiB;
constexpr size_t WS_MEMN = WS_H + 128 * MiB;
constexpr size_t WS_KM = WS_MEMN + 2 * MiB;
constexpr size_t WS_VMT = WS_KM + 1 * MiB;
constexpr size_t WS_QC = WS_VMT + 1 * MiB;
constexpr size_t WS_OC = WS_QC + 16 * MiB;
constexpr size_t WS_TOPI = WS_OC + 16 * MiB;
constexpr size_t WS_TOPW = WS_TOPI + 1 * MiB;
constexpr size_t WS_ROWSLOT = WS_TOPW + 1 * MiB;
constexpr size_t WS_ROWW = WS_ROWSLOT + 1 * MiB;
constexpr size_t WS_XG = WS_ROWW + 1 * MiB;
constexpr size_t WS_ACT = WS_XG + 288 * MiB;
constexpr size_t WS_MOEOUT = WS_ACT + 288 * MiB;
constexpr size_t WS_ROWSQP = WS_MOEOUT + 256 * MiB;
constexpr size_t WS_WING8 = WS_ROWSQP + 2 * MiB;
constexpr size_t WS_XN8 = WS_WING8 + 8 * MiB;
constexpr size_t WS_G8 = WS_XN8 + 32 * MiB;
constexpr size_t WS_WRT = WS_G8 + 64 * MiB;
constexpr size_t WS_ROWTOK = WS_WRT + 1 * MiB;
constexpr size_t WS_END = WS_ROWTOK + 1 * MiB;
constexpr int CW_CNT = 64;
constexpr int CW_CUR = 128;
constexpr int CW_QHEAD = 1024;
constexpr int CW_KMAX = 192;
constexpr int CW_KDONE = 448;
constexpr int CW_RSC = 16384;
constexpr int CW_CONV = 1920;
constexpr int CW_DONE = 2048;
constexpr int CW_BAR = 4096;

constexpr int RING_BYTES = 131072;
constexpr int LDS_FLAG_OFF = 131072;
constexpr int LDS_TAB_OFF = 134144;
constexpr int LDS_MISC_OFF = 136192;
constexpr int LDS_BYTES = 147456;
constexpr int NWAVES = 8, NTHR = 512;

__device__ __forceinline__ unsigned f2bf(float f) { unsigned u = __builtin_bit_cast(unsigned, f); return (u + 0x7fffu + ((u >> 16) & 1u)) >> 16; }
__device__ __forceinline__ unsigned pk2(float lo, float hi) { typedef __bf16 bf2 __attribute__((ext_vector_type(2))); f32x2 v = {lo, hi}; bf2 b = __builtin_convertvector(v, bf2); return __builtin_bit_cast(unsigned, b); }
__device__ __forceinline__ float bf_lo(unsigned w) { return __builtin_bit_cast(float, w << 16); }
__device__ __forceinline__ float bf_hi(unsigned w) { return __builtin_bit_cast(float, w & 0xffff0000u); }
__device__ __forceinline__ float wave_sum(float v) {
#pragma unroll
    for (int o = 1; o < 64; o <<= 1) v += __shfl_xor(v, o);
    return v;
}
#define LDS_WAIT() asm volatile("s_waitcnt lgkmcnt(0)" ::: "memory")
#define VM_WAIT() asm volatile("s_waitcnt vmcnt(0)" ::: "memory")
namespace pg8 {
#define PG8_LAS __attribute__((address_space(3)))
constexpr int BM = 256, BK = 64, HALF = 128, HTB = HALF * BK * 2  , STAGE_BYTES = 8 * HTB, NXCD = 8, WGM = 4;

__host__ __device__ __forceinline__ int lds_byte(int r, int c) { const int st = (r >> 4) * 2 + (c >> 5), rr = r & 15, cc = c & 31, ob = rr * 64 + cc * 2; return st * 1024 + (ob ^ (((ob >> 9) & 1) << 5)); }
__host__ __device__ __forceinline__ void stage_rc(int b, int& R, int& C) { const int st = b / 1024, sb = b % 1024, swz = sb ^ (((sb >> 9) & 1) << 5); R = (st >> 1) * 16 + swz / 64; C = (st & 1) * 32 + (swz % 64) / 2; }
__host__ __device__ __forceinline__ int perm32(int rho) { const int n = rho >> 4, i = rho & 15; return 8 * (i >> 2) + 4 * n + (i & 3); }

typedef int v8i_t __attribute__((ext_vector_type(8)));
__device__ __forceinline__ v8i_t cat16(bf16x8 a, bf16x8 b) { typedef int v4i_t __attribute__((ext_vector_type(4))); const v4i_t x = __builtin_bit_cast(v4i_t, a), y = __builtin_bit_cast(v4i_t, b); return (v8i_t){x[0], x[1], x[2], x[3], y[0], y[1], y[2], y[3]}; }
__device__ __forceinline__ void glds16_s(const char* sbase, unsigned voff, unsigned ldsdst) {
    unsigned keep;
    asm volatile("s_mov_b32 %0, m0\n\ts_mov_b32 m0, %3\n\ts_nop 2\n\tglobal_load_lds_dwordx4 %1, %2\n\ts_mov_b32 m0, %0" : "=&s"(keep) : "v"(voff), "s"(sbase), "s"(ldsdst) : "memory");
}
struct Unit { int pm, pn, e; };
struct Gemm { int K; size_t bhstep; };

struct StaticOrder {
    static constexpr bool GATHER = false;
    const bf16_t* A; const bf16_t* Bt; int K;
    int nM, nN, nwg, G, c;
    __device__ void init(const bf16_t* A_, const bf16_t* Bt_, int M, int N, int K_, int G_, int c_) { A = A_; Bt = Bt_; K = K_; nM = M / BM; nN = N / BM; nwg = nM * nN; G = G_; c = c_; }
    __device__ bool next(int i, Unit& u) const {
        const long L = (long)i * G + c; if (L >= nwg) return false;
        int wgid = (int)L; { const int q = nwg / NXCD, r = nwg % NXCD, xcd = wgid % NXCD, off = wgid / NXCD; wgid = (xcd < r ? xcd * (q + 1) : r * (q + 1) + (xcd - r) * q) + off; }
        const int nig = WGM * nN, gid = wgid / nig, fm = gid * WGM, gsz = (nM - fm) < WGM ? (nM - fm) : WGM;
        u.pm = fm + ((wgid % nig) % gsz); u.pn = (wgid % nig) / gsz; u.e = 0; return true;
    }
    __device__ __forceinline__ void ptrs(const Unit& u, const char*& a, const char*& b) const {
        a = (const char*)A + (size_t)u.pm * (size_t)(BM * 2) * K; b = (const char*)Bt + (size_t)u.pn * (size_t)(BM * 2) * K; }
    __device__ __forceinline__ void a_ready(const Unit&) const {}
    __device__ __forceinline__ void done(const Unit&) const {}
};
__device__ __forceinline__ void grid_map(int L, int nM, int nN, int& pm, int& pn) {
    const int nwg = nM * nN; int wgid = L; { const int q = nwg / NXCD, r = nwg % NXCD, xcd = wgid % NXCD, off = wgid / NXCD; wgid = (xcd < r ? xcd * (q + 1) : r * (q + 1) + (xcd - r) * q) + off; }
    const int nig = WGM * nN, gid = wgid / nig, fm = gid * WGM, gsz = (nM - fm) < WGM ? (nM - fm) : WGM;
    pm = fm + ((wgid % nig) % gsz); pn = (wgid % nig) / gsz;
}
struct ProjOrder {
    static constexpr bool GATHER = false;
    const bf16_t* XN; const bf16_t* WIN; const bf16_t* MEMN; const bf16_t* WCKV; int G, c;
    static constexpr int N0 = 64 * 13, N1 = 5 * 64, N2 = 4, N3 = 4, NTOT = N0 + N1 + N2 + N3;
    __device__ bool next(int i, Unit& u) const {
        int L = i * G + c; if (L >= NTOT) return false;
        if (L < N0) { u.e = 0; grid_map(L, 64, 13, u.pm, u.pn); return true; } L -= N0;
        if (L < N1) { u.e = 1; grid_map(L, 5, 64, u.pm, u.pn); return true; } L -= N1;
        if (L < N2) { u.e = 2; u.pm = L >> 1; u.pn = L & 1; return true; } L -= N2;
        u.e = 3; u.pm = L >> 1; u.pn = L & 1; return true;
    }
    __device__ __forceinline__ void ptrs(const Unit& u, const char*& a, const char*& b) const {
        const size_t ts = (size_t)(BM * 2) * 2048;
        const bf16_t* A = u.e == 0 ? XN : (u.e == 1 ? WIN + (size_t)NPROJ * 2048 : (u.e == 2 ? MEMN : WCKV + (size_t)512 * 2048));
        const bf16_t* B = u.e == 0 ? WIN : (u.e == 1 ? XN : (u.e == 2 ? WCKV : MEMN));
        a = (const char*)A + (size_t)u.pm * ts; b = (const char*)B + (size_t)u.pn * ts; }
    __device__ __forceinline__ void a_ready(const Unit&) const {}
    __device__ __forceinline__ void done(const Unit&) const {}
};
struct BranchOrder {
    static constexpr bool GATHER = false;
    const bf16_t* YA; const bf16_t* YD; const bf16_t* WB; int G, c;
    __device__ bool next(int i, Unit& u) const {
        const int L = (i >> 1) * G + c; if (L >= 64 * 8) return false;
        u.e = i & 1; grid_map(L, 64, 8, u.pm, u.pn); return true;
    }
    __device__ __forceinline__ void ptrs(const Unit& u, const char*& a, const char*& b) const {
        const size_t ts = (size_t)(BM * 2) * 1024;
        a = (const char*)(u.e ? YD : YA) + (size_t)u.pm * ts; b = (const char*)(WB + (size_t)u.e * 2048 * 1024) + (size_t)u.pn * ts; }
    __device__ __forceinline__ void a_ready(const Unit&) const {}
    __device__ __forceinline__ void done(const Unit&) const {}
};
template <bool GATHER_>
struct MoeOrder {
    static constexpr bool GATHER = GATHER_;
    const void* A; const void* Bt; const PG8_LAS int* tile_e; int ntiles, nN, G, c; size_t a_tstride, b_estride, b_tstride;
    const unsigned short* rowtok;
    __device__ bool next(int i, Unit& u) const {
        if (G == 256) {
            const int x = c >> 5, w = c & 31, mpr = 256 / nN;
            const int m = (nN == 16) ? 4 * (x >> 1) + (w >> 3) : 4 * x + (w >> 3), n = (nN == 16) ? 8 * (x & 1) + (w & 7) : (w & 7);
            u.pm = i * mpr + m; u.pn = n; if (u.pm >= ntiles) return false;
        } else { const long L = (long)i * G + c; if (L >= (long)ntiles * nN) return false; u.pm = (int)(L / nN); u.pn = (int)(L % nN); }
        u.e = __builtin_amdgcn_readfirstlane(tile_e[u.pm]); return true;
    }
    __device__ __forceinline__ void ptrs(const Unit& u, const char*& a, const char*& b) const {
        a = GATHER_ ? (const char*)A : (const char*)A + (size_t)u.pm * a_tstride; b = (const char*)Bt + (size_t)u.e * b_estride + (size_t)u.pn * b_tstride; }
    __device__ __forceinline__ const unsigned short* rows(const Unit& u) const { return rowtok + u.pm * 256; }
    __device__ __forceinline__ void a_ready(const Unit&) const {}
    __device__ __forceinline__ void done(const Unit&) const {}
};

#define EPI_ROWS_BEGIN const int row0 = u.pm * BM + wr * 64 + fr; \
    _Pragma("unroll") for (int ai = 0; ai < 2; ++ai) _Pragma("unroll") for (int m = 0; m < 4; ++m) { const int row = row0 + ai * HALF + m * 16;
#define EPI_ROWS_END }
__device__ __forceinline__ u32x4 pack8(f32x4 v0, f32x4 v1) { u32x4 w; w.x = pk2(v0[0], v0[1]); w.y = pk2(v0[2], v0[3]); w.z = pk2(v1[0], v1[1]); w.w = pk2(v1[2], v1[3]); return w; }
__device__ __forceinline__ void unpack8(u32x4 w, f32x4& v0, f32x4& v1) { v0 = (f32x4){bf_lo(w.x), bf_hi(w.x), bf_lo(w.y), bf_hi(w.y)}; v1 = (f32x4){bf_lo(w.z), bf_hi(w.z), bf_lo(w.w), bf_hi(w.w)}; }
__device__ __forceinline__ float sigm(float x) { return __builtin_amdgcn_rcpf(1.0f + __builtin_amdgcn_exp2f(-LOG2E * x)); }

struct EpiPlain {
    static constexpr bool PERM = true, AFTER_DRAIN = false;
    bf16_t* O; int ldc; float scale;
    __device__ __forceinline__ void operator()(const f32x4 (&acc)[2][2][4][2], const Unit& u, int wr, int wc, int fr, int fq) const {
        const int col0 = u.pn * BM + wc * 32 + 8 * fq;
        EPI_ROWS_BEGIN
            bf16_t* rowp = O + (size_t)row * ldc + col0;
#pragma unroll
            for (int bj = 0; bj < 2; ++bj) *(u32x4*)(rowp + bj * HALF) = pack8(acc[ai][bj][m][0] * scale, acc[ai][bj][m][1] * scale);
        EPI_ROWS_END
    }
};
struct EpiRowScale {
    static constexpr bool PERM = true, AFTER_DRAIN = false;
    bf16_t* O; int ldc; float scale; const float* RS; const unsigned* rsc;
    __device__ __forceinline__ void operator()(const f32x4 (&acc)[2][2][4][2], const Unit& u, int wr, int wc, int fr, int fq) const {
        const int col0 = u.pn * BM + wc * 32 + 8 * fq;
        if (fr == 0 && fq == 0) { while (__hip_atomic_load(rsc + 32 * u.pm, __ATOMIC_RELAXED, __HIP_MEMORY_SCOPE_AGENT) < 256u) __builtin_amdgcn_s_sleep(4); }
        asm volatile("" ::: "memory");
        EPI_ROWS_BEGIN
            bf16_t* rowp = O + (size_t)row * ldc + col0;
            const float s = scale * __builtin_bit_cast(float, __hip_atomic_load((const unsigned*)RS + row, __ATOMIC_RELAXED, __HIP_MEMORY_SCOPE_AGENT));
#pragma unroll
            for (int bj = 0; bj < 2; ++bj) *(u32x4*)(rowp + bj * HALF) = pack8(acc[ai][bj][m][0] * s, acc[ai][bj][m][1] * s);
        EPI_ROWS_END
    }
};
struct EpiProj {
    static constexpr bool PERM = true, AFTER_DRAIN = false;
    bf16_t* O;
    __device__ __forceinline__ void operator()(const f32x4 (&acc)[2][2][4][2], const Unit& u, int wr, int wc, int fr, int fq) const {
        const int col0 = u.pn * BM + wc * 32 + 8 * fq; const int pn = u.pn;
        const int mode = (pn < 4 || (pn >= 5 && pn < 9)) ? 1 : (pn >= 13 ? 2 : 0);
        EPI_ROWS_BEGIN
            bf16_t* rowp = O + (size_t)row * NPROJ + col0;
#pragma unroll
            for (int bj = 0; bj < 2; ++bj) { f32x4 v0 = acc[ai][bj][m][0], v1 = acc[ai][bj][m][1];
                if (mode == 1) { v0 = v0 * C2_64; v1 = v1 * C2_64; }
                else if (mode == 2) {
#pragma unroll
                    for (int i = 0; i < 4; ++i) { v0[i] = sigm(v0[i]); v1[i] = sigm(v1[i]); } }
                *(u32x4*)(rowp + bj * HALF) = pack8(v0, v1); }
        EPI_ROWS_END
    }
};
__device__ __forceinline__ unsigned q4_u8(f32x4 v) { const unsigned a = (unsigned)(v[0] * 255.0f + 0.5f), b = (unsigned)(v[1] * 255.0f + 0.5f), c = (unsigned)(v[2] * 255.0f + 0.5f), d = (unsigned)(v[3] * 255.0f + 0.5f); return a | (b << 8) | (c << 16) | (d << 24); }
__device__ __forceinline__ f32x4 u8_f4(unsigned w) { return (f32x4){(float)(w & 0xffu), (float)((w >> 8) & 0xffu), (float)((w >> 16) & 0xffu), (float)(w >> 24)} * (1.0f / 255.0f); }
struct EpiBranch0 {
    static constexpr bool PERM = true, AFTER_DRAIN = false;
    const unsigned char* G8; bf16_t* O;
    __device__ __forceinline__ void operator()(const f32x4 (&acc)[2][2][4][2], const Unit& u, int wr, int wc, int fr, int fq) const {
        const int col0 = u.pn * BM + wc * 32 + 8 * fq;
        EPI_ROWS_BEGIN
#pragma unroll
            for (int bj = 0; bj < 2; ++bj) { const int col = col0 + bj * HALF;
                const u32x2 gw = *(const u32x2*)(G8 + (size_t)row * 4096 + col); const f32x4 g0 = u8_f4(gw.x), g1 = u8_f4(gw.y);
                *(u32x4*)(O + (size_t)row * DM + col) = pack8(g0 * acc[ai][bj][m][0], g1 * acc[ai][bj][m][1]); }
        EPI_ROWS_END
    }
};
struct EpiBranch1 {
    static constexpr bool PERM = true, AFTER_DRAIN = false;
    const unsigned char* G8; bf16_t* O;
    __device__ __forceinline__ void operator()(const f32x4 (&acc)[2][2][4][2], const Unit& u, int wr, int wc, int fr, int fq) const {
        const int col0 = u.pn * BM + wc * 32 + 8 * fq;
        EPI_ROWS_BEGIN
#pragma unroll
            for (int bj = 0; bj < 2; ++bj) { const int col = col0 + bj * HALF;
                const u32x2 gw = *(const u32x2*)(G8 + (size_t)row * 4096 + DM + col); const f32x4 g0 = u8_f4(gw.x), g1 = u8_f4(gw.y);
                f32x4 t0, t1; unpack8(*(const u32x4*)(O + (size_t)row * DM + col), t0, t1);
                *(u32x4*)(O + (size_t)row * DM + col) = pack8(t0 + g0 * acc[ai][bj][m][0], t1 + g1 * acc[ai][bj][m][1]); }
        EPI_ROWS_END
    }
};
template <bool BASE_BF16>
struct EpiResid {
    static constexpr bool PERM = true, AFTER_DRAIN = false;
    const void* BASE; bf16_t* OUT;
    __device__ __forceinline__ void operator()(const f32x4 (&acc)[2][2][4][2], const Unit& u, int wr, int wc, int fr, int fq) const {
        const int col0 = u.pn * BM + wc * 32 + 8 * fq;
        EPI_ROWS_BEGIN
#pragma unroll
            for (int bj = 0; bj < 2; ++bj) { const size_t off = (size_t)row * DM + col0 + bj * HALF;
                f32x4 b0, b1;
                if (BASE_BF16) unpack8(*(const u32x4*)((const bf16_t*)BASE + off), b0, b1);
                else { b0 = *(const f32x4*)((const float*)BASE + off); b1 = *(const f32x4*)((const float*)BASE + off + 4); }
                *(u32x4*)(OUT + off) = pack8(b0 + acc[ai][bj][m][0], b1 + acc[ai][bj][m][1]); }
        EPI_ROWS_END
    }
};
__device__ __forceinline__ unsigned pk4_fp8(float a, float b, float c, float d) { int w = 0; w = __builtin_amdgcn_cvt_pk_fp8_f32(a, b, w, false); w = __builtin_amdgcn_cvt_pk_fp8_f32(c, d, w, true); return (unsigned)w; }
struct EpiGlu {
    static constexpr bool PERM = true, AFTER_DRAIN = false;
    const float* bgu; unsigned char* ACT;
    __device__ __forceinline__ void operator()(const f32x4 (&acc)[2][2][4][2], const Unit& u, int wr, int wc, int fr, int fq) const {
        const int col = u.pn * HALF + wc * 32 + 8 * fq;
        const float* bg = bgu + (size_t)u.e * (2 * DFF) + col; const float* bl = bg + DFF;
        const f32x4 bg0 = *(const f32x4*)bg, bg1 = *(const f32x4*)(bg + 4), bl0 = *(const f32x4*)bl, bl1 = *(const f32x4*)(bl + 4);
        EPI_ROWS_BEGIN
            f32x4 a[2];
#pragma unroll
            for (int n = 0; n < 2; ++n) { const f32x4 g = acc[ai][0][m][n] * (1.0f / 512.0f) + (n ? bg1 : bg0), l = acc[ai][1][m][n] * (1.0f / 512.0f) + (n ? bl1 : bl0);
#pragma unroll
                for (int i = 0; i < 4; ++i) { const float gl = fminf(g[i], 7.0f), li = fminf(fmaxf(l[i], -7.0f), 7.0f);
                    a[n][i] = 4.0f * gl * __builtin_amdgcn_rcpf(1.0f + __builtin_amdgcn_exp2f(-1.702f * LOG2E * gl)) * (li + 1.0f); } }
            u32x2 w; w.x = pk4_fp8(a[0][0], a[0][1], a[0][2], a[0][3]); w.y = pk4_fp8(a[1][0], a[1][1], a[1][2], a[1][3]);
            *(u32x2*)(ACT + (size_t)row * DFF + col) = w;
        EPI_ROWS_END
    }
};
struct EpiDown {
    static constexpr bool PERM = true, AFTER_DRAIN = false;
    const float* bd; const int* rowslot; const float* roww; unsigned char* OUT;
    __device__ __forceinline__ void operator()(const f32x4 (&acc)[2][2][4][2], const Unit& u, int wr, int wc, int fr, int fq) const {
        const int col0 = u.pn * BM + wc * 32 + 8 * fq;
        const float* bp = bd + (size_t)u.e * DM + col0;
        f32x4 bv[2][2];
#pragma unroll
        for (int bj = 0; bj < 2; ++bj) { bv[bj][0] = *(const f32x4*)(bp + bj * HALF); bv[bj][1] = *(const f32x4*)(bp + bj * HALF + 4); }
        EPI_ROWS_BEGIN
            const int slot = rowslot[row]; const float w = roww[row];
            if (slot >= 0) {
#pragma unroll
                for (int bj = 0; bj < 2; ++bj)
                { const f32x4 y0 = (acc[ai][bj][m][0] * (1.0f / 256.0f) + bv[bj][0]) * (32.0f * w), y1 = (acc[ai][bj][m][1] * (1.0f / 256.0f) + bv[bj][1]) * (32.0f * w);
                    u32x2 q; q.x = pk4_fp8(y0[0], y0[1], y0[2], y0[3]); q.y = pk4_fp8(y1[0], y1[1], y1[2], y1[3]); *(u32x2*)(OUT + (size_t)slot * DM + col0 + bj * HALF) = q; }
            }
        EPI_ROWS_END
    }
};


struct EpiGate {
    static constexpr bool PERM = true, AFTER_DRAIN = false;
    unsigned char* G8;
    __device__ __forceinline__ void operator()(const f32x4 (&acc)[2][2][4][2], const Unit& u, int wr, int wc, int fr, int fq) const {
        const int col0 = u.pn * BM + wc * 32 + 8 * fq;
        EPI_ROWS_BEGIN
            unsigned char* rowp = G8 + (size_t)row * 4096 + col0;
#pragma unroll
            for (int bj = 0; bj < 2; ++bj) { f32x4 v0 = acc[ai][bj][m][0] * (1.0f / 512.0f), v1 = acc[ai][bj][m][1] * (1.0f / 512.0f);
#pragma unroll
                for (int i = 0; i < 4; ++i) { v0[i] = sigm(v0[i]); v1[i] = sigm(v1[i]); }
                u32x2 w; w.x = q4_u8(v0); w.y = q4_u8(v1); *(u32x2*)(rowp + bj * HALF) = w; }
        EPI_ROWS_END
    }
};

struct EpiProjAll {
    static constexpr bool PERM = true, AFTER_DRAIN = false;
    bf16_t* PROJ; bf16_t* VT; bf16_t* KM; bf16_t* VMT;
    __device__ __forceinline__ void operator()(const f32x4 (&acc)[2][2][4][2], const Unit& u, int wr, int wc, int fr, int fq) const {
        if (u.e == 0) { EpiProj E{PROJ}; E(acc, u, wr, wc, fr, fq); }
        else { EpiPlain E{u.e == 1 ? VT : (u.e == 2 ? KM : VMT), u.e == 1 ? T : 512, 1.0f}; E(acc, u, wr, wc, fr, fq); }
    }
};
struct EpiBranchAll {
    static constexpr bool PERM = true, AFTER_DRAIN = false;
    const unsigned char* PROJ; bf16_t* O;
    __device__ __forceinline__ void operator()(const f32x4 (&acc)[2][2][4][2], const Unit& u, int wr, int wc, int fr, int fq) const {
        if (u.e == 0) { EpiBranch0 E{PROJ, O}; E(acc, u, wr, wc, fr, fq); }
        else { asm volatile("s_waitcnt vmcnt(0)" ::: "memory");
               EpiBranch1 E{PROJ, O}; E(acc, u, wr, wc, fr, fq); }
    }
};
template <class Epi, class Sched, bool ALIGN_EPI = false, bool SP2 = false, bool FP8 = false>
__device__ __forceinline__ void gemm_phase(PG8_LAS unsigned char* lds, const Gemm g, const Sched& S, const Epi& E) {
    int tid = threadIdx.x; asm volatile("" : "+v"(tid)); const int wid = __builtin_amdgcn_readfirstlane(tid >> 6), lane = tid & 63, wr = wid >> 2, wc = wid & 3, fr = lane & 15, fq = lane >> 4;
    const int K = g.K, nt = K / BK;
    unsigned voffA[2], voffB[2];
#pragma unroll
    for (int i = 0; i < 2; ++i) { int R, C; stage_rc(tid * 16 + i * 8192, R, C); const int Rb = Epi::PERM ? ((R & ~31) + perm32(R & 31)) : R;
        voffA[i] = (unsigned)(R * K + C) * 2u; voffB[i] = (unsigned)(Rb * K + C) * 2u; }
    u32x2 vgc = {0u, 0u}, vgn = {0u, 0u};
    auto gather_issue = [&](const unsigned short* rp, u32x2& dst) { int t4 = threadIdx.x; asm volatile("" : "+v"(t4)); int R, C; stage_rc(t4 * 16, R, C); const unsigned o = (unsigned)R * 8u;
        asm volatile("s_nop 4\n\tglobal_load_dwordx2 %0, %1, %2" : "=&v"(dst) : "v"(o), "s"(rp) : "memory"); };
#define PG8_GOFF(v, h, i) ((((i) ? ((h) ? (v).y >> 16 : (v).x >> 16) : ((h) ? (v).y & 0xffffu : (v).x & 0xffffu)) * (unsigned)(K * 2)) + (voffB[0] & (unsigned)(K * 2 - 1)))
    const size_t kstep = (size_t)(BK * 2);
    const size_t hstep = Sched::GATHER ? (size_t)0 : (size_t)HALF * K * 2;
    const size_t bhs = g.bhstep;
    const unsigned lds0 = (unsigned)(unsigned long)lds;
    const unsigned ldsw = (unsigned)wid * 1024u;
    const int aoff = lds_byte(wr * 64 + fr, fq * 8), boff = lds_byte(wc * 32 + fr, fq * 8);
#define PG8_SA(b, h) (((b) * 2 + (h)) * HTB)
#define PG8_SB(b, h) ((4 + (b) * 2 + (h)) * HTB)
#define PG8_STAGE(bufoff, gbase, voff) do { _Pragma("unroll") for (int _i = 0; _i < 2; ++_i) \
        glds16_s((const char*)(gbase), (voff)[_i], lds0 + (unsigned)(bufoff) + ldsw + (unsigned)(_i * 8192)); } while (0)
#define PG8_STAGE_A(bufoff, gbase, h, nx) do { if constexpr (Sched::GATHER) { u32x2 vv_ = (nx) ? vgn : vgc; asm volatile("" : "+v"(vv_));        const unsigned vs_[2] = {PG8_GOFF(vv_, h, 0), PG8_GOFF(vv_, h, 1)}; PG8_STAGE(bufoff, gbase, vs_); } else PG8_STAGE(bufoff, gbase, voffA); } while (0)
#define PG8_LDA(dst, b, h) do { _Pragma("unroll") for (int m = 0; m < 4; ++m) _Pragma("unroll") for (int k = 0; k < 2; ++k) dst[m][k] = *(const PG8_LAS bf16x8*)(lds + PG8_SA(b, h) + aoff + m * 2048 + k * 1024); } while (0)
#define PG8_LDB(dst, b, h) do { _Pragma("unroll") for (int n = 0; n < 2; ++n) _Pragma("unroll") for (int k = 0; k < 2; ++k) dst[n][k] = *(const PG8_LAS bf16x8*)(lds + PG8_SB(b, h) + boff + n * 2048 + k * 1024); } while (0)
#define PG8_MMA(ai, bj, At, Bt) do { __builtin_amdgcn_s_setprio(1); _Pragma("unroll") for (int m = 0; m < 4; ++m) _Pragma("unroll") for (int n = 0; n < 2; ++n) { \
        if constexpr (FP8) acc[ai][bj][m][n] = __builtin_amdgcn_mfma_scale_f32_16x16x128_f8f6f4(cat16(Bt[n][0], Bt[n][1]), cat16(At[m][0], At[m][1]), acc[ai][bj][m][n], 0, 0, 0, 0, 0, 0); \
        else { _Pragma("unroll") for (int k = 0; k < 2; ++k) acc[ai][bj][m][n] = __builtin_amdgcn_mfma_f32_16x16x32_bf16(Bt[n][k], At[m][k], acc[ai][bj][m][n], 0, 0, 0); } } __builtin_amdgcn_s_setprio(0); } while (0)
#define PG8_WAIT_V(n) asm volatile("s_waitcnt vmcnt(" #n ")" ::: "memory")
#define PG8_WAIT_L(n) asm volatile("s_waitcnt lgkmcnt(" #n ")" ::: "memory")
#define PG8_BAR __builtin_amdgcn_s_barrier()
#define PG8_SCHED __builtin_amdgcn_sched_barrier(0)
    Unit cur, nxt; int ui = 0;
    if (!S.next(0, cur)) return;
    f32x4 acc[2][2][4][2];
#pragma unroll
    for (int a = 0; a < 2; ++a)
#pragma unroll
        for (int b = 0; b < 2; ++b)
#pragma unroll
            for (int m = 0; m < 4; ++m)
#pragma unroll
                for (int n = 0; n < 2; ++n) acc[a][b][m][n] = (f32x4){0.f, 0.f, 0.f, 0.f};
    bf16x8 At[4][2], B0[2][2], B1[2][2];
    const char* cA; const char* cB; S.ptrs(cur, cA, cB);
    S.a_ready(cur);
    if constexpr (Sched::GATHER) { static_assert(SP2, "gather is written for the SP2 loop"); gather_issue(S.rows(cur), vgc); asm volatile("s_waitcnt vmcnt(0)" : "+v"(vgc) :: "memory"); vgn = vgc; }
    if constexpr (SP2) {
        PG8_STAGE(PG8_SB(0, 0), cB, voffB); PG8_STAGE(PG8_SB(0, 1), cB + bhs, voffB); PG8_STAGE_A(PG8_SA(0, 0), cA, 0, false); PG8_STAGE_A(PG8_SA(0, 1), cA + hstep, 1, false);
        if (wr == 1) PG8_BAR;
        PG8_WAIT_V(2); PG8_BAR;
        PG8_STAGE(PG8_SB(1, 0), cB + kstep, voffB); PG8_STAGE_A(PG8_SA(1, 0), cA + kstep, 0, false); PG8_STAGE(PG8_SB(1, 1), cB + bhs + kstep, voffB);
        PG8_WAIT_V(6); PG8_BAR;
    } else {
        PG8_STAGE(PG8_SB(0, 0), cB, voffB); PG8_STAGE(PG8_SA(0, 0), cA, voffA); PG8_STAGE(PG8_SB(0, 1), cB + bhs, voffB); PG8_STAGE(PG8_SA(0, 1), cA + hstep, voffA);
        if (wr == 1) PG8_BAR;
        PG8_WAIT_V(4); PG8_BAR;
        PG8_STAGE(PG8_SB(1, 0), cB + kstep, voffB); PG8_STAGE(PG8_SA(1, 0), cA + kstep, voffA); PG8_STAGE(PG8_SB(1, 1), cB + bhs + kstep, voffB);
        PG8_WAIT_V(6); PG8_BAR;
    }
    for (;;) {
        const bool has_next = S.next(ui + 1, nxt);
        const char* nA = cA; const char* nB = cB; if (has_next) S.ptrs(nxt, nA, nB);
        if constexpr (Sched::GATHER) { if (has_next) gather_issue(S.rows(nxt), vgn); }
        for (int t = 0; t < nt; t += 2) {
            const bool last = (t == nt - 2);
            const char* a1 = cA + (size_t)(t + 1) * kstep;
            const char* a2 = last ? nA : cA + (size_t)(t + 2) * kstep; const char* b2 = last ? nB : cB + (size_t)(t + 2) * kstep;
            const char* a3 = a2 + kstep; const char* b3 = b2 + kstep;
            if (last && has_next) S.a_ready(nxt);
            if constexpr (SP2) {
            PG8_LDB(B0, 0, 0); PG8_LDB(B1, 0, 1); PG8_SCHED; PG8_LDA(At, 0, 0); PG8_STAGE_A(PG8_SA(1, 1), a1 + hstep, 1, false);
            PG8_WAIT_V(8); PG8_WAIT_L(0); PG8_BAR; PG8_MMA(0, 0, At, B0); PG8_MMA(0, 1, At, B1); PG8_BAR; PG8_SCHED;
            PG8_LDA(At, 0, 1); PG8_STAGE(PG8_SB(0, 0), b2, voffB); PG8_STAGE(PG8_SB(0, 1), b2 + bhs, voffB); PG8_STAGE_A(PG8_SA(0, 0), a2, 0, last);
            PG8_WAIT_V(8); PG8_WAIT_L(0); PG8_BAR;
            PG8_MMA(1, 0, At, B0); PG8_MMA(1, 1, At, B1); PG8_BAR; PG8_SCHED;
            PG8_LDB(B0, 1, 0); PG8_LDB(B1, 1, 1); PG8_SCHED; PG8_LDA(At, 1, 0); PG8_STAGE_A(PG8_SA(0, 1), a2 + hstep, 1, last);
            PG8_WAIT_V(8); PG8_WAIT_L(0); PG8_BAR; PG8_MMA(0, 0, At, B0); PG8_MMA(0, 1, At, B1); PG8_BAR; PG8_SCHED;
            PG8_LDA(At, 1, 1); PG8_STAGE(PG8_SB(1, 0), b3, voffB); PG8_STAGE(PG8_SB(1, 1), b3 + bhs, voffB); PG8_STAGE_A(PG8_SA(1, 0), a3, 0, last);
            PG8_WAIT_V(8); PG8_WAIT_L(0); PG8_BAR; PG8_MMA(1, 0, At, B0); PG8_MMA(1, 1, At, B1); PG8_BAR; PG8_SCHED;
            } else {
            PG8_LDB(B0, 0, 0); PG8_SCHED; PG8_LDA(At, 0, 0); PG8_STAGE(PG8_SA(1, 1), a1 + hstep, voffA);
            PG8_WAIT_L(8); PG8_BAR; PG8_WAIT_L(0); PG8_MMA(0, 0, At, B0); PG8_BAR; PG8_SCHED;
            PG8_LDB(B1, 0, 1); PG8_STAGE(PG8_SB(0, 0), b2, voffB);
            PG8_BAR; PG8_WAIT_L(0); PG8_MMA(0, 1, At, B1); PG8_BAR;
            PG8_LDA(At, 0, 1); PG8_STAGE(PG8_SA(0, 0), a2, voffA);
            PG8_BAR; PG8_WAIT_L(0); PG8_MMA(1, 0, At, B0); PG8_BAR; PG8_SCHED;
            PG8_STAGE(PG8_SB(0, 1), b2 + bhs, voffB);
            PG8_WAIT_V(6); PG8_BAR; PG8_MMA(1, 1, At, B1); PG8_BAR;
            PG8_LDB(B0, 1, 0); PG8_SCHED; PG8_LDA(At, 1, 0); PG8_STAGE(PG8_SA(0, 1), a2 + hstep, voffA);
            PG8_WAIT_L(8); PG8_BAR; PG8_WAIT_L(0); PG8_MMA(0, 0, At, B0); PG8_BAR; PG8_SCHED;
            PG8_LDB(B1, 1, 1); PG8_STAGE(PG8_SB(1, 0), b3, voffB);
            PG8_BAR; PG8_WAIT_L(0); PG8_MMA(0, 1, At, B1); PG8_BAR;
            PG8_LDA(At, 1, 1); PG8_STAGE(PG8_SA(1, 0), a3, voffA);
            PG8_BAR; PG8_WAIT_L(0); PG8_MMA(1, 0, At, B0); PG8_BAR; PG8_SCHED;
            PG8_STAGE(PG8_SB(1, 1), b3 + bhs, voffB);
            PG8_WAIT_V(6); PG8_BAR; PG8_MMA(1, 1, At, B1); PG8_BAR;
            }
        }
        if constexpr (ALIGN_EPI) { if (wr == 0) PG8_BAR; }
        if constexpr (!Epi::AFTER_DRAIN) { int t2 = threadIdx.x; asm volatile("" : "+v"(t2)); const int l2 = t2 & 63, w2 = __builtin_amdgcn_readfirstlane(t2 >> 6); E(acc, cur, w2 >> 2, w2 & 3, l2 & 15, l2 >> 4); S.done(cur); }
        if (!has_next) break;
#pragma unroll
        for (int a = 0; a < 2; ++a)
#pragma unroll
            for (int b = 0; b < 2; ++b)
#pragma unroll
                for (int m = 0; m < 4; ++m)
#pragma unroll
                    for (int n = 0; n < 2; ++n) acc[a][b][m][n] = (f32x4){0.f, 0.f, 0.f, 0.f};
        cur = nxt; cA = nA; cB = nB; ++ui;
        if constexpr (Sched::GATHER) vgc = vgn;
        if constexpr (ALIGN_EPI) { if (wr == 1) PG8_BAR; }
    }
    PG8_WAIT_V(0);
    if constexpr (!ALIGN_EPI) { if (wr == 0) PG8_BAR; }
    PG8_BAR;
    if constexpr (Epi::AFTER_DRAIN) { E.fused(acc, cur, wr, wc, fr, fq, lds, wid, lane); S.done(cur); }
#undef PG8_SA
#undef PG8_SB
#undef PG8_STAGE
#undef PG8_STAGE_A
#undef PG8_GOFF
#undef PG8_LDA
#undef PG8_LDB
#undef PG8_MMA
#undef PG8_WAIT_V
#undef PG8_WAIT_L
#undef PG8_BAR
#undef PG8_SCHED
}
}

#define XB_TMO      128
#define XB_XCNT(j)  (256  + 64 * (j))
#define XB_XSUB(j)  (1280 + 64 * (j))
#define XB_XGEN(j)  (2304 + 64 * (j))
#define XB_TOP      3328
#define XB_TOPGEN   3392
#define XCD_BAR_WORDS 3456
#define XB_SPIN_CAP (1u << 18)
#define LAS __attribute__((address_space(3)))

__device__ __forceinline__ unsigned xb_ld(unsigned* p)              { return __hip_atomic_load(p, __ATOMIC_RELAXED, __HIP_MEMORY_SCOPE_AGENT); }
__device__ __forceinline__ unsigned xb_add(unsigned* p, unsigned v) { return __hip_atomic_fetch_add(p, v, __ATOMIC_RELAXED, __HIP_MEMORY_SCOPE_AGENT); }
__device__ __forceinline__ unsigned xb_xcc_id() { return (unsigned)__builtin_amdgcn_s_getreg((3 << 11) | 20) & 0xFu; }
#define XB_SPIN(cond, bar) do { unsigned _sp = 0; while (cond) { __builtin_amdgcn_s_sleep(1); \
    if ((++_sp & 255u) == 0u) { if (xb_ld(&(bar)[XB_TMO])) break; if (_sp > XB_SPIN_CAP) { atomicAdd(&(bar)[XB_TMO], 1u); break; } } } } while (0)

struct XcdBarrier {
    unsigned* bar; unsigned x;
    volatile LAS unsigned* st;
};

__device__ __forceinline__ XcdBarrier xcd_barrier_post(unsigned* bar, volatile LAS unsigned* st) {
    XcdBarrier b; b.bar = bar; b.x = xb_xcc_id(); b.st = st;
    if (threadIdx.x == 0) (void)xb_add(&bar[XB_XCNT(b.x)], 1u);
    return b;
}
__device__ __forceinline__ void xcd_barrier_complete(unsigned* bar, unsigned x, unsigned& nloc, unsigned& nx) {
    const unsigned G = gridDim.x * gridDim.y * gridDim.z;
    unsigned sum, cnt, mine, sp = 0u;
    for (;;) {
        sum = 0u; cnt = 0u; mine = 0u;
#pragma unroll
        for (unsigned j = 0; j < 16; ++j) { const unsigned c = xb_ld(&bar[XB_XCNT(j)]); sum += c; cnt += (c > 0u) ? 1u : 0u; mine = (j == x) ? c : mine; }
        if (sum == G) break;
        __builtin_amdgcn_s_sleep(1);
        if ((++sp & 255u) == 0u) { if (xb_ld(&bar[XB_TMO])) break; if (sp > XB_SPIN_CAP) { atomicAdd(&bar[XB_TMO], 1u); break; } }
    }
    nloc = mine > 0u ? mine : 1u; nx = cnt > 0u ? cnt : 1u;
}

__device__ __forceinline__ void xcd_barrier(const XcdBarrier& b) {
    asm volatile("s_waitcnt vmcnt(0)" ::: "memory");
    __syncthreads();
    if (threadIdx.x == 0) {
        unsigned* bar = b.bar;
        __builtin_amdgcn_s_waitcnt(0);
        unsigned nloc = b.st[0], nx = b.st[1];
        if (nloc == 0u) { xcd_barrier_complete(bar, b.x, nloc, nx); b.st[0] = nloc; b.st[1] = nx; }
        const unsigned old = xb_add(&bar[XB_XSUB(b.x)], 1u);
        const unsigned gen = old / nloc;
        if (old + 1u == (gen + 1u) * nloc) {
            __builtin_amdgcn_fence(__ATOMIC_RELEASE, "agent");
            asm volatile("s_waitcnt vmcnt(0)" ::: "memory");
            const unsigned og = xb_add(&bar[XB_TOP], 1u);
            const unsigned tg = og / nx;
            if (og + 1u == (tg + 1u) * nx) xb_add(&bar[XB_TOPGEN], 1u);
            else XB_SPIN(xb_ld(&bar[XB_TOPGEN]) == tg, bar);
            __builtin_amdgcn_fence(__ATOMIC_ACQUIRE, "agent");
            xb_add(&bar[XB_XGEN(b.x)], 1u);
            asm volatile("s_waitcnt vmcnt(0)" ::: "memory");
        } else {
            XB_SPIN(xb_ld(&bar[XB_XGEN(b.x)]) == gen, bar);
            __builtin_amdgcn_fence(__ATOMIC_ACQUIRE, "agent");
            asm volatile("s_waitcnt vmcnt(0)" ::: "memory");
        }
    }
    __syncthreads();
}


__device__ __forceinline__ const float* fin(int k) { typedef const float* const __attribute__((address_space(4))) * kap_t; return ((kap_t)__builtin_amdgcn_kernarg_segment_ptr())[k]; }
struct Frame {
    LAS unsigned char* lds;
    unsigned* ctl;
    int wave, vcu, G;
    float* out;
    unsigned char* ws;
};
#define WSP(type, off) ((type*)(F.ws + (off)))

__device__ __forceinline__ int win_dst_row(int n0) {
    if (n0 < 1280) return n0;
    if (n0 < 1536) return NPROJ + (n0 - 1280);
    if (n0 < 2560) return PC_QD + (n0 - 1536);
    if (n0 < 3584) return PC_KD + (n0 - 2560);
    if (n0 < 4608) return NPROJ + 256 + (n0 - 3584);
    return PC_G + (n0 - 4608);
}
__device__ __forceinline__ void rms_row_bf16(const float* xrow, const float* gain, bf16_t* orow, int lane, unsigned char* o8 = nullptr) {
    f32x4 v[8]; float s = 0.f;
#pragma unroll
    for (int j = 0; j < 8; ++j) { v[j] = ((const f32x4*)xrow)[lane + 64 * j]; s += (v[j][0] * v[j][0] + v[j][1] * v[j][1]) + (v[j][2] * v[j][2] + v[j][3] * v[j][3]); }
    const float rstd = 1.0f / sqrtf(wave_sum(s) * (1.0f / DM) + RMS_EPS);
#pragma unroll
    for (int j = 0; j < 8; ++j) { const f32x4 g = ((const f32x4*)gain)[lane + 64 * j]; const f32x4 o = v[j] * rstd * g;
        u32x2 w; w.x = pk2(o[0], o[1]); w.y = pk2(o[2], o[3]); ((u32x2*)orow)[lane + 64 * j] = w;
        if (o8) ((unsigned*)o8)[lane + 64 * j] = pg8::pk4_fp8(o[0] * 8.0f, o[1] * 8.0f, o[2] * 8.0f, o[3] * 8.0f); }
}
__device__ __forceinline__ void rows_rms_phase(Frame& F, const float* X, const float* gain, bf16_t* O, int nrows, unsigned char* O8 = nullptr) {
    int lane = threadIdx.x; asm volatile("" : "+v"(lane)); lane &= 63;
    const int gw = F.vcu * NWAVES + F.wave, NGW = F.G * NWAVES;
    for (int r = gw; r < nrows; r += NGW) rms_row_bf16(X + (size_t)r * DM, gain, O + (size_t)r * DM, lane, O8 ? O8 + (size_t)r * DM : nullptr);
}

__device__ __forceinline__ void rows_rstd_phase(Frame& F, const bf16_t* X, float* RS, unsigned* rsc, int nrows) {
    int lane = threadIdx.x; asm volatile("" : "+v"(lane)); lane &= 63;
    const int gw = F.vcu * NWAVES + F.wave, NGW = F.G * NWAVES;
    for (int r = gw; r < nrows; r += 2 * NGW) {
        const int r1 = r + NGW; const bool two = r1 < nrows;
        u32x4 w[2][4];
#pragma unroll
        for (int j = 0; j < 4; ++j) { w[0][j] = ((const u32x4*)(X + (size_t)r * DM))[lane + 64 * j]; w[1][j] = ((const u32x4*)(X + (size_t)(two ? r1 : r) * DM))[lane + 64 * j]; }
#pragma unroll
        for (int q = 0; q < 2; ++q) { float s = 0.f;
#pragma unroll
            for (int j = 0; j < 4; ++j) { f32x4 v0, v1; pg8::unpack8(w[q][j], v0, v1);
                s += ((v0[0] * v0[0] + v0[1] * v0[1]) + (v0[2] * v0[2] + v0[3] * v0[3])) + ((v1[0] * v1[0] + v1[1] * v1[1]) + (v1[2] * v1[2] + v1[3] * v1[3])); }
            s = wave_sum(s);
            if (lane == 0 && (q == 0 || two)) __hip_atomic_store((unsigned*)RS + (q ? r1 : r), __builtin_bit_cast(unsigned, 1.0f / sqrtf(s * (1.0f / DM) + RMS_EPS)), __ATOMIC_RELAXED, __HIP_MEMORY_SCOPE_AGENT); }
    }
    asm volatile("s_waitcnt vmcnt(0)" ::: "memory");
    if (lane == 0) for (int r = gw; r < nrows; r += NGW) __hip_atomic_fetch_add(rsc + 32 * (r >> 8), 1u, __ATOMIC_RELAXED, __HIP_MEMORY_SCOPE_AGENT);
}

struct TrItem { const float* src; int N; unsigned char* dst; int dpitch; int fp8; const float* gain; };
__device__ __forceinline__ bool tr_decode(Frame& F, int it, TrItem& d) {
    constexpr int I_IN = 32 * 136, I_B = 16 * 32, I_O = 32 * 32, I_CQ = 32 * 8, I_CKV = 32 * 16, I_CO = 8 * 32, I_GU1 = 32 * 64, I_D1 = 32 * 32;
    constexpr int NITEMS = I_IN + 2 * I_B + I_O + I_CQ + I_CKV + I_CO + NE * I_GU1 + NE * I_D1;
    if (it >= NITEMS) return false;
    int r = it; const float* W; int K, N, kb, nb, drow; unsigned char* D; int esz = 2; d.fp8 = 0; d.gain = nullptr;
    if (r < NE * I_GU1) { const int e = r / I_GU1, q = r % I_GU1; kb = q / 128; nb = q % 128; W = fin(20) + (size_t)e * DM * 2 * DFF; K = DM; N = 2 * DFF; D = WSP(unsigned char, WS_WGU) + (size_t)e * 2 * DFF * DM; drow = 32 * nb; esz = 1; d.fp8 = 1; }
    else if ((r -= NE * I_GU1) < NE * I_D1) { const int e = r / I_D1, q = r % I_D1; kb = q / 64; nb = q % 64; W = fin(22) + (size_t)e * DFF * DM; K = DFF; N = DM; D = WSP(unsigned char, WS_WD) + (size_t)e * DM * DFF; drow = 32 * nb; esz = 1; d.fp8 = 1; }
    else if ((r -= NE * I_D1) < 32 * 72) { kb = r / 72; nb = r % 72; W = fin(3); K = DM; N = 8704; D = WSP(unsigned char, WS_WIN); drow = win_dst_row(64 * nb); }
    else if ((r -= 32 * 72) < 16 * 128) { kb = r / 128; nb = r % 128; d.fp8 = 1; d.src = fin(3) + (size_t)(128 * kb) * 8704 + 4608 + 32 * nb; d.N = 8704; d.dpitch = DM; d.dst = WSP(unsigned char, WS_WING8) + (size_t)(32 * nb) * DM + 128 * kb; return true; }
    else if ((r -= 16 * 128) < 2 * I_B) { const int n = r / I_B, q = r % I_B; kb = q / 32; nb = q % 32; W = fin(10) + (size_t)n * 1024 * DM; K = 1024; N = DM; D = WSP(unsigned char, WS_WB) + (size_t)n * DM * 1024 * 2; drow = 64 * nb; }
    else if ((r -= 2 * I_B) < I_O) { kb = r / 32; nb = r % 32; W = fin(11); K = DM; N = DM; D = WSP(unsigned char, WS_WO); drow = 64 * nb; }
    else if ((r -= I_O) < I_CQ) { kb = r / 8; nb = r % 8; W = fin(14); K = DM; N = 512; D = WSP(unsigned char, WS_WCQ); drow = 64 * nb; d.gain = fin(12) + 64 * kb; }
    else if ((r -= I_CQ) < I_CKV) { kb = r / 16; nb = r % 16; W = fin(15); K = DM; N = 1024; D = WSP(unsigned char, WS_WCKV); drow = 64 * nb; }
    else { r -= I_CKV; kb = r / 32; nb = r % 32; W = fin(16); K = 512; N = DM; D = WSP(unsigned char, WS_WCO); drow = 64 * nb; }
    if (d.fp8) { d.src = W + (size_t)(128 * kb) * N + 32 * nb; d.N = N; d.dpitch = K; d.dst = D + (size_t)drow * K + (size_t)(128 * kb); return true; }
    d.src = W + (size_t)(64 * kb) * N + 64 * nb; d.N = N; d.dpitch = K * esz; d.dst = D + (size_t)drow * d.dpitch + (size_t)(64 * kb) * esz;
    return true;
}
constexpr int NMOE_ITEMS = NE * (32 * 64 + 32 * 32);
constexpr int NALL_ITEMS = NMOE_ITEMS + 32 * 136 + 2 * 16 * 32 + 32 * 32 + 32 * 8 + 32 * 16 + 8 * 32;
__device__ __forceinline__ void conv_items(Frame& F, int lane, int it0, int step, int end) {
    LAS float* scr = (LAS float*)(F.lds + F.wave * 16896);
    TrItem cur, nxt; int it = it0;
    bool have = it < end && tr_decode(F, it, cur);
    f32x4 v[16];
#define TR_LOAD(D_) do { if ((D_).fp8) { _Pragma("unroll") for (int i = 0; i < 16; ++i) v[i] = *(const f32x4*)((D_).src + (size_t)((lane >> 3) + 8 * i) * (D_).N + 4 * (lane & 7)); } \
        else { _Pragma("unroll") for (int i = 0; i < 16; ++i) v[i] = *(const f32x4*)((D_).src + (size_t)((lane >> 4) + 4 * i) * (D_).N + 4 * (lane & 15)); } } while (0)
    if (have) TR_LOAD(cur);
    while (have) {
        if (cur.fp8) {
#pragma unroll
            for (int i = 0; i < 16; ++i) { LAS float* s = scr + ((lane >> 3) + 8 * i) * 33 + 4 * (lane & 7); s[0] = v[i][0] * 64.0f; s[1] = v[i][1] * 64.0f; s[2] = v[i][2] * 64.0f; s[3] = v[i][3] * 64.0f; }
        } else {
#pragma unroll
            for (int i = 0; i < 16; ++i) { const float sc = cur.gain ? cur.gain[(lane >> 4) + 4 * i] : 1.0f; LAS float* s = scr + ((lane >> 4) + 4 * i) * 65 + 4 * (lane & 15); s[0] = v[i][0] * sc; s[1] = v[i][1] * sc; s[2] = v[i][2] * sc; s[3] = v[i][3] * sc; }
        }
        it += step;
        const bool hn = it < end && tr_decode(F, it, nxt);
        if (hn) TR_LOAD(nxt);
        LDS_WAIT(); asm volatile("" ::: "memory");
        const int kc = lane >> 3;
        if (cur.fp8) {
#pragma unroll
            for (int j = 0; j < 4; ++j) { const int n = lane & 31, k16 = 2 * j + (lane >> 5); const LAS float* s = scr + (16 * k16) * 33 + n;
                u32x4 o; o.x = pg8::pk4_fp8(s[0], s[33], s[66], s[99]); o.y = pg8::pk4_fp8(s[132], s[165], s[198], s[231]);
                o.z = pg8::pk4_fp8(s[264], s[297], s[330], s[363]); o.w = pg8::pk4_fp8(s[396], s[429], s[462], s[495]);
                *(u32x4*)(cur.dst + (size_t)n * cur.dpitch + 16 * k16) = o; }
        } else {
#pragma unroll
            for (int j = 0; j < 8; ++j) { const int n = (lane & 7) + 8 * j; const LAS float* s = scr + (8 * kc) * 65 + n;
                u32x4 o; o.x = pk2(s[0], s[65]); o.y = pk2(s[130], s[195]); o.z = pk2(s[260], s[325]); o.w = pk2(s[390], s[455]);
                *(u32x4*)(cur.dst + (size_t)n * cur.dpitch + 16 * kc) = o; }
        }
        LDS_WAIT(); asm volatile("" ::: "memory");
        cur = nxt; have = hn;
    }
#undef TR_LOAD
}
template <int BLK>
__device__ __forceinline__ void conv_filler(Frame& F, int phase) {
    int tid = threadIdx.x; asm volatile("" : "+v"(tid)); const int lane = tid & 63;
    volatile LAS unsigned* fl = (volatile LAS unsigned*)(F.lds + LDS_MISC_OFF) + 16;
    asm volatile("s_waitcnt vmcnt(0)" ::: "memory");
    __syncthreads();
    unsigned nbase = (unsigned)NMOE_ITEMS, arrived = 0u;
    if (tid == 0) { if (phase >= 0) arrived = __hip_atomic_fetch_add(F.ctl + CW_DONE + 64 * phase, 1u, __ATOMIC_RELAXED, __HIP_MEMORY_SCOPE_AGENT) + 1u;
                    if (phase < 0 || arrived < (unsigned)F.G) nbase = __hip_atomic_fetch_add(F.ctl + CW_CONV, (unsigned)(NWAVES * BLK), __ATOMIC_RELAXED, __HIP_MEMORY_SCOPE_AGENT); }
    for (;;) {
        if (tid == 0) fl[0] = nbase;
        __syncthreads();
        const unsigned base = fl[0];
        __syncthreads();
        if (base >= (unsigned)NMOE_ITEMS) break;
        if (tid == 0) {
            if (phase >= 0 && arrived >= (unsigned)F.G) nbase = (unsigned)NMOE_ITEMS;
            else { nbase = __hip_atomic_fetch_add(F.ctl + CW_CONV, (unsigned)(NWAVES * BLK), __ATOMIC_RELAXED, __HIP_MEMORY_SCOPE_AGENT);
                   if (phase >= 0) arrived = __hip_atomic_load(F.ctl + CW_DONE + 64 * phase, __ATOMIC_RELAXED, __HIP_MEMORY_SCOPE_AGENT); } }
        const int b0 = (int)base + F.wave * BLK, b1 = b0 + BLK;
        conv_items(F, lane, b0, 1, b1 < NMOE_ITEMS ? b1 : NMOE_ITEMS);
    }
}
__device__ __forceinline__ void p0_prologue(Frame& F) {
    int tid = threadIdx.x; asm volatile("" : "+v"(tid)); const int lane = tid & 63;
    const int gw = F.vcu * NWAVES + F.wave, NGW = F.G * NWAVES;
    conv_items(F, lane, NMOE_ITEMS + gw, NGW, NALL_ITEMS);
    rows_rms_phase(F, fin(0), fin(2), WSP(bf16_t, WS_XN), T, WSP(unsigned char, WS_XN8));
    rows_rms_phase(F, fin(1), fin(13), WSP(bf16_t, WS_MEMN), BATCH * 256);
    int* rs = WSP(int, WS_ROWSLOT);
    for (int i = blockIdx.x * NTHR + tid; i < XROWS; i += F.G * NTHR) rs[i] = -1;
    { unsigned* rt = WSP(unsigned, WS_ROWTOK); for (int i = blockIdx.x * NTHR + tid; i < XROWS / 2; i += F.G * NTHR) rt[i] = 0u; }
    { bf16_t* WRT = WSP(bf16_t, WS_WRT); const float* Wr = fin(18); const float* gffn = fin(17);
      for (int i = blockIdx.x * NTHR + tid; i < NE * DM; i += F.G * NTHR) { const int e = i >> 11, k = i & (DM - 1);
          const float w = Wr[(size_t)k * NE + e] * gffn[k]; const unsigned h0 = f2bf(w); const float r1 = w - __builtin_bit_cast(float, h0 << 16);
          const unsigned h1 = f2bf(r1); const float r2 = r1 - __builtin_bit_cast(float, h1 << 16); const unsigned h2 = f2bf(r2);
          const int c = k >> 9, wv = (k >> 6) & 7, kk = (k >> 4) & 3, hi_ = (k >> 3) & 1, j = k & 7;
          const size_t d = ((size_t)((wv * 16 + 4 * c + kk) * 3) * 64 + 32 * hi_ + e) * 8 + j;
          WRT[d] = (bf16_t)h0; WRT[d + 512] = (bf16_t)h1; WRT[d + 1024] = (bf16_t)h2; } }
}

__device__ __forceinline__ void route_r1(Frame& F) {
    const bf16_t* H2 = WSP(bf16_t, WS_H); const float* gffn = fin(17); const float* br = fin(19); const u32x4* WRTF = WSP(u32x4, WS_WRT);
    unsigned char* XN3 = WSP(unsigned char, WS_XN); int* TOPI = WSP(int, WS_TOPI); float* TOPW = WSP(float, WS_TOPW);
    LAS unsigned char* Xb = F.lds;
    LAS float* Lp = (LAS float*)(F.lds + 67584);
    LAS float* rsq = (LAS float*)(F.lds + 100352);
    LAS float* rstd_s = (LAS float*)(F.lds + 100864);
    LAS float* Lg = (LAS float*)(F.lds + 100992);
    LAS int* hist = (LAS int*)(F.lds + 105216);
    int tid = threadIdx.x; asm volatile("" : "+v"(tid)); const int lane = tid & 63;
    const int wave = F.wave, ql = lane & 31, hi = lane >> 5;
    u32x4 pf0[4], pf1[4];
#define R1_LOAD(P_, TASK_, CH_) do { _Pragma("unroll") for (int i = 0; i < 4; ++i) { const int f = tid + 512 * i, row = f >> 6, c8 = f & 63; \
        P_[i] = *(const u32x4*)(H2 + (size_t)((TASK_) * 32 + row) * DM + (CH_) * 512 + 8 * c8); } } while (0)
#define R1_CHUNK(P_, CH_) do { \
            LAS unsigned char* xb = Xb + ((CH_) & 1) * 33280; \
            bf16x8 bfr[4][3];                                     \
            _Pragma("unroll") for (int kk = 0; kk < 4; ++kk) _Pragma("unroll") for (int tm = 0; tm < 3; ++tm) bfr[kk][tm] = __builtin_bit_cast(bf16x8, WRTF[(size_t)((wave * 16 + 4 * (CH_) + kk) * 3 + tm) * 64 + lane]); \
            _Pragma("unroll") for (int i = 0; i < 4; ++i) { const int f = tid + 512 * i, row = f >> 6, c8 = f & 63; \
                f32x4 v0, v1; pg8::unpack8(P_[i], v0, v1); \
                sq[i] += ((v0[0] * v0[0] + v0[1] * v0[1]) + (v0[2] * v0[2] + v0[3] * v0[3])) + ((v1[0] * v1[0] + v1[1] * v1[1]) + (v1[2] * v1[2] + v1[3] * v1[3])); \
                *(LAS u32x4*)(xb + row * 1040 + 16 * c8) = P_[i]; } \
            if ((CH_) < 2) R1_LOAD(P_, task, (CH_) + 2); else if (task + F.G < T / 32) R1_LOAD(P_, task + F.G, (CH_) - 2); \
            __syncthreads();                                      \
            _Pragma("unroll") for (int kk = 0; kk < 4; ++kk) { const bf16x8 a = *(const LAS bf16x8*)(xb + ql * 1040 + (64 * wave + 16 * kk + 8 * hi) * 2); \
                _Pragma("unroll") for (int tm = 0; tm < 3; ++tm) acc = __builtin_amdgcn_mfma_f32_32x32x16_bf16(a, bfr[kk][tm], acc, 0, 0, 0); } } while (0)
    if (F.vcu < T / 32) { R1_LOAD(pf0, F.vcu, 0); R1_LOAD(pf1, F.vcu, 1); }
    for (int task = F.vcu; task < T / 32; task += F.G) {
        const int r0 = task * 32;
        f32x16 acc = {};
        float sq[4];
#pragma unroll
        for (int i = 0; i < 4; ++i) sq[i] = 0.f;
        if (tid < 32) hist[tid] = 0;
#pragma unroll 1
        for (int cp = 0; cp < 4; cp += 2) { R1_CHUNK(pf0, cp); R1_CHUNK(pf1, cp + 1); }
#pragma unroll
        for (int i = 0; i < 4; ++i) { const float s = wave_sum(sq[i]); if (lane == 0) rsq[(wave + 8 * i) * 4] = s; }
#pragma unroll
        for (int r = 0; r < 16; ++r) Lp[wave * 1024 + ((r & 3) + 8 * (r >> 2) + 4 * hi) * 32 + ql] = acc[r];
        __syncthreads();
#pragma unroll
        for (int i = 0; i < 2; ++i) { const int o = tid + 512 * i, tok = o >> 5, e = o & 31; float s = 0.f;
#pragma unroll
            for (int w = 0; w < 8; ++w) s += Lp[w * 1024 + o];
            const float rstd = 1.0f / sqrtf(rsq[tok * 4] * (1.0f / DM) + RMS_EPS);
            if (e == 0) rstd_s[tok] = rstd;
            Lg[tok * 33 + e] = s * rstd + br[e]; }
        __syncthreads();
        { const int tl = lane >> 4, j = lane & 15, tok = 4 * wave + tl; float v0 = Lg[tok * 33 + j], v1 = Lg[tok * 33 + j + 16]; int idx[4]; float val[4];
#pragma unroll
          for (int k = 0; k < 4; ++k) { float bv = v0 >= v1 ? v0 : v1; int bi = v0 >= v1 ? j : j + 16;
#pragma unroll
              for (int m = 1; m < 16; m <<= 1) { const float ov = __shfl_xor(bv, m); const int oi = __shfl_xor(bi, m); const bool take = ov > bv || (ov == bv && oi < bi); bv = take ? ov : bv; bi = take ? oi : bi; }
              idx[k] = bi; val[k] = bv; if (bi == j) v0 = -INFINITY; if (bi == j + 16) v1 = -INFINITY; }
          if (j == 0) { float ex[4], sum = 0.f;
#pragma unroll
              for (int k = 0; k < 4; ++k) { ex[k] = __expf(val[k] - val[0]); sum += ex[k]; }
              const float inv = 1.0f / sum; const int t = r0 + tok;
              *(int __attribute__((ext_vector_type(4)))*)(TOPI + t * 4) = (int __attribute__((ext_vector_type(4)))){idx[0], idx[1], idx[2], idx[3]};
              *(f32x4*)(TOPW + t * 4) = (f32x4){ex[0] * inv, ex[1] * inv, ex[2] * inv, ex[3] * inv};
#pragma unroll
              for (int k = 0; k < 4; ++k) atomicAdd((int*)&hist[idx[k]], 1); } }
#pragma unroll
        for (int rr = 0; rr < 4; ++rr) { const int row = 4 * wave + rr; const float rstd = rstd_s[row];
            const bf16_t* xr = H2 + (size_t)(r0 + row) * DM; unsigned char* orow = XN3 + (size_t)(r0 + row) * DM; const float r8 = rstd * 8.0f;
#pragma unroll
            for (int j = 0; j < 4; ++j) { f32x4 v0, v1; pg8::unpack8(((const u32x4*)xr)[lane + 64 * j], v0, v1);
                const f32x4 o0 = v0 * r8 * ((const f32x4*)gffn)[2 * (lane + 64 * j)], o1 = v1 * r8 * ((const f32x4*)gffn)[2 * (lane + 64 * j) + 1];
                u32x2 w; w.x = pg8::pk4_fp8(o0[0], o0[1], o0[2], o0[3]); w.y = pg8::pk4_fp8(o1[0], o1[1], o1[2], o1[3]); ((u32x2*)orow)[lane + 64 * j] = w; } }
        __syncthreads();
        if (tid < 32) { const int h = hist[tid]; if (h) atomicAdd(F.ctl + CW_CNT + tid, (unsigned)h); }
    }
}
__device__ __forceinline__ void route_r2(Frame& F) {
    const int* TOPI = WSP(int, WS_TOPI); const float* TOPW = WSP(float, WS_TOPW);
    int* ROWSLOT = WSP(int, WS_ROWSLOT); float* ROWW = WSP(float, WS_ROWW); unsigned short* ROWTOK = WSP(unsigned short, WS_ROWTOK);
    LAS int* pst = (LAS int*)F.lds; LAS int* lcnt = pst + 32; LAS int* lbase = pst + 64; LAS int* tmpc = pst + 96;
    int tid = threadIdx.x; asm volatile("" : "+v"(tid));
    if (tid < 32) { const unsigned c = __hip_atomic_load(F.ctl + CW_CNT + tid, __ATOMIC_RELAXED, __HIP_MEMORY_SCOPE_AGENT); tmpc[tid] = (int)((c + 255u) & ~255u); }
    __syncthreads();
    if (tid == 0) { int a = 0; for (int e = 0; e < 32; ++e) { pst[e] = a; a += tmpc[e]; } }
    __syncthreads();
    for (int task = F.vcu; task < T / 64; task += F.G) {
        if (tid < 32) lcnt[tid] = 0;
        __syncthreads();
        int e = 0, rank = 0, t = 0, k = 0; float w = 0.f;
        if (tid < 256) { t = 64 * task + (tid >> 2); k = tid & 3; e = TOPI[t * 4 + k]; w = TOPW[t * 4 + k]; rank = atomicAdd((int*)&lcnt[e], 1); }
        __syncthreads();
        if (tid < 32) { const int n = lcnt[tid]; lbase[tid] = n ? (int)atomicAdd(F.ctl + CW_CUR + tid, (unsigned)n) : 0; }
        __syncthreads();
        if (tid < 256) { const int p = pst[e] + lbase[e] + rank; ROWSLOT[p] = t * 4 + k; ROWW[p] = w; ROWTOK[((p >> 8) * 64 + (p & 63)) * 4 + ((p >> 6) & 3)] = (unsigned short)t; }
        __syncthreads();
    }
}
__device__ __forceinline__ int moe_tile_table(Frame& F) {
    LAS int* tab = (LAS int*)(F.lds + LDS_TAB_OFF); LAS int* pt = tab + 304;
    int tid = threadIdx.x; asm volatile("" : "+v"(tid));
    __syncthreads();
    if (tid < 32) { const unsigned c = __hip_atomic_load(F.ctl + CW_CNT + tid, __ATOMIC_RELAXED, __HIP_MEMORY_SCOPE_AGENT); pt[40 + tid] = (int)((c + 255u) >> 8); }
    __syncthreads();
    if (tid == 0) { int a = 0; for (int e = 0; e < 32; ++e) { pt[e] = a; a += pt[40 + e]; } pt[32] = a; tab[300] = a; }
    __syncthreads();
    const int total = tab[300];
    for (int j = tid; j < total; j += NTHR) { int e = 0; for (int x = 0; x < 32; ++x) if (pt[x + 1] <= j) e = x + 1; tab[j] = e; }
    __syncthreads();
    return total;
}
__device__ __forceinline__ void final_phase(Frame& F) {
    const bf16_t* H2 = WSP(bf16_t, WS_H); const unsigned char* MO = WSP(unsigned char, WS_MOEOUT); const float* gain = fin(24);
    int lane = threadIdx.x; asm volatile("" : "+v"(lane)); lane &= 63;
    const int gw = F.vcu * NWAVES + F.wave, NGW = F.G * NWAVES;
    for (int r = gw; r < T; r += NGW) {
        f32x4 v[8];
#pragma unroll
        for (int j = 0; j < 8; ++j) { const u32x2 w = ((const u32x2*)(H2 + (size_t)r * DM))[lane + 64 * j]; v[j] = (f32x4){bf_lo(w.x), bf_hi(w.x), bf_lo(w.y), bf_hi(w.y)}; }
#pragma unroll
        for (int k = 0; k < 4; ++k) { const unsigned* mr = (const unsigned*)(MO + (size_t)(4 * r + k) * DM);
#pragma unroll
            for (int j = 0; j < 8; ++j) { const unsigned w = mr[lane + 64 * j]; const f32x2 lo = __builtin_amdgcn_cvt_pk_f32_fp8((int)w, false), hi = __builtin_amdgcn_cvt_pk_f32_fp8((int)w, true);
                v[j][0] += lo[0] * (1.0f / 32.0f); v[j][1] += lo[1] * (1.0f / 32.0f); v[j][2] += hi[0] * (1.0f / 32.0f); v[j][3] += hi[1] * (1.0f / 32.0f); } }
        float s = 0.f;
#pragma unroll
        for (int j = 0; j < 8; ++j) s += (v[j][0] * v[j][0] + v[j][1] * v[j][1]) + (v[j][2] * v[j][2] + v[j][3] * v[j][3]);
        const float rstd = 1.0f / sqrtf(wave_sum(s) * (1.0f / DM) + RMS_EPS);
#pragma unroll
        for (int j = 0; j < 8; ++j) { const f32x4 g = ((const f32x4*)gain)[lane + 64 * j]; ((f32x4*)(F.out + (size_t)r * DM))[lane + 64 * j] = v[j] * rstd * g; }
    }
}

namespace att {
constexpr int VP = 72;
__device__ __forceinline__ int pi32(int m) { return (m & ~12) | ((m & 4) << 1) | ((m & 8) >> 1); }
__device__ __forceinline__ float pmax(float v) { auto rr = __builtin_amdgcn_permlane32_swap(__float_as_uint(v), __float_as_uint(v), false, false); return fmaxf(__uint_as_float(rr[0]), __uint_as_float(rr[1])); }
__device__ __forceinline__ float max3f(float a, float b, float c) { float r; asm("v_max3_f32 %0, %1, %2, %3" : "=v"(r) : "v"(a), "v"(b), "v"(c)); return r; }
__device__ __forceinline__ float psum(float v) { auto rr = __builtin_amdgcn_permlane32_swap(__float_as_uint(v), __float_as_uint(v), false, false); return __uint_as_float(rr[0]) + __uint_as_float(rr[1]); }

template <int DQK, int DV, int MASK>
__device__ __forceinline__ void tile_compute(const LAS bf16_t* Ks, const LAS bf16_t* Vs, const bf16x8 (&qf)[DQK / 16], f32x16 (&cin)[2], f32x16 (&o)[DV / 32], float& l, float& mtot,
                                             bool first, bool domask, int qpos, int kbase, int lane) {
    constexpr int KP = DQK + 8, NDS = DQK / 16, NDB = DV / 32;
    const int ql = lane & 31, hi = lane >> 5;
    f32x16 p[2];
#pragma unroll
    for (int j = 0; j < 2; ++j) { const LAS bf16_t* kr = Ks + (32 * j + pi32(ql)) * KP + 8 * hi;
#pragma unroll
        for (int ds = 0; ds < NDS; ++ds) { const bf16x8 kf = *(const LAS bf16x8*)(kr + 16 * ds);
            p[j] = __builtin_amdgcn_mfma_f32_32x32x16_bf16(kf, qf[ds], ds == 0 ? cin[j] : p[j], 0, 0, 0); } }
    if (MASK != 0 && domask) {
#pragma unroll
        for (int j = 0; j < 2; ++j)
#pragma unroll
            for (int r = 0; r < 16; ++r) { const int key = kbase + 32 * j + 16 * (r >> 3) + 8 * hi + (r & 7);
                bool ok = key <= qpos; if (MASK == 2) ok = ok && (key > qpos - 128);
                p[j][r] = ok ? p[j][r] : -INFINITY; }
    }
    float mx = fmaxf(p[0][0], p[1][0]);
#pragma unroll
    for (int r = 1; r < 16; ++r) mx = fmaxf(mx, fmaxf(p[0][r], p[1][r]));
    mx = pmax(mx);
    if (first || __any(mx > 10.0f)) {
        const float delta = first ? mx : fmaxf(mx, 0.f);
#pragma unroll
        for (int j = 0; j < 2; ++j)
#pragma unroll
            for (int r = 0; r < 16; ++r) { p[j][r] -= delta; cin[j][r] -= delta; }
        mtot += delta;
        if (!first) { const float alpha = __builtin_amdgcn_exp2f(-delta); l *= alpha;
#pragma unroll
            for (int db = 0; db < NDB; ++db)
#pragma unroll
                for (int r = 0; r < 16; ++r) o[db][r] *= alpha; }
    }
    float s = 0.f;
#pragma unroll
    for (int j = 0; j < 2; ++j)
#pragma unroll
        for (int r = 0; r < 16; ++r) { p[j][r] = __builtin_amdgcn_exp2f(p[j][r]); s += p[j][r]; }
    l += s;
#pragma unroll
    for (int st = 0; st < 4; ++st) { const int j = st >> 1, a = st & 1;
        u32x4 pw; pw.x = pk2(p[j][8 * a + 0], p[j][8 * a + 1]); pw.y = pk2(p[j][8 * a + 2], p[j][8 * a + 3]); pw.z = pk2(p[j][8 * a + 4], p[j][8 * a + 5]); pw.w = pk2(p[j][8 * a + 6], p[j][8 * a + 7]);
        const bf16x8 pf = __builtin_bit_cast(bf16x8, pw);
#pragma unroll
        for (int db = 0; db < NDB; ++db) { const bf16x8 vf = *(const LAS bf16x8*)(Vs + (32 * db + ql) * VP + 16 * st + 8 * hi);
            o[db] = __builtin_amdgcn_mfma_f32_32x32x16_bf16(vf, pf, o[db], 0, 0, 0); } }
}
template <bool ALIBI>
__device__ __forceinline__ void cin_init(f32x16 (&cin)[2], float slope2, int kbase, int qpos, int hi) {
#pragma unroll
    for (int j = 0; j < 2; ++j)
#pragma unroll
        for (int r = 0; r < 16; ++r) cin[j][r] = ALIBI ? slope2 * (float)(kbase + 32 * j + 16 * (r >> 3) + 8 * hi + (r & 7) - qpos) : 0.f;
}

__device__ __forceinline__ int swz7(int row) { return (row ^ (row >> 3)) & 7; }
template <int MASK>
__device__ __forceinline__ void tile_compute_sw(unsigned slot, int kmat, const unsigned (&krow)[2], const unsigned (&kswz)[2], const unsigned (&vrow)[4], const unsigned (&vswz)[4],
                                                const bf16x8 (&qf)[4], float slope2, f32x16 (&o)[4], float& l, float& mtot, bool first, bool domask, int qpos, int kbase, int lane) {
    const int hi = lane >> 5;
    const float base = slope2 * (float)(kbase - qpos + 8 * hi) - mtot;
    f32x16 p[2];
    bf16x8 kf[2][4];
#pragma unroll
    for (int j = 0; j < 2; ++j)
#pragma unroll
        for (int ds = 0; ds < 4; ++ds) kf[j][ds] = *(const LAS bf16x8*)(unsigned long)(slot + kmat * 8192 + krow[j] + ((unsigned)(32 * ds + 16 * hi) ^ kswz[j]));
    __builtin_amdgcn_sched_barrier(0);
#pragma unroll
    for (int j = 0; j < 2; ++j)
#pragma unroll
        for (int r = 0; r < 16; ++r) p[j][r] = __builtin_fmaf(slope2, (float)(32 * j + 16 * (r >> 3) + (r & 7)), base);
#pragma unroll
    for (int j = 0; j < 2; ++j)
#pragma unroll
        for (int ds = 0; ds < 4; ++ds) p[j] = __builtin_amdgcn_mfma_f32_32x32x16_bf16(kf[j][ds], qf[ds], p[j], 0, 0, 0);
    asm volatile("s_nop 15\n\ts_nop 7" : "+v"(p[0]), "+v"(p[1]));
    bf16x8 vf[4];
#pragma unroll
    for (int db = 0; db < 4; ++db) vf[db] = *(const LAS bf16x8*)(unsigned long)(slot + 16384 + vrow[db] + ((unsigned)(16 * hi) ^ vswz[db]));
    if (MASK != 0 && domask) {
#pragma unroll
        for (int j = 0; j < 2; ++j)
#pragma unroll
            for (int r = 0; r < 16; ++r) { const int key = kbase + 32 * j + 16 * (r >> 3) + 8 * hi + (r & 7); p[j][r] = key <= qpos ? p[j][r] : -INFINITY; }
    }
    float mx = max3f(p[0][0], p[1][0], p[0][1]);
#pragma unroll
    for (int r = 1; r < 15; ++r) mx = max3f(mx, p[1][r], p[0][r + 1]);
    mx = max3f(mx, p[1][15], mx);
    mx = pmax(mx);
    if (first || __any(mx > 10.0f)) {
        const float delta = first ? mx : fmaxf(mx, 0.f);
#pragma unroll
        for (int j = 0; j < 2; ++j)
#pragma unroll
            for (int r = 0; r < 16; ++r) p[j][r] -= delta;
        mtot += delta;
        if (!first) { const float alpha = __builtin_amdgcn_exp2f(-delta); l *= alpha;
#pragma unroll
            for (int db = 0; db < 4; ++db)
#pragma unroll
                for (int r = 0; r < 16; ++r) o[db][r] *= alpha; }
    }
    float s = 0.f;
    u32x4 pw;
#define EXPPACK(st_) do { const int j_ = (st_) >> 1, a_ = (st_) & 1; \
        _Pragma("unroll") for (int r = 0; r < 8; ++r) { p[j_][8 * a_ + r] = __builtin_amdgcn_exp2f(p[j_][8 * a_ + r]); s += p[j_][8 * a_ + r]; } \
        pw.x = pk2(p[j_][8 * a_ + 0], p[j_][8 * a_ + 1]); pw.y = pk2(p[j_][8 * a_ + 2], p[j_][8 * a_ + 3]); pw.z = pk2(p[j_][8 * a_ + 4], p[j_][8 * a_ + 5]); pw.w = pk2(p[j_][8 * a_ + 6], p[j_][8 * a_ + 7]); } while (0)
    EXPPACK(0);
#pragma unroll
    for (int st = 0; st < 4; ++st) {
        const bf16x8 pf = __builtin_bit_cast(bf16x8, pw);
        bf16x8 vn[4];
        if (st < 3) {
#pragma unroll
            for (int db = 0; db < 4; ++db) vn[db] = *(const LAS bf16x8*)(unsigned long)(slot + 16384 + vrow[db] + ((unsigned)(32 * (st + 1) + 16 * hi) ^ vswz[db])); }
        __builtin_amdgcn_sched_barrier(0);
#pragma unroll
        for (int db = 0; db < 4; ++db) o[db] = __builtin_amdgcn_mfma_f32_32x32x16_bf16(vf[db], pf, o[db], 0, 0, 0);
        if (st < 3) { EXPPACK(st + 1);
#pragma unroll
            for (int db = 0; db < 4; ++db) vf[db] = vn[db]; } }
#undef EXPPACK
    l += s;
}
__device__ __forceinline__ void diff_unit(LAS unsigned char* lds, const bf16_t* PROJ, const bf16_t* VT, bf16_t* YD, const float* subg, float lam, const unsigned* kmax2, int b, int h, int i) {
    int tid = threadIdx.x; asm volatile("" : "+v"(tid)); const int lane = tid & 63, wid = __builtin_amdgcn_readfirstlane(tid >> 6), ql = lane & 31, hi = lane >> 5, c = wid >> 2, w4 = wid & 3;
    const int qw0 = 128 * i + 32 * w4, qpos = qw0 + ql;
    const size_t rowbase = (size_t)b * SEQ;
    constexpr unsigned SLOT = 32768;
    const unsigned lds0 = (unsigned)(unsigned long)lds;
    LAS unsigned* flags = (LAS unsigned*)(lds + LDS_FLAG_OFF);
    if (lane == 0) { flags[wid] = 0u; flags[8 + wid] = 0u; }
    bool wdone = false;
    const int R = 8 * wid + (lane >> 3), cp = lane & 7;
    const unsigned voffK = (unsigned)(R * NPROJ + 8 * (cp ^ swz7(R))) * 2u;
    const unsigned voffV0 = (unsigned)(R * T + 8 * (cp ^ swz7(R))) * 2u, voffV1 = (unsigned)((R + 64) * T + 8 * (cp ^ swz7(R + 64))) * 2u;
    const char* Kbase = (const char*)(PROJ + rowbase * NPROJ + PC_KD + h * 128);
    const char* Vbase = (const char*)(VT + (size_t)(256 + h * 128) * T + rowbase);
    const unsigned pdst = lds0 + (unsigned)wid * 1024u;
#define DIFF_DMA(t, so) do { const char* kb_ = Kbase + (size_t)(t) * (64 * NPROJ * 2); const char* vb_ = Vbase + (size_t)(t) * 128; \
        pg8::glds16_s(kb_, voffK, pdst + (so)); pg8::glds16_s(kb_ + 128, voffK, pdst + (so) + 8192u); \
        pg8::glds16_s(vb_, voffV0, pdst + (so) + 16384u); pg8::glds16_s(vb_, voffV1, pdst + (so) + 24576u); } while (0)
    unsigned krow[2], kswz[2], vrow[4], vswz[4];
#pragma unroll
    for (int j = 0; j < 2; ++j) { const int row = 32 * j + pi32(ql); krow[j] = (unsigned)row * 128u; kswz[j] = (unsigned)swz7(row) * 16u; }
#pragma unroll
    for (int db = 0; db < 4; ++db) { const int row = 32 * db + ql; vrow[db] = (unsigned)row * 128u; vswz[db] = (unsigned)swz7(row) * 16u; }
    const float slope2 = __builtin_amdgcn_exp2f(-(float)(h + 1)) * LOG2E;
    f32x16 o[4]; float l = 0.f, mtot = 0.f;
#pragma unroll
    for (int db = 0; db < 4; ++db) o[db] = f32x16{};
    const int thi = 2 * i + 1;
    DIFF_DMA(thi, 0u);
    DIFF_DMA(thi - 1, SLOT);
    bf16x8 qf[4];
    { const bf16_t* Qp = PROJ + (rowbase + qpos) * NPROJ + PC_QD + h * 128 + c * 64 + 8 * hi;
#pragma unroll
      for (int ds = 0; ds < 4; ++ds) qf[ds] = *(const bf16x8*)(Qp + 16 * ds); }
    unsigned kmx_bits = __hip_atomic_load(kmax2 + (b * 8 + h) * 2 + c, __ATOMIC_RELAXED, __HIP_MEMORY_SCOPE_AGENT);
    asm volatile("s_waitcnt vmcnt(0)" ::: "memory");
    asm volatile("" : "+v"(qf[0]), "+v"(qf[1]), "+v"(qf[2]), "+v"(qf[3]), "+v"(kmx_bits));
    const float kmx = sqrtf(__uint_as_float(kmx_bits)) * 1.001f;
    float qk_bound;
    { float s2 = 0.f;
#pragma unroll
      for (int ds = 0; ds < 4; ++ds) { const u32x4 w = __builtin_bit_cast(u32x4, qf[ds]);
#pragma unroll
          for (int e = 0; e < 4; ++e) { const float a = bf_lo(w[e]), b2 = bf_hi(w[e]); s2 += a * a + b2 * b2; } }
      qk_bound = sqrtf(psum(s2)) * 1.001f * kmx; }
    unsigned so = 0u; bool first = true;
    if (wid >= 4) __builtin_amdgcn_s_setprio(1);
    for (int t = thi; t >= 0; --t) {
        if (t >= 1) asm volatile("s_waitcnt vmcnt(4) lgkmcnt(0)\n\ts_barrier" ::: "memory"); else asm volatile("s_waitcnt vmcnt(0) lgkmcnt(0)\n\ts_barrier" ::: "memory");
        { const LAS unsigned* fs = flags + ((t + 1) & 1) * 8; const u32x4 f0 = *(const LAS u32x4*)fs, f1 = *(const LAS u32x4*)(fs + 4);
          if ((f0.x & f0.y & f0.z & f0.w & f1.x & f1.y & f1.z & f1.w) != 0u) break; }
        if (t >= 2) { const unsigned sn = so >= SLOT ? so - SLOT : so + 2 * SLOT; DIFF_DMA(t - 2, sn); }
        const int kbase = 64 * t;
        if (kbase <= qw0 + 31 && !wdone) {
            tile_compute_sw<1>(lds0 + so, c, krow, kswz, vrow, vswz, qf, slope2, o, l, mtot, first, kbase + 63 > qw0, qpos, kbase, lane);
            first = false;
            const float emax = qk_bound - slope2 * (float)(qpos - kbase + 1) - mtot;
            if (__all(emax < -127.0f)) wdone = true;
        }
        if (lane == 0) flags[(t & 1) * 8 + wid] = wdone ? 1u : 0u;
        so = so >= 2 * SLOT ? 0u : so + SLOT;
    }
    asm volatile("s_waitcnt vmcnt(0)" ::: "memory");
#undef DIFF_DMA
    __builtin_amdgcn_s_setprio(0);
    const float inv = 1.0f / psum(l);
    __syncthreads();
    LAS float* X = (LAS float*)lds + w4 * 4096;
    if (c == 1) {
#pragma unroll
        for (int db = 0; db < 4; ++db)
#pragma unroll
            for (int r = 0; r < 16; ++r) X[(db * 16 + r) * 64 + lane] = o[db][r] * inv;
    }
    __syncthreads();
    if (c == 0) {
        float ss = 0.f;
#pragma unroll
        for (int db = 0; db < 4; ++db)
#pragma unroll
            for (int r = 0; r < 16; ++r) { const float d = o[db][r] * inv - lam * X[(db * 16 + r) * 64 + lane]; o[db][r] = d; ss += d * d; }
        ss = psum(ss);
        const float rstd = 0.8f / sqrtf(ss * (1.0f / 128.0f) + RMS_EPS);
        bf16_t* yp = YD + (rowbase + qpos) * 1024 + h * 128 + 4 * hi;
#pragma unroll
        for (int db = 0; db < 4; ++db)
#pragma unroll
            for (int g4 = 0; g4 < 4; ++g4) { const f32x4 g = *(const f32x4*)(subg + 32 * db + 8 * g4 + 4 * hi);
                u32x2 w; w.x = pk2(o[db][4 * g4] * rstd * g[0], o[db][4 * g4 + 1] * rstd * g[1]); w.y = pk2(o[db][4 * g4 + 2] * rstd * g[2], o[db][4 * g4 + 3] * rstd * g[3]);
                *(u32x2*)(yp + 32 * db + 8 * g4) = w; }
    }
    __syncthreads();
}

__device__ __forceinline__ void swa_unit(LAS unsigned char* lds, const bf16_t* PROJ, const bf16_t* VT, bf16_t* YA, const float* sinks, int b, int hk, int i) {
    int tid = threadIdx.x; asm volatile("" : "+v"(tid)); const int lane = tid & 63, wid = __builtin_amdgcn_readfirstlane(tid >> 6), ql = lane & 31, hi = lane >> 5;
    const int hq = hk * 4 + (wid >> 1), qw0 = 64 * i + 32 * (wid & 1), qpos = qw0 + ql;
    const size_t rowbase = (size_t)b * SEQ;
    constexpr int BUF = 18432, VOFF = 9216;
    bf16x8 qf[4];
    { const bf16_t* Qp = PROJ + (rowbase + qpos) * NPROJ + PC_QA + hq * 64 + 8 * hi;
#pragma unroll
      for (int ds = 0; ds < 4; ++ds) qf[ds] = *(const bf16x8*)(Qp + 16 * ds); }
    const int krow = tid >> 3, kch = tid & 7;
    const bf16_t* Kg = PROJ + (rowbase + krow) * NPROJ + PC_KA + hk * 64 + kch * 8;
    const bf16_t* Vg = VT + (size_t)(hk * 64 + krow) * T + rowbase + kch * 8;
    const int sdst = (krow * 72 + kch * 8) * 2;
    const float slope2 = __builtin_amdgcn_exp2f(-0.5f * (float)(hq + 1)) * LOG2E;
    f32x16 cin[2], o[2]; float l = 0.f, mtot = 0.f;
    o[0] = f32x16{}; o[1] = f32x16{};
    u32x4 sk, sv;
    const int thi = i, tlo = i >= 2 ? i - 2 : 0;
    sk = *(const u32x4*)(Kg + (size_t)thi * 64 * NPROJ); sv = *(const u32x4*)(Vg + thi * 64);
    int bo = 0; bool first = true;
    for (int t = thi; t >= tlo; --t) {
        *(LAS u32x4*)(lds + bo + sdst) = sk; *(LAS u32x4*)(lds + bo + VOFF + sdst) = sv;
        __syncthreads();
        if (t > tlo) { sk = *(const u32x4*)(Kg + (size_t)(t - 1) * 64 * NPROJ); sv = *(const u32x4*)(Vg + (t - 1) * 64); }
        const int kbase = 64 * t;
        if (first) cin_init<true>(cin, slope2, kbase, qpos, hi);
        tile_compute<64, 64, 2>((const LAS bf16_t*)(lds + bo), (const LAS bf16_t*)(lds + bo + VOFF), qf, cin, o, l, mtot, first, true, qpos, kbase, lane);
        first = false;
        const float step = 64.f * slope2;
#pragma unroll
        for (int j = 0; j < 2; ++j)
#pragma unroll
            for (int r = 0; r < 16; ++r) cin[j][r] -= step;
        bo ^= BUF;
    }
    const float lt = psum(l), sink2 = sinks[hq] * LOG2E, M = fmaxf(mtot, sink2), f = __builtin_amdgcn_exp2f(mtot - M);
    const float sc = f / (lt * f + __builtin_amdgcn_exp2f(sink2 - M));
    bf16_t* yp = YA + (rowbase + qpos) * 1024 + hq * 64 + 4 * hi;
#pragma unroll
    for (int db = 0; db < 2; ++db)
#pragma unroll
        for (int g4 = 0; g4 < 4; ++g4) { u32x2 w; w.x = pk2(o[db][4 * g4] * sc, o[db][4 * g4 + 1] * sc); w.y = pk2(o[db][4 * g4 + 2] * sc, o[db][4 * g4 + 3] * sc);
            *(u32x2*)(yp + 32 * db + 8 * g4) = w; }
    __syncthreads();
}

__device__ __forceinline__ void cross_unit(LAS unsigned char* lds, const bf16_t* QC, const bf16_t* KM, const bf16_t* VMT, bf16_t* OC, int b, int h, int i) {
    int tid = threadIdx.x; asm volatile("" : "+v"(tid)); const int lane = tid & 63, wid = __builtin_amdgcn_readfirstlane(tid >> 6), ql = lane & 31, hi = lane >> 5;
    const int qpos = 256 * i + 32 * wid + ql;
    const size_t rowbase = (size_t)b * SEQ;
    constexpr int BUF = 35840, VOFF = 17408;
    bf16x8 qf[8];
    { const bf16_t* Qp = QC + (rowbase + qpos) * 512 + h * 128 + 8 * hi;
#pragma unroll
      for (int ds = 0; ds < 8; ++ds) qf[ds] = *(const bf16x8*)(Qp + 16 * ds); }
    const int kr0 = tid >> 4, kc0 = tid & 15, vr0 = tid >> 3, vc0 = tid & 7;
    const bf16_t* Kg = KM + (size_t)(b * 256 + kr0) * 512 + h * 128 + kc0 * 8;
    const bf16_t* Vg = VMT + (size_t)(h * 128 + vr0) * 512 + b * 256 + vc0 * 8;
    const int kdst = (kr0 * 136 + kc0 * 8) * 2, vdst = (vr0 * 72 + vc0 * 8) * 2;
    f32x16 cin[2], o[4]; float l = 0.f, mtot = 0.f;
#pragma unroll
    for (int db = 0; db < 4; ++db) o[db] = f32x16{};
    cin_init<false>(cin, 0.f, 0, 0, 0);
    u32x4 sk0, sk1, sv0, sv1;
#define CR_LOAD(t) do { sk0 = *(const u32x4*)(Kg + (size_t)(t) * 64 * 512); sk1 = *(const u32x4*)(Kg + (size_t)((t) * 64 + 32) * 512); \
        sv0 = *(const u32x4*)(Vg + (t) * 64); sv1 = *(const u32x4*)(Vg + (size_t)64 * 512 + (t) * 64); } while (0)
    CR_LOAD(3);
    int bo = 0; bool first = true;
    for (int t = 3; t >= 0; --t) {
        *(LAS u32x4*)(lds + bo + kdst) = sk0; *(LAS u32x4*)(lds + bo + kdst + 32 * 136 * 2) = sk1;
        *(LAS u32x4*)(lds + bo + VOFF + vdst) = sv0; *(LAS u32x4*)(lds + bo + VOFF + vdst + 64 * 72 * 2) = sv1;
        __syncthreads();
        if (t > 0) CR_LOAD(t - 1);
        tile_compute<128, 128, 0>((const LAS bf16_t*)(lds + bo), (const LAS bf16_t*)(lds + bo + VOFF), qf, cin, o, l, mtot, first, false, qpos, 64 * t, lane);
        first = false;
        bo ^= BUF;
    }
#undef CR_LOAD
    const float inv = 1.0f / psum(l);
    bf16_t* yp = OC + (rowbase + qpos) * 512 + h * 128 + 4 * hi;
#pragma unroll
    for (int db = 0; db < 4; ++db)
#pragma unroll
        for (int g4 = 0; g4 < 4; ++g4) { u32x2 w; w.x = pk2(o[db][4 * g4] * inv, o[db][4 * g4 + 1] * inv); w.y = pk2(o[db][4 * g4 + 2] * inv, o[db][4 * g4 + 3] * inv);
            *(u32x2*)(yp + 32 * db + 8 * g4) = w; }
    __syncthreads();
}
}

constexpr int NPHASES = 14;
struct Args { const float* in[25]; float* out; unsigned char* ws; int ph_lo, ph_hi; };

__global__ void __launch_bounds__(NTHR, 2) mk_fwd(Args args) {
    extern __shared__ __attribute__((aligned(16))) unsigned char lds_raw[];
    Frame F;
    F.lds = (LAS unsigned char*)lds_raw;
    F.wave = __builtin_amdgcn_readfirstlane(threadIdx.x >> 6);
    F.G = gridDim.x; { const int bx = blockIdx.x; F.vcu = (F.G % 8 == 0) ? (bx % 8) * (F.G / 8) + bx / 8 : bx; }
    F.ws = args.ws; F.ctl = (unsigned*)(args.ws + WS_CTL); F.out = args.out;
    volatile LAS unsigned* MISC = (volatile LAS unsigned*)(F.lds + LDS_MISC_OFF);
    if (threadIdx.x < 64) MISC[threadIdx.x] = 0u;
    __syncthreads();
    XcdBarrier bar; bar.bar = F.ctl + CW_BAR; bar.x = 0; bar.st = nullptr;
    const int lo = args.ph_lo, hi = args.ph_hi;
    if (hi - lo > 1) bar = xcd_barrier_post(F.ctl + CW_BAR, MISC + 8);
#define IN(k) (lo <= (k) && (k) < hi)
#define SEAM(k) do { if (IN(k) && IN((k) + 1)) xcd_barrier(bar); } while (0)
    LAS unsigned char* lds = F.lds;
    const int bid = blockIdx.x;
    bf16_t* XN = WSP(bf16_t, WS_XN); bf16_t* PROJ = WSP(bf16_t, WS_PROJ); bf16_t* VT = WSP(bf16_t, WS_VT); bf16_t* YA = WSP(bf16_t, WS_YA); bf16_t* YD = WSP(bf16_t, WS_YD);
    bf16_t* MERGED = WSP(bf16_t, WS_MERGED); bf16_t* H = WSP(bf16_t, WS_H); bf16_t* MEMN = WSP(bf16_t, WS_MEMN); bf16_t* KM = WSP(bf16_t, WS_KM); bf16_t* VMT = WSP(bf16_t, WS_VMT);
    bf16_t* QC = WSP(bf16_t, WS_QC); bf16_t* OC = WSP(bf16_t, WS_OC);

    if (IN(0)) { p0_prologue(F); }
    SEAM(0);
    if (IN(1)) {
        const pg8::Gemm g{DM, (size_t)128 * DM * 2};
        pg8::ProjOrder S{XN, WSP(bf16_t, WS_WIN), MEMN, WSP(bf16_t, WS_WCKV), F.G, bid}; pg8::EpiProjAll E{PROJ, VT, KM, VMT};
        pg8::gemm_phase<pg8::EpiProjAll, pg8::ProjOrder, true, true>(lds, g, S, E);
        { const pg8::Gemm g8{DM / 2, (size_t)128 * DM};
          pg8::StaticOrder S8; S8.init(WSP(bf16_t, WS_XN8), WSP(bf16_t, WS_WING8), T, 4096, DM / 2, F.G, bid); pg8::EpiGate E8{WSP(unsigned char, WS_G8)};
          pg8::gemm_phase<pg8::EpiGate, pg8::StaticOrder, true, true, true>(lds, g8, S8, E8); }
    }
    if (IN(1) && IN(2)) conv_filler<8>(F, 1);
    SEAM(1);
    if (IN(2)) {
        { int l_ = threadIdx.x; asm volatile("" : "+v"(l_)); l_ &= 63; float mx0 = 0.f, mx1 = 0.f;
          const int rs = F.G * NWAVES;
          for (int r = F.vcu * NWAVES + F.wave; r < T; r += 4 * rs) {
              u32x4 w0[4], w1[4];
#pragma unroll
              for (int q = 0; q < 4; ++q) { const int rq = r + q * rs; const u32x4* kp = (const u32x4*)(PROJ + (size_t)(rq < T ? rq : r) * NPROJ + PC_KD + 16 * l_); w0[q] = kp[0]; w1[q] = kp[1]; }
#pragma unroll
              for (int q = 0; q < 4; ++q) { const int rq = r + q * rs; float s2 = 0.f;
#pragma unroll
                  for (int e = 0; e < 4; ++e) { const float a0 = bf_lo(w0[q][e]), a1 = bf_hi(w0[q][e]), a2 = bf_lo(w1[q][e]), a3 = bf_hi(w1[q][e]); s2 += (a0 * a0 + a1 * a1) + (a2 * a2 + a3 * a3); }
                  s2 += __shfl_xor(s2, 1); s2 += __shfl_xor(s2, 2);
                  if (rq < T) { if (rq < SEQ) mx0 = fmaxf(mx0, s2); else mx1 = fmaxf(mx1, s2); } } }
          if ((l_ & 3) == 0) { atomicMax(F.ctl + CW_KMAX + (l_ >> 2), __float_as_uint(mx0)); atomicMax(F.ctl + CW_KMAX + 16 + (l_ >> 2), __float_as_uint(mx1)); } }
        asm volatile("s_waitcnt vmcnt(0)" ::: "memory");
        __syncthreads();
        if (threadIdx.x == 0) __hip_atomic_fetch_add(F.ctl + CW_KDONE, 1u, __ATOMIC_RELAXED, __HIP_MEMORY_SCOPE_AGENT);
        for (int n = F.vcu; n < 1024; n += F.G) { const int i = n & 127, bhk = n >> 7; att::swa_unit(lds, PROJ, VT, YA, fin(4), bhk >> 2, bhk & 3, i); }
        if (threadIdx.x == 0) { while (__hip_atomic_load(F.ctl + CW_KDONE, __ATOMIC_RELAXED, __HIP_MEMORY_SCOPE_AGENT) < (unsigned)F.G) __builtin_amdgcn_s_sleep(4); }
        __syncthreads();
        float lam;
        { int l_ = threadIdx.x; asm volatile("" : "+v"(l_)); l_ &= 63; const float a = fin(5)[l_] * fin(6)[l_], b2 = fin(7)[l_] * fin(8)[l_];
          lam = __expf(wave_sum(a)) - __expf(wave_sum(b2)) + 0.2f; }
        { LAS int* qs = (LAS int*)(lds + LDS_FLAG_OFF + 128); LAS int* cost = qs + 32; LAS int* order = cost + 128;
          const int nq = (F.G % 8 == 0 && F.G >= 8) ? 8 : 1, x0 = (nq == 8) ? F.vcu / (F.G / 8) : 0, per = 1024 / nq;
          for (int qi = 0; qi < 1; ++qi) {
              const int x = (x0 + qi) % nq;
              __syncthreads();
              for (int u = threadIdx.x; u < per && nq == 8; u += NTHR) {
                  const int bh = (x >> 2) * 8 + ((u >> 6) ? 7 - (x & 3) : (x & 3)), i = u & 63;
                  const float s2 = __builtin_amdgcn_exp2f(-(float)((bh & 7) + 1)) * LOG2E; const int cut = (int)(146.0f / (s2 * 64.0f)) + 3;
                  const int c0 = 2 * i + 2; cost[u] = c0 < cut ? c0 : cut; }
              __syncthreads();
              if (nq == 8 && threadIdx.x < 128) { const int me = cost[threadIdx.x]; int r = 0; for (int u = 0; u < 128; ++u) { const int cu = cost[u]; r += (cu > me || (cu == me && u < (int)threadIdx.x)) ? 1 : 0; } order[r] = threadIdx.x; }
              int nxt = 0;
              if (threadIdx.x == 0) qs[0] = (int)atomicAdd(F.ctl + CW_QHEAD + 64 * x, 1u);
              __syncthreads();
              int n = qs[0];
              while (n < per) {
                  if (threadIdx.x == 0) nxt = (int)atomicAdd(F.ctl + CW_QHEAD + 64 * x, 1u);
                  int bh, i;
                  if (nq == 8) { const int u = order[n]; bh = (x >> 2) * 8 + ((u >> 6) ? 7 - (x & 3) : (x & 3)); i = u & 63; } else { bh = n & 15; i = 63 - (n >> 4); }
                  att::diff_unit(lds, PROJ, VT, YD, fin(9), lam, F.ctl + CW_KMAX, bh >> 3, bh & 7, i);
                  if (threadIdx.x == 0) qs[0] = nxt;
                  __syncthreads();
                  n = qs[0];
              }
          } }
    }
    if (IN(2) && IN(3)) conv_filler<4>(F, 2);
    SEAM(2);
    if (IN(3)) {
        const pg8::Gemm g{1024, (size_t)128 * 1024 * 2};
        pg8::BranchOrder S{YA, YD, WSP(bf16_t, WS_WB), F.G, bid}; pg8::EpiBranchAll E{WSP(unsigned char, WS_G8), MERGED};
        pg8::gemm_phase<pg8::EpiBranchAll, pg8::BranchOrder, true, true>(lds, g, S, E);
    }
    SEAM(3);
    if (IN(4)) {
        const pg8::Gemm g{DM, (size_t)128 * DM * 2};
        pg8::StaticOrder S; S.init(MERGED, WSP(bf16_t, WS_WO), T, DM, DM, F.G, bid); pg8::EpiResid<false> E{fin(0), H};
        pg8::gemm_phase<pg8::EpiResid<false>, pg8::StaticOrder, true, true>(lds, g, S, E);
    }
    SEAM(4);
    if (IN(5)) { rows_rstd_phase(F, H, WSP(float, WS_ROWSQP), F.ctl + CW_RSC, T); }
    if (IN(6)) {
        const pg8::Gemm g{DM, (size_t)128 * DM * 2};
        pg8::StaticOrder S; S.init(H, WSP(bf16_t, WS_WCQ), T, 512, DM, F.G, bid); pg8::EpiRowScale E{QC, 512, C2_128, WSP(float, WS_ROWSQP), F.ctl + CW_RSC};
        pg8::gemm_phase<pg8::EpiRowScale, pg8::StaticOrder, true, true>(lds, g, S, E);
    }
    if (IN(6) && IN(7)) conv_filler<8>(F, 6);
    SEAM(6);
    if (IN(7)) {
        for (int n = F.vcu; n < 256; n += F.G) att::cross_unit(lds, QC, KM, VMT, OC, n >> 7, (n >> 5) & 3, n & 31);
    }
    SEAM(7);
    if (IN(8)) {
        const pg8::Gemm g{512, (size_t)128 * 512 * 2};
        pg8::StaticOrder S; S.init(OC, WSP(bf16_t, WS_WCO), T, DM, 512, F.G, bid); pg8::EpiResid<true> E{H, H};
        pg8::gemm_phase<pg8::EpiResid<true>, pg8::StaticOrder, true, true>(lds, g, S, E);
    }
    SEAM(8);
    if (IN(9)) { route_r1(F); }
    SEAM(9);
    if (IN(10)) { route_r2(F); conv_filler<16>(F, -1); }
    SEAM(10);
    if (IN(11)) {
        const int ntiles = moe_tile_table(F);
        const pg8::Gemm g{DM / 2, (size_t)DFF * DM};
        pg8::MoeOrder<true> S{WSP(void, WS_XN), WSP(void, WS_WGU), (const LAS int*)(F.lds + LDS_TAB_OFF), ntiles, 16, F.G, F.vcu, (size_t)256 * DM, (size_t)2 * DFF * DM, (size_t)128 * DM, WSP(unsigned short, WS_ROWTOK)};
        pg8::EpiGlu E{fin(21), WSP(unsigned char, WS_ACT)};
        pg8::gemm_phase<pg8::EpiGlu, pg8::MoeOrder<true>, true, true, true>(lds, g, S, E);
    }
    SEAM(11);
    if (IN(12)) {
        const int ntiles = moe_tile_table(F);
        const pg8::Gemm g{DFF / 2, (size_t)128 * DFF};
        pg8::MoeOrder<false> S{WSP(void, WS_ACT), WSP(void, WS_WD), (const LAS int*)(F.lds + LDS_TAB_OFF), ntiles, 8, F.G, F.vcu, (size_t)256 * DFF, (size_t)DM * DFF, (size_t)256 * DFF, nullptr};
        pg8::EpiDown E{fin(23), WSP(int, WS_ROWSLOT), WSP(float, WS_ROWW), WSP(unsigned char, WS_MOEOUT)};
        pg8::gemm_phase<pg8::EpiDown, pg8::MoeOrder<false>, true, true, true>(lds, g, S, E);
    }
    SEAM(12);
    if (IN(13)) { final_phase(F); }
#undef IN
#undef SEAM
}

extern "C" void kernel_launch(void* const* d_in, const int* in_sizes, int n_in, void* d_out, int out_size, void* d_ws, size_t ws_size, hipStream_t stream) {
    static int grid = 0;
    if (grid == 0) {
        if (n_in != 25 || out_size != T * DM || ws_size < WS_END) { fprintf(stderr, "kernel_launch: unexpected shapes (n_in %d out %d ws %zu need %zu)\n", n_in, out_size, ws_size, (size_t)WS_END); grid = -1; return; }
        int dev = 0, cus = 0, per_cu = 0;
        if (hipGetDevice(&dev) != hipSuccess || hipDeviceGetAttribute(&cus, hipDeviceAttributeMultiprocessorCount, dev) != hipSuccess) { grid = -1; return; }
        if (hipFuncSetAttribute((const void*)mk_fwd, hipFuncAttributeMaxDynamicSharedMemorySize, LDS_BYTES) != hipSuccess) { fprintf(stderr, "kernel_launch: hipFuncSetAttribute failed\n"); grid = -1; return; }
        if (hipOccupancyMaxActiveBlocksPerMultiprocessor(&per_cu, (const void*)mk_fwd, NTHR, LDS_BYTES) != hipSuccess || per_cu < 1) { fprintf(stderr, "kernel_launch: occupancy query says %d\n", per_cu); (void)hipGetLastError(); }
        grid = cus;
    }
    if (grid < 0) return;
    (void)hipMemsetAsync((char*)d_ws + WS_CTL, 0, CTL_ZERO_BYTES, stream);
    Args a{};
    for (int i = 0; i < 25; ++i) a.in[i] = (const float*)d_in[i];
    a.out = (float*)d_out; a.ws = (unsigned char*)d_ws;
    a.ph_lo = 0; a.ph_hi = NPHASES;
    hipLaunchKernelGGL(mk_fwd, dim3(grid), dim3(NTHR), LDS_BYTES, stream, a);
}
```

```cpp
#include <hip/hip_runtime.h>
#include <cstdio>
#include <cstdint>

#define LAS __attribute__((address_space(3)))
#define GAS __attribute__((address_space(1)))
typedef unsigned short bf16_t;
typedef short bf16x8 __attribute__((ext_vector_type(8)));
typedef float f32x4 __attribute__((ext_vector_type(4)));
typedef float f32x2 __attribute__((ext_vector_type(2)));
typedef float f32x16 __attribute__((ext_vector_type(16)));
typedef unsigned u32x4 __attribute__((ext_vector_type(4)));
typedef unsigned u32x2 __attribute__((ext_vector_type(2)));

constexpr int BATCH = 2, SEQ = 8192, T = BATCH * SEQ, DM = 2048;
constexpr int NPROJ = 7424;
constexpr int PC_QA = 0, PC_KA = 1024, PC_QD = 1280, PC_KD = 2304, PC_G = 3328;
constexpr int NVT = 1280;
constexpr int NE = 32, TOPK = 4, DFF = 2048;
constexpr int XROWS = 73728;
constexpr int MAXTILES = XROWS / 256;
constexpr float RMS_EPS = 1e-5f;
constexpr float LOG2E = 1.4426950408889634f;
constexpr float C2_64 = 0.125f * LOG2E;
constexpr float C2_128 = 0.08838834764831845f * LOG2E;

constexpr size_t MiB = 1u << 20;
constexpr size_t WS_CTL = 0, CTL_ZERO_BYTES = 1 * MiB;
constexpr size_t WS_WIN = 2 * MiB;
constexpr size_t WS_WB = WS_WIN + 34 * MiB;
constexpr size_t WS_WO = WS_WB + 8 * MiB;
constexpr size_t WS_WCQ = WS_WO + 8 * MiB;
constexpr size_t WS_WCKV = WS_WCQ + 2 * MiB;
constexpr size_t WS_WCO = WS_WCKV + 4 * MiB;
constexpr size_t WS_WGU = WS_WCO + 2 * MiB;
constexpr size_t WS_WD = WS_WGU + 512 * MiB;
constexpr size_t WS_XN = WS_WD + 256 * MiB;
constexpr size_t WS_PROJ = WS_XN + 64 * MiB;
constexpr size_t WS_VT = WS_PROJ + 232 * MiB;
constexpr size_t WS_YA = WS_VT + 40 * MiB;
constexpr size_t WS_YD = WS_YA + 32 * MiB;
constexpr size_t WS_MERGED = WS_YD + 32 * MiB;
constexpr size_t WS_H = WS_MERGED + 64 * MiB;
constexpr size_t WS_MEMN = WS_H + 128 * MiB;
constexpr size_t WS_KM = WS_MEMN + 2 * MiB;
constexpr size_t WS_VMT = WS_KM + 1 * MiB;
constexpr size_t WS_QC = WS_VMT + 1 * MiB;
constexpr size_t WS_OC = WS_QC + 16 * MiB;
constexpr size_t WS_TOPI = WS_OC + 16 * MiB;
constexpr size_t WS_TOPW = WS_TOPI + 1 * MiB;
constexpr size_t WS_ROWSLOT = WS_TOPW + 1 * MiB;
constexpr size_t WS_ROWW = WS_ROWSLOT + 1 * MiB;
constexpr size_t WS_XG = WS_ROWW + 1 * MiB;
constexpr size_t WS_ACT = WS_XG + 288 * MiB;
constexpr size_t WS_MOEOUT = WS_ACT + 288 * MiB;
constexpr size_t WS_ROWSQP = WS_MOEOUT + 256 * MiB;
constexpr size_t WS_WING8 = WS_ROWSQP + 2 * MiB;
constexpr size_t WS_XN8 = WS_WING8 + 8 * MiB;
constexpr size_t WS_G8 = WS_XN8 + 32 * MiB;
constexpr size_t WS_WRT = WS_G8 + 64 * MiB;
constexpr size_t WS_ROWTOK = WS_WRT + 1 * MiB;
constexpr size_t WS_END = WS_ROWTOK + 1 * MiB;
constexpr int CW_CNT = 64;
constexpr int CW_CUR = 128;
constexpr int CW_QHEAD = 1024;
constexpr int CW_KMAX = 192;
constexpr int CW_KDONE = 448;
constexpr int CW_RSC = 16384;
constexpr int CW_CONV = 1920;
constexpr int CW_DONE = 2048;
constexpr int CW_BAR = 4096;

constexpr int RING_BYTES = 131072;
constexpr int LDS_FLAG_OFF = 131072;
constexpr int LDS_TAB_OFF = 134144;
constexpr int LDS_MISC_OFF = 136192;
constexpr int LDS_BYTES = 147456;
constexpr int NWAVES = 8, NTHR = 512;

__device__ __forceinline__ unsigned f2bf(float f) { unsigned u = __builtin_bit_cast(unsigned, f); return (u + 0x7fffu + ((u >> 16) & 1u)) >> 16; }
__device__ __forceinline__ unsigned pk2(float lo, float hi) { typedef __bf16 bf2 __attribute__((ext_vector_type(2))); f32x2 v = {lo, hi}; bf2 b = __builtin_convertvector(v, bf2); return __builtin_bit_cast(unsigned, b); }
__device__ __forceinline__ float bf_lo(unsigned w) { return __builtin_bit_cast(float, w << 16); }
__device__ __forceinline__ float bf_hi(unsigned w) { return __builtin_bit_cast(float, w & 0xffff0000u); }
__device__ __forceinline__ float wave_sum(float v) {
#pragma unroll
    for (int o = 1; o < 64; o <<= 1) v += __shfl_xor(v, o);
    return v;
}
#define LDS_WAIT() asm volatile("s_waitcnt lgkmcnt(0)" ::: "memory")
#define VM_WAIT() asm volatile("s_waitcnt vmcnt(0)" ::: "memory")
namespace pg8 {
#define PG8_LAS __attribute__((address_space(3)))
constexpr int BM = 256, BK = 64, HALF = 128, HTB = HALF * BK * 2  , STAGE_BYTES = 8 * HTB, NXCD = 8, WGM = 4;

__host__ __device__ __forceinline__ int lds_byte(int r, int c) { const int st = (r >> 4) * 2 + (c >> 5), rr = r & 15, cc = c & 31, ob = rr * 64 + cc * 2; return st * 1024 + (ob ^ (((ob >> 9) & 1) << 5)); }
__host__ __device__ __forceinline__ void stage_rc(int b, int& R, int& C) { const int st = b / 1024, sb = b % 1024, swz = sb ^ (((sb >> 9) & 1) << 5); R = (st >> 1) * 16 + swz / 64; C = (st & 1) * 32 + (swz % 64) / 2; }
__host__ __device__ __forceinline__ int perm32(int rho) { const int n = rho >> 4, i = rho & 15; return 8 * (i >> 2) + 4 * n + (i & 3); }

typedef int v8i_t __attribute__((ext_vector_type(8)));
__device__ __forceinline__ v8i_t cat16(bf16x8 a, bf16x8 b) { typedef int v4i_t __attribute__((ext_vector_type(4))); const v4i_t x = __builtin_bit_cast(v4i_t, a), y = __builtin_bit_cast(v4i_t, b); return (v8i_t){x[0], x[1], x[2], x[3], y[0], y[1], y[2], y[3]}; }
__device__ __forceinline__ void glds16_s(const char* sbase, unsigned voff, unsigned ldsdst) {
    unsigned keep;
    asm volatile("s_mov_b32 %0, m0\n\ts_mov_b32 m0, %3\n\ts_nop 2\n\tglobal_load_lds_dwordx4 %1, %2\n\ts_mov_b32 m0, %0" : "=&s"(keep) : "v"(voff), "s"(sbase), "s"(ldsdst) : "memory");
}
struct Unit { int pm, pn, e; };
struct Gemm { int K; size_t bhstep; };

struct StaticOrder {
    static constexpr bool GATHER = false;
    const bf16_t* A; const bf16_t* Bt; int K;
    int nM, nN, nwg, G, c;
    __device__ void init(const bf16_t* A_, const bf16_t* Bt_, int M, int N, int K_, int G_, int c_) { A = A_; Bt = Bt_; K = K_; nM = M / BM; nN = N / BM; nwg = nM * nN; G = G_; c = c_; }
    __device__ bool next(int i, Unit& u) const {
        const long L = (long)i * G + c; if (L >= nwg) return false;
        int wgid = (int)L; { const int q = nwg / NXCD, r = nwg % NXCD, xcd = wgid % NXCD, off = wgid / NXCD; wgid = (xcd < r ? xcd * (q + 1) : r * (q + 1) + (xcd - r) * q) + off; }
        const int nig = WGM * nN, gid = wgid / nig, fm = gid * WGM, gsz = (nM - fm) < WGM ? (nM - fm) : WGM;
        u.pm = fm + ((wgid % nig) % gsz); u.pn = (wgid % nig) / gsz; u.e = 0; return true;
    }
    __device__ __forceinline__ void ptrs(const Unit& u, const char*& a, const char*& b) const {
        a = (const char*)A + (size_t)u.pm * (size_t)(BM * 2) * K; b = (const char*)Bt + (size_t)u.pn * (size_t)(BM * 2) * K; }
    __device__ __forceinline__ void a_ready(const Unit&) const {}
    __device__ __forceinline__ void done(const Unit&) const {}
};
__device__ __forceinline__ void grid_map(int L, int nM, int nN, int& pm, int& pn) {
    const int nwg = nM * nN; int wgid = L; { const int q = nwg / NXCD, r = nwg % NXCD, xcd = wgid % NXCD, off = wgid / NXCD; wgid = (xcd < r ? xcd * (q + 1) : r * (q + 1) + (xcd - r) * q) + off; }
    const int nig = WGM * nN, gid = wgid / nig, fm = gid * WGM, gsz = (nM - fm) < WGM ? (nM - fm) : WGM;
    pm = fm + ((wgid % nig) % gsz); pn = (wgid % nig) / gsz;
}
struct ProjOrder {
    static constexpr bool GATHER = false;
    const bf16_t* XN; const bf16_t* WIN; const bf16_t* MEMN; const bf16_t* WCKV; int G, c;
    static constexpr int N0 = 64 * 13, N1 = 5 * 64, N2 = 4, N3 = 4, NTOT = N0 + N1 + N2 + N3;
    __device__ bool next(int i, Unit& u) const {
        int L = i * G + c; if (L >= NTOT) return false;
        if (L < N0) { u.e = 0; grid_map(L, 64, 13, u.pm, u.pn); return true; } L -= N0;
        if (L < N1) { u.e = 1; grid_map(L, 5, 64, u.pm, u.pn); return true; } L -= N1;
        if (L < N2) { u.e = 2; u.pm = L >> 1; u.pn = L & 1; return true; } L -= N2;
        u.e = 3; u.pm = L >> 1; u.pn = L & 1; return true;
    }
    __device__ __forceinline__ void ptrs(const Unit& u, const char*& a, const char*& b) const {
        const size_t ts = (size_t)(BM * 2) * 2048;
        const bf16_t* A = u.e == 0 ? XN : (u.e == 1 ? WIN + (size_t)NPROJ * 2048 : (u.e == 2 ? MEMN : WCKV + (size_t)512 * 2048));
        const bf16_t* B = u.e == 0 ? WIN : (u.e == 1 ? XN : (u.e == 2 ? WCKV : MEMN));
        a = (const char*)A + (size_t)u.pm * ts; b = (const char*)B + (size_t)u.pn * ts; }
    __device__ __forceinline__ void a_ready(const Unit&) const {}
    __device__ __forceinline__ void done(const Unit&) const {}
};
struct BranchOrder {
    static constexpr bool GATHER = false;
    const bf16_t* YA; const bf16_t* YD; const bf16_t* WB; int G, c;
    __device__ bool next(int i, Unit& u) const {
        const int L = (i >> 1) * G + c; if (L >= 64 * 8) return false;
        u.e = i & 1; grid_map(L, 64, 8, u.pm, u.pn); return true;
    }
    __device__ __forceinline__ void ptrs(const Unit& u, const char*& a, const char*& b) const {
        const size_t ts = (size_t)(BM * 2) * 1024;
        a = (const char*)(u.e ? YD : YA) + (size_t)u.pm * ts; b = (const char*)(WB + (size_t)u.e * 2048 * 1024) + (size_t)u.pn * ts; }
    __device__ __forceinline__ void a_ready(const Unit&) const {}
    __device__ __forceinline__ void done(const Unit&) const {}
};
template <bool GATHER_>
struct MoeOrder {
    static constexpr bool GATHER = GATHER_;
    const void* A; const void* Bt; const PG8_LAS int* tile_e; int ntiles, nN, G, c; size_t a_tstride, b_estride, b_tstride;
    const unsigned short* rowtok;
    __device__ bool next(int i, Unit& u) const {
        if (G == 256) {
            const int x = c >> 5, w = c & 31, mpr = 256 / nN;
            const int m = (nN == 16) ? 4 * (x >> 1) + (w >> 3) : 4 * x + (w >> 3), n = (nN == 16) ? 8 * (x & 1) + (w & 7) : (w & 7);
            u.pm = i * mpr + m; u.pn = n; if (u.pm >= ntiles) return false;
        } else { const long L = (long)i * G + c; if (L >= (long)ntiles * nN) return false; u.pm = (int)(L / nN); u.pn = (int)(L % nN); }
        u.e = __builtin_amdgcn_readfirstlane(tile_e[u.pm]); return true;
    }
    __device__ __forceinline__ void ptrs(const Unit& u, const char*& a, const char*& b) const {
        a = GATHER_ ? (const char*)A : (const char*)A + (size_t)u.pm * a_tstride; b = (const char*)Bt + (size_t)u.e * b_estride + (size_t)u.pn * b_tstride; }
    __device__ __forceinline__ const unsigned short* rows(const Unit& u) const { return rowtok + u.pm * 256; }
    __device__ __forceinline__ void a_ready(const Unit&) const {}
    __device__ __forceinline__ void done(const Unit&) const {}
};

#define EPI_ROWS_BEGIN const int row0 = u.pm * BM + wr * 64 + fr; \
    _Pragma("unroll") for (int ai = 0; ai < 2; ++ai) _Pragma("unroll") for (int m = 0; m < 4; ++m) { const int row = row0 + ai * HALF + m * 16;
#define EPI_ROWS_END }
__device__ __forceinline__ u32x4 pack8(f32x4 v0, f32x4 v1) { u32x4 w; w.x = pk2(v0[0], v0[1]); w.y = pk2(v0[2], v0[3]); w.z = pk2(v1[0], v1[1]); w.w = pk2(v1[2], v1[3]); return w; }
__device__ __forceinline__ void unpack8(u32x4 w, f32x4& v0, f32x4& v1) { v0 = (f32x4){bf_lo(w.x), bf_hi(w.x), bf_lo(w.y), bf_hi(w.y)}; v1 = (f32x4){bf_lo(w.z), bf_hi(w.z), bf_lo(w.w), bf_hi(w.w)}; }
__device__ __forceinline__ float sigm(float x) { return __builtin_amdgcn_rcpf(1.0f + __builtin_amdgcn_exp2f(-LOG2E * x)); }

struct EpiPlain {
    static constexpr bool PERM = true, AFTER_DRAIN = false;
    bf16_t* O; int ldc; float scale;
    __device__ __forceinline__ void operator()(const f32x4 (&acc)[2][2][4][2], const Unit& u, int wr, int wc, int fr, int fq) const {
        const int col0 = u.pn * BM + wc * 32 + 8 * fq;
        EPI_ROWS_BEGIN
            bf16_t* rowp = O + (size_t)row * ldc + col0;
#pragma unroll
            for (int bj = 0; bj < 2; ++bj) *(u32x4*)(rowp + bj * HALF) = pack8(acc[ai][bj][m][0] * scale, acc[ai][bj][m][1] * scale);
        EPI_ROWS_END
    }
};
struct EpiRowScale {
    static constexpr bool PERM = true, AFTER_DRAIN = false;
    bf16_t* O; int ldc; float scale; const float* RS; const unsigned* rsc;
    __device__ __forceinline__ void operator()(const f32x4 (&acc)[2][2][4][2], const Unit& u, int wr, int wc, int fr, int fq) const {
        const int col0 = u.pn * BM + wc * 32 + 8 * fq;
        if (fr == 0 && fq == 0) { while (__hip_atomic_load(rsc + 32 * u.pm, __ATOMIC_RELAXED, __HIP_MEMORY_SCOPE_AGENT) < 256u) __builtin_amdgcn_s_sleep(4); }
        asm volatile("" ::: "memory");
        EPI_ROWS_BEGIN
            bf16_t* rowp = O + (size_t)row * ldc + col0;
            const float s = scale * __builtin_bit_cast(float, __hip_atomic_load((const unsigned*)RS + row, __ATOMIC_RELAXED, __HIP_MEMORY_SCOPE_AGENT));
#pragma unroll
            for (int bj = 0; bj < 2; ++bj) *(u32x4*)(rowp + bj * HALF) = pack8(acc[ai][bj][m][0] * s, acc[ai][bj][m][1] * s);
        EPI_ROWS_END
    }
};
struct EpiProj {
    static constexpr bool PERM = true, AFTER_DRAIN = false;
    bf16_t* O;
    __device__ __forceinline__ void operator()(const f32x4 (&acc)[2][2][4][2], const Unit& u, int wr, int wc, int fr, int fq) const {
        const int col0 = u.pn * BM + wc * 32 + 8 * fq; const int pn = u.pn;
        const int mode = (pn < 4 || (pn >= 5 && pn < 9)) ? 1 : (pn >= 13 ? 2 : 0);
        EPI_ROWS_BEGIN
            bf16_t* rowp = O + (size_t)row * NPROJ + col0;
#pragma unroll
            for (int bj = 0; bj < 2; ++bj) { f32x4 v0 = acc[ai][bj][m][0], v1 = acc[ai][bj][m][1];
                if (mode == 1) { v0 = v0 * C2_64; v1 = v1 * C2_64; }
                else if (mode == 2) {
#pragma unroll
                    for (int i = 0; i < 4; ++i) { v0[i] = sigm(v0[i]); v1[i] = sigm(v1[i]); } }
                *(u32x4*)(rowp + bj * HALF) = pack8(v0, v1); }
        EPI_ROWS_END
    }
};
__device__ __forceinline__ unsigned q4_u8(f32x4 v) { const unsigned a = (unsigned)(v[0] * 255.0f + 0.5f), b = (unsigned)(v[1] * 255.0f + 0.5f), c = (unsigned)(v[2] * 255.0f + 0.5f), d = (unsigned)(v[3] * 255.0f + 0.5f); return a | (b << 8) | (c << 16) | (d << 24); }
__device__ __forceinline__ f32x4 u8_f4(unsigned w) { return (f32x4){(float)(w & 0xffu), (float)((w >> 8) & 0xffu), (float)((w >> 16) & 0xffu), (float)(w >> 24)} * (1.0f / 255.0f); }
struct EpiBranch0 {
    static constexpr bool PERM = true, AFTER_DRAIN = false;
    const unsigned char* G8; bf16_t* O;
    __device__ __forceinline__ void operator()(const f32x4 (&acc)[2][2][4][2], const Unit& u, int wr, int wc, int fr, int fq) const {
        const int col0 = u.pn * BM + wc * 32 + 8 * fq;
        EPI_ROWS_BEGIN
#pragma unroll
            for (int bj = 0; bj < 2; ++bj) { const int col = col0 + bj * HALF;
                const u32x2 gw = *(const u32x2*)(G8 + (size_t)row * 4096 + col); const f32x4 g0 = u8_f4(gw.x), g1 = u8_f4(gw.y);
                *(u32x4*)(O + (size_t)row * DM + col) = pack8(g0 * acc[ai][bj][m][0], g1 * acc[ai][bj][m][1]); }
        EPI_ROWS_END
    }
};
struct EpiBranch1 {
    static constexpr bool PERM = true, AFTER_DRAIN = false;
    const unsigned char* G8; bf16_t* O;
    __device__ __forceinline__ void operator()(const f32x4 (&acc)[2][2][4][2], const Unit& u, int wr, int wc, int fr, int fq) const {
        const int col0 = u.pn * BM + wc * 32 + 8 * fq;
        EPI_ROWS_BEGIN
#pragma unroll
            for (int bj = 0; bj < 2; ++bj) { const int col = col0 + bj * HALF;
                const u32x2 gw = *(const u32x2*)(G8 + (size_t)row * 4096 + DM + col); const f32x4 g0 = u8_f4(gw.x), g1 = u8_f4(gw.y);
                f32x4 t0, t1; unpack8(*(const u32x4*)(O + (size_t)row * DM + col), t0, t1);
                *(u32x4*)(O + (size_t)row * DM + col) = pack8(t0 + g0 * acc[ai][bj][m][0], t1 + g1 * acc[ai][bj][m][1]); }
        EPI_ROWS_END
    }
};
template <bool BASE_BF16>
struct EpiResid {
    static constexpr bool PERM = true, AFTER_DRAIN = false;
    const void* BASE; bf16_t* OUT;
    __device__ __forceinline__ void operator()(const f32x4 (&acc)[2][2][4][2], const Unit& u, int wr, int wc, int fr, int fq) const {
        const int col0 = u.pn * BM + wc * 32 + 8 * fq;
        EPI_ROWS_BEGIN
#pragma unroll
            for (int bj = 0; bj < 2; ++bj) { const size_t off = (size_t)row * DM + col0 + bj * HALF;
                f32x4 b0, b1;
                if (BASE_BF16) unpack8(*(const u32x4*)((const bf16_t*)BASE + off), b0, b1);
                else { b0 = *(const f32x4*)((const float*)BASE + off); b1 = *(const f32x4*)((const float*)BASE + off + 4); }
                *(u32x4*)(OUT + off) = pack8(b0 + acc[ai][bj][m][0], b1 + acc[ai][bj][m][1]); }
        EPI_ROWS_END
    }
};
__device__ __forceinline__ unsigned pk4_fp8(float a, float b, float c, float d) { int w = 0; w = __builtin_amdgcn_cvt_pk_fp8_f32(a, b, w, false); w = __builtin_amdgcn_cvt_pk_fp8_f32(c, d, w, true); return (unsigned)w; }
struct EpiGlu {
    static constexpr bool PERM = true, AFTER_DRAIN = false;
    const float* bgu; unsigned char* ACT;
    __device__ __forceinline__ void operator()(const f32x4 (&acc)[2][2][4][2], const Unit& u, int wr, int wc, int fr, int fq) const {
        const int col = u.pn * HALF + wc * 32 + 8 * fq;
        const float* bg = bgu + (size_t)u.e * (2 * DFF) + col; const float* bl = bg + DFF;
        const f32x4 bg0 = *(const f32x4*)bg, bg1 = *(const f32x4*)(bg + 4), bl0 = *(const f32x4*)bl, bl1 = *(const f32x4*)(bl + 4);
        EPI_ROWS_BEGIN
            f32x4 a[2];
#pragma unroll
            for (int n = 0; n < 2; ++n) { const f32x4 g = acc[ai][0][m][n] * (1.0f / 512.0f) + (n ? bg1 : bg0), l = acc[ai][1][m][n] * (1.0f / 512.0f) + (n ? bl1 : bl0);
#pragma unroll
                for (int i = 0; i < 4; ++i) { const float gl = fminf(g[i], 7.0f), li = fminf(fmaxf(l[i], -7.0f), 7.0f);
                    a[n][i] = 4.0f * gl * __builtin_amdgcn_rcpf(1.0f + __builtin_amdgcn_exp2f(-1.702f * LOG2E * gl)) * (li + 1.0f); } }
            u32x2 w; w.x = pk4_fp8(a[0][0], a[0][1], a[0][2], a[0][3]); w.y = pk4_fp8(a[1][0], a[1][1], a[1][2], a[1][3]);
            *(u32x2*)(ACT + (size_t)row * DFF + col) = w;
        EPI_ROWS_END
    }
};
struct EpiDown {
    static constexpr bool PERM = true, AFTER_DRAIN = false;
    const float* bd; const int* rowslot; const float* roww; unsigned char* OUT;
    __device__ __forceinline__ void operator()(const f32x4 (&acc)[2][2][4][2], const Unit& u, int wr, int wc, int fr, int fq) const {
        const int col0 = u.pn * BM + wc * 32 + 8 * fq;
        const float* bp = bd + (size_t)u.e * DM + col0;
        f32x4 bv[2][2];
#pragma unroll
        for (int bj = 0; bj < 2; ++bj) { bv[bj][0] = *(const f32x4*)(bp + bj * HALF); bv[bj][1] = *(const f32x4*)(bp + bj * HALF + 4); }
        EPI_ROWS_BEGIN
            const int slot = rowslot[row]; const float w = roww[row];
            if (slot >= 0) {
#pragma unroll
                for (int bj = 0; bj < 2; ++bj)
                { const f32x4 y0 = (acc[ai][bj][m][0] * (1.0f / 256.0f) + bv[bj][0]) * (32.0f * w), y1 = (acc[ai][bj][m][1] * (1.0f / 256.0f) + bv[bj][1]) * (32.0f * w);
                    u32x2 q; q.x = pk4_fp8(y0[0], y0[1], y0[2], y0[3]); q.y = pk4_fp8(y1[0], y1[1], y1[2], y1[3]); *(u32x2*)(OUT + (size_t)slot * DM + col0 + bj * HALF) = q; }
            }
        EPI_ROWS_END
    }
};


struct EpiGate {
    static constexpr bool PERM = true, AFTER_DRAIN = false;
    unsigned char* G8;
    __device__ __forceinline__ void operator()(const f32x4 (&acc)[2][2][4][2], const Unit& u, int wr, int wc, int fr, int fq) const {
        const int col0 = u.pn * BM + wc * 32 + 8 * fq;
        EPI_ROWS_BEGIN
            unsigned char* rowp = G8 + (size_t)row * 4096 + col0;
#pragma unroll
            for (int bj = 0; bj < 2; ++bj) { f32x4 v0 = acc[ai][bj][m][0] * (1.0f / 512.0f), v1 = acc[ai][bj][m][1] * (1.0f / 512.0f);
#pragma unroll
                for (int i = 0; i < 4; ++i) { v0[i] = sigm(v0[i]); v1[i] = sigm(v1[i]); }
                u32x2 w; w.x = q4_u8(v0); w.y = q4_u8(v1); *(u32x2*)(rowp + bj * HALF) = w; }
        EPI_ROWS_END
    }
};

struct EpiProjAll {
    static constexpr bool PERM = true, AFTER_DRAIN = false;
    bf16_t* PROJ; bf16_t* VT; bf16_t* KM; bf16_t* VMT;
    __device__ __forceinline__ void operator()(const f32x4 (&acc)[2][2][4][2], const Unit& u, int wr, int wc, int fr, int fq) const {
        if (u.e == 0) { EpiProj E{PROJ}; E(acc, u, wr, wc, fr, fq); }
        else { EpiPlain E{u.e == 1 ? VT : (u.e == 2 ? KM : VMT), u.e == 1 ? T : 512, 1.0f}; E(acc, u, wr, wc, fr, fq); }
    }
};
struct EpiBranchAll {
    static constexpr bool PERM = true, AFTER_DRAIN = false;
    const unsigned char* PROJ; bf16_t* O;
    __device__ __forceinline__ void operator()(const f32x4 (&acc)[2][2][4][2], const Unit& u, int wr, int wc, int fr, int fq) const {
        if (u.e == 0) { EpiBranch0 E{PROJ, O}; E(acc, u, wr, wc, fr, fq); }
        else { asm volatile("s_waitcnt vmcnt(0)" ::: "memory");
               EpiBranch1 E{PROJ, O}; E(acc, u, wr, wc, fr, fq); }
    }
};
template <class Epi, class Sched, bool ALIGN_EPI = false, bool SP2 = false, bool FP8 = false>
__device__ __forceinline__ void gemm_phase(PG8_LAS unsigned char* lds, const Gemm g, const Sched& S, const Epi& E) {
    int tid = threadIdx.x; asm volatile("" : "+v"(tid)); const int wid = __builtin_amdgcn_readfirstlane(tid >> 6), lane = tid & 63, wr = wid >> 2, wc = wid & 3, fr = lane & 15, fq = lane >> 4;
    const int K = g.K, nt = K / BK;
    unsigned voffA[2], voffB[2];
#pragma unroll
    for (int i = 0; i < 2; ++i) { int R, C; stage_rc(tid * 16 + i * 8192, R, C); const int Rb = Epi::PERM ? ((R & ~31) + perm32(R & 31)) : R;
        voffA[i] = (unsigned)(R * K + C) * 2u; voffB[i] = (unsigned)(Rb * K + C) * 2u; }
    u32x2 vgc = {0u, 0u}, vgn = {0u, 0u};
    auto gather_issue = [&](const unsigned short* rp, u32x2& dst) { int t4 = threadIdx.x; asm volatile("" : "+v"(t4)); int R, C; stage_rc(t4 * 16, R, C); const unsigned o = (unsigned)R * 8u;
        asm volatile("s_nop 4\n\tglobal_load_dwordx2 %0, %1, %2" : "=&v"(dst) : "v"(o), "s"(rp) : "memory"); };
#define PG8_GOFF(v, h, i) ((((i) ? ((h) ? (v).y >> 16 : (v).x >> 16) : ((h) ? (v).y & 0xffffu : (v).x & 0xffffu)) * (unsigned)(K * 2)) + (voffB[0] & (unsigned)(K * 2 - 1)))
    const size_t kstep = (size_t)(BK * 2);
    const size_t hstep = Sched::GATHER ? (size_t)0 : (size_t)HALF * K * 2;
    const size_t bhs = g.bhstep;
    const unsigned lds0 = (unsigned)(unsigned long)lds;
    const unsigned ldsw = (unsigned)wid * 1024u;
    const int aoff = lds_byte(wr * 64 + fr, fq * 8), boff = lds_byte(wc * 32 + fr, fq * 8);
#define PG8_SA(b, h) (((b) * 2 + (h)) * HTB)
#define PG8_SB(b, h) ((4 + (b) * 2 + (h)) * HTB)
#define PG8_STAGE(bufoff, gbase, voff) do { _Pragma("unroll") for (int _i = 0; _i < 2; ++_i) \
        glds16_s((const char*)(gbase), (voff)[_i], lds0 + (unsigned)(bufoff) + ldsw + (unsigned)(_i * 8192)); } while (0)
#define PG8_STAGE_A(bufoff, gbase, h, nx) do { if constexpr (Sched::GATHER) { u32x2 vv_ = (nx) ? vgn : vgc; asm volatile("" : "+v"(vv_));        const unsigned vs_[2] = {PG8_GOFF(vv_, h, 0), PG8_GOFF(vv_, h, 1)}; PG8_STAGE(bufoff, gbase, vs_); } else PG8_STAGE(bufoff, gbase, voffA); } while (0)
#define PG8_LDA(dst, b, h) do { _Pragma("unroll") for (int m = 0; m < 4; ++m) _Pragma("unroll") for (int k = 0; k < 2; ++k) dst[m][k] = *(const PG8_LAS bf16x8*)(lds + PG8_SA(b, h) + aoff + m * 2048 + k * 1024); } while (0)
#define PG8_LDB(dst, b, h) do { _Pragma("unroll") for (int n = 0; n < 2; ++n) _Pragma("unroll") for (int k = 0; k < 2; ++k) dst[n][k] = *(const PG8_LAS bf16x8*)(lds + PG8_SB(b, h) + boff + n * 2048 + k * 1024); } while (0)
#define PG8_MMA(ai, bj, At, Bt) do { __builtin_amdgcn_s_setprio(1); _Pragma("unroll") for (int m = 0; m < 4; ++m) _Pragma("unroll") for (int n = 0; n < 2; ++n) { \
        if constexpr (FP8) acc[ai][bj][m][n] = __builtin_amdgcn_mfma_scale_f32_16x16x128_f8f6f4(cat16(Bt[n][0], Bt[n][1]), cat16(At[m][0], At[m][1]), acc[ai][bj][m][n], 0, 0, 0, 0, 0, 0); \
        else { _Pragma("unroll") for (int k = 0; k < 2; ++k) acc[ai][bj][m][n] = __builtin_amdgcn_mfma_f32_16x16x32_bf16(Bt[n][k], At[m][k], acc[ai][bj][m][n], 0, 0, 0); } } __builtin_amdgcn_s_setprio(0); } while (0)
#define PG8_WAIT_V(n) asm volatile("s_waitcnt vmcnt(" #n ")" ::: "memory")
#define PG8_WAIT_L(n) asm volatile("s_waitcnt lgkmcnt(" #n ")" ::: "memory")
#define PG8_BAR __builtin_amdgcn_s_barrier()
#define PG8_SCHED __builtin_amdgcn_sched_barrier(0)
    Unit cur, nxt; int ui = 0;
    if (!S.next(0, cur)) return;
    f32x4 acc[2][2][4][2];
#pragma unroll
    for (int a = 0; a < 2; ++a)
#pragma unroll
        for (int b = 0; b < 2; ++b)
#pragma unroll
            for (int m = 0; m < 4; ++m)
#pragma unroll
                for (int n = 0; n < 2; ++n) acc[a][b][m][n] = (f32x4){0.f, 0.f, 0.f, 0.f};
    bf16x8 At[4][2], B0[2][2], B1[2][2];
    const char* cA; const char* cB; S.ptrs(cur, cA, cB);
    S.a_ready(cur);
    if constexpr (Sched::GATHER) { static_assert(SP2, "gather is written for the SP2 loop"); gather_issue(S.rows(cur), vgc); asm volatile("s_waitcnt vmcnt(0)" : "+v"(vgc) :: "memory"); vgn = vgc; }
    if constexpr (SP2) {
        PG8_STAGE(PG8_SB(0, 0), cB, voffB); PG8_STAGE(PG8_SB(0, 1), cB + bhs, voffB); PG8_STAGE_A(PG8_SA(0, 0), cA, 0, false); PG8_STAGE_A(PG8_SA(0, 1), cA + hstep, 1, false);
        if (wr == 1) PG8_BAR;
        PG8_WAIT_V(2); PG8_BAR;
        PG8_STAGE(PG8_SB(1, 0), cB + kstep, voffB); PG8_STAGE_A(PG8_SA(1, 0), cA + kstep, 0, false); PG8_STAGE(PG8_SB(1, 1), cB + bhs + kstep, voffB);
        PG8_WAIT_V(6); PG8_BAR;
    } else {
        PG8_STAGE(PG8_SB(0, 0), cB, voffB); PG8_STAGE(PG8_SA(0, 0), cA, voffA); PG8_STAGE(PG8_SB(0, 1), cB + bhs, voffB); PG8_STAGE(PG8_SA(0, 1), cA + hstep, voffA);
        if (wr == 1) PG8_BAR;
        PG8_WAIT_V(4); PG8_BAR;
        PG8_STAGE(PG8_SB(1, 0), cB + kstep, voffB); PG8_STAGE(PG8_SA(1, 0), cA + kstep, voffA); PG8_STAGE(PG8_SB(1, 1), cB + bhs + kstep, voffB);
        PG8_WAIT_V(6); PG8_BAR;
    }
    for (;;) {
        const bool has_next = S.next(ui + 1, nxt);
        const char* nA = cA; const char* nB = cB; if (has_next) S.ptrs(nxt, nA, nB);
        if constexpr (Sched::GATHER) { if (has_next) gather_issue(S.rows(nxt), vgn); }
        for (int t = 0; t < nt; t += 2) {
            const bool last = (t == nt - 2);
            const char* a1 = cA + (size_t)(t + 1) * kstep;
            const char* a2 = last ? nA : cA + (size_t)(t + 2) * kstep; const char* b2 = last ? nB : cB + (size_t)(t + 2) * kstep;
            const char* a3 = a2 + kstep; const char* b3 = b2 + kstep;
            if (last && has_next) S.a_ready(nxt);
            if constexpr (SP2) {
            PG8_LDB(B0, 0, 0); PG8_LDB(B1, 0, 1); PG8_SCHED; PG8_LDA(At, 0, 0); PG8_STAGE_A(PG8_SA(1, 1), a1 + hstep, 1, false);
            PG8_WAIT_V(8); PG8_WAIT_L(0); PG8_BAR; PG8_MMA(0, 0, At, B0); PG8_MMA(0, 1, At, B1); PG8_BAR; PG8_SCHED;
            PG8_LDA(At, 0, 1); PG8_STAGE(PG8_SB(0, 0), b2, voffB); PG8_STAGE(PG8_SB(0, 1), b2 + bhs, voffB); PG8_STAGE_A(PG8_SA(0, 0), a2, 0, last);
            PG8_WAIT_V(8); PG8_WAIT_L(0); PG8_BAR;
            PG8_MMA(1, 0, At, B0); PG8_MMA(1, 1, At, B1); PG8_BAR; PG8_SCHED;
            PG8_LDB(B0, 1, 0); PG8_LDB(B1, 1, 1); PG8_SCHED; PG8_LDA(At, 1, 0); PG8_STAGE_A(PG8_SA(0, 1), a2 + hstep, 1, last);
            PG8_WAIT_V(8); PG8_WAIT_L(0); PG8_BAR; PG8_MMA(0, 0, At, B0); PG8_MMA(0, 1, At, B1); PG8_BAR; PG8_SCHED;
            PG8_LDA(At, 1, 1); PG8_STAGE(PG8_SB(1, 0), b3, voffB); PG8_STAGE(PG8_SB(1, 1), b3 + bhs, voffB); PG8_STAGE_A(PG8_SA(1, 0), a3, 0, last);
            PG8_WAIT_V(8); PG8_WAIT_L(0); PG8_BAR; PG8_MMA(1, 0, At, B0); PG8_MMA(1, 1, At, B1); PG8_BAR; PG8_SCHED;
            } else {
            PG8_LDB(B0, 0, 0); PG8_SCHED; PG8_LDA(At, 0, 0); PG8_STAGE(PG8_SA(1, 1), a1 + hstep, voffA);
            PG8_WAIT_L(8); PG8_BAR; PG8_WAIT_L(0); PG8_MMA(0, 0, At, B0); PG8_BAR; PG8_SCHED;
            PG8_LDB(B1, 0, 1); PG8_STAGE(PG8_SB(0, 0), b2, voffB);
            PG8_BAR; PG8_WAIT_L(0); PG8_MMA(0, 1, At, B1); PG8_BAR;
            PG8_LDA(At, 0, 1); PG8_STAGE(PG8_SA(0, 0), a2, voffA);
            PG8_BAR; PG8_WAIT_L(0); PG8_MMA(1, 0, At, B0); PG8_BAR; PG8_SCHED;
            PG8_STAGE(PG8_SB(0, 1), b2 + bhs, voffB);
            PG8_WAIT_V(6); PG8_BAR; PG8_MMA(1, 1, At, B1); PG8_BAR;
            PG8_LDB(B0, 1, 0); PG8_SCHED; PG8_LDA(At, 1, 0); PG8_STAGE(PG8_SA(0, 1), a2 + hstep, voffA);
            PG8_WAIT_L(8); PG8_BAR; PG8_WAIT_L(0); PG8_MMA(0, 0, At, B0); PG8_BAR; PG8_SCHED;
            PG8_LDB(B1, 1, 1); PG8_STAGE(PG8_SB(1, 0), b3, voffB);
            PG8_BAR; PG8_WAIT_L(0); PG8_MMA(0, 1, At, B1); PG8_BAR;
            PG8_LDA(At, 1, 1); PG8_STAGE(PG8_SA(1, 0), a3, voffA);
            PG8_BAR; PG8_WAIT_L(0); PG8_MMA(1, 0, At, B0); PG8_BAR; PG8_SCHED;
            PG8_STAGE(PG8_SB(1, 1), b3 + bhs, voffB);
            PG8_WAIT_V(6); PG8_BAR; PG8_MMA(1, 1, At, B1); PG8_BAR;
            }
        }
        if constexpr (ALIGN_EPI) { if (wr == 0) PG8_BAR; }
        if constexpr (!Epi::AFTER_DRAIN) { int t2 = threadIdx.x; asm volatile("" : "+v"(t2)); const int l2 = t2 & 63, w2 = __builtin_amdgcn_readfirstlane(t2 >> 6); E(acc, cur, w2 >> 2, w2 & 3, l2 & 15, l2 >> 4); S.done(cur); }
        if (!has_next) break;
#pragma unroll
        for (int a = 0; a < 2; ++a)
#pragma unroll
            for (int b = 0; b < 2; ++b)
#pragma unroll
                for (int m = 0; m < 4; ++m)
#pragma unroll
                    for (int n = 0; n < 2; ++n) acc[a][b][m][n] = (f32x4){0.f, 0.f, 0.f, 0.f};
        cur = nxt; cA = nA; cB = nB; ++ui;
        if constexpr (Sched::GATHER) vgc = vgn;
        if constexpr (ALIGN_EPI) { if (wr == 1) PG8_BAR; }
    }
    PG8_WAIT_V(0);
    if constexpr (!ALIGN_EPI) { if (wr == 0) PG8_BAR; }
    PG8_BAR;
    if constexpr (Epi::AFTER_DRAIN) { E.fused(acc, cur, wr, wc, fr, fq, lds, wid, lane); S.done(cur); }
#undef PG8_SA
#undef PG8_SB
#undef PG8_STAGE
#undef PG8_STAGE_A
#undef PG8_GOFF
#undef PG8_LDA
#undef PG8_LDB
#undef PG8_MMA
#undef PG8_WAIT_V
#undef PG8_WAIT_L
#undef PG8_BAR
#undef PG8_SCHED
}
}

#define XB_TMO      128
#define XB_XCNT(j)  (256  + 64 * (j))
#define XB_XSUB(j)  (1280 + 64 * (j))
#define XB_XGEN(j)  (2304 + 64 * (j))
#define XB_TOP      3328
#define XB_TOPGEN   3392
#define XCD_BAR_WORDS 3456
#define XB_SPIN_CAP (1u << 18)
#define LAS __attribute__((address_space(3)))

__device__ __forceinline__ unsigned xb_ld(unsigned* p)              { return __hip_atomic_load(p, __ATOMIC_RELAXED, __HIP_MEMORY_SCOPE_AGENT); }
__device__ __forceinline__ unsigned xb_add(unsigned* p, unsigned v) { return __hip_atomic_fetch_add(p, v, __ATOMIC_RELAXED, __HIP_MEMORY_SCOPE_AGENT); }
__device__ __forceinline__ unsigned xb_xcc_id() { return (unsigned)__builtin_amdgcn_s_getreg((3 << 11) | 20) & 0xFu; }
#define XB_SPIN(cond, bar) do { unsigned _sp = 0; while (cond) { __builtin_amdgcn_s_sleep(1); \
    if ((++_sp & 255u) == 0u) { if (xb_ld(&(bar)[XB_TMO])) break; if (_sp > XB_SPIN_CAP) { atomicAdd(&(bar)[XB_TMO], 1u); break; } } } } while (0)

struct XcdBarrier {
    unsigned* bar; unsigned x;
    volatile LAS unsigned* st;
};

__device__ __forceinline__ XcdBarrier xcd_barrier_post(unsigned* bar, volatile LAS unsigned* st) {
    XcdBarrier b; b.bar = bar; b.x = xb_xcc_id(); b.st = st;
    if (threadIdx.x == 0) (void)xb_add(&bar[XB_XCNT(b.x)], 1u);
    return b;
}
__device__ __forceinline__ void xcd_barrier_complete(unsigned* bar, unsigned x, unsigned& nloc, unsigned& nx) {
    const unsigned G = gridDim.x * gridDim.y * gridDim.z;
    unsigned sum, cnt, mine, sp = 0u;
    for (;;) {
        sum = 0u; cnt = 0u; mine = 0u;
#pragma unroll
        for (unsigned j = 0; j < 16; ++j) { const unsigned c = xb_ld(&bar[XB_XCNT(j)]); sum += c; cnt += (c > 0u) ? 1u : 0u; mine = (j == x) ? c : mine; }
        if (sum == G) break;
        __builtin_amdgcn_s_sleep(1);
        if ((++sp & 255u) == 0u) { if (xb_ld(&bar[XB_TMO])) break; if (sp > XB_SPIN_CAP) { atomicAdd(&bar[XB_TMO], 1u); break; } }
    }
    nloc = mine > 0u ? mine : 1u; nx = cnt > 0u ? cnt : 1u;
}

__device__ __forceinline__ void xcd_barrier(const XcdBarrier& b) {
    asm volatile("s_waitcnt vmcnt(0)" ::: "memory");
    __syncthreads();
    if (threadIdx.x == 0) {
        unsigned* bar = b.bar;
        __builtin_amdgcn_s_waitcnt(0);
        unsigned nloc = b.st[0], nx = b.st[1];
        if (nloc == 0u) { xcd_barrier_complete(bar, b.x, nloc, nx); b.st[0] = nloc; b.st[1] = nx; }
        const unsigned old = xb_add(&bar[XB_XSUB(b.x)], 1u);
        const unsigned gen = old / nloc;
        if (old + 1u == (gen + 1u) * nloc) {
            __builtin_amdgcn_fence(__ATOMIC_RELEASE, "agent");
            asm volatile("s_waitcnt vmcnt(0)" ::: "memory");
            const unsigned og = xb_add(&bar[XB_TOP], 1u);
            const unsigned tg = og / nx;
            if (og + 1u == (tg + 1u) * nx) xb_add(&bar[XB_TOPGEN], 1u);
            else XB_SPIN(xb_ld(&bar[XB_TOPGEN]) == tg, bar);
            __builtin_amdgcn_fence(__ATOMIC_ACQUIRE, "agent");
            xb_add(&bar[XB_XGEN(b.x)], 1u);
            asm volatile("s_waitcnt vmcnt(0)" ::: "memory");
        } else {
            XB_SPIN(xb_ld(&bar[XB_XGEN(b.x)]) == gen, bar);
            __builtin_amdgcn_fence(__ATOMIC_ACQUIRE, "agent");
            asm volatile("s_waitcnt vmcnt(0)" ::: "memory");
        }
    }
    __syncthreads();
}


struct Frame {
    LAS unsigned char* lds;
    unsigned* ctl;
    int wave, vcu, G;
    const float* in[25];
    float* out;
    unsigned char* ws;
};
#define WSP(type, off) ((type*)(F.ws + (off)))

__device__ __forceinline__ int win_dst_row(int n0) {
    if (n0 < 1280) return n0;
    if (n0 < 1536) return NPROJ + (n0 - 1280);
    if (n0 < 2560) return PC_QD + (n0 - 1536);
    if (n0 < 3584) return PC_KD + (n0 - 2560);
    if (n0 < 4608) return NPROJ + 256 + (n0 - 3584);
    return PC_G + (n0 - 4608);
}
__device__ __forceinline__ void rms_row_bf16(const float* xrow, const float* gain, bf16_t* orow, int lane, unsigned char* o8 = nullptr) {
    f32x4 v[8]; float s = 0.f;
#pragma unroll
    for (int j = 0; j < 8; ++j) { v[j] = ((const f32x4*)xrow)[lane + 64 * j]; s += (v[j][0] * v[j][0] + v[j][1] * v[j][1]) + (v[j][2] * v[j][2] + v[j][3] * v[j][3]); }
    const float rstd = 1.0f / sqrtf(wave_sum(s) * (1.0f / DM) + RMS_EPS);
#pragma unroll
    for (int j = 0; j < 8; ++j) { const f32x4 g = ((const f32x4*)gain)[lane + 64 * j]; const f32x4 o = v[j] * rstd * g;
        u32x2 w; w.x = pk2(o[0], o[1]); w.y = pk2(o[2], o[3]); ((u32x2*)orow)[lane + 64 * j] = w;
        if (o8) ((unsigned*)o8)[lane + 64 * j] = pg8::pk4_fp8(o[0] * 8.0f, o[1] * 8.0f, o[2] * 8.0f, o[3] * 8.0f); }
}
__device__ __forceinline__ void rows_rms_phase(Frame& F, const float* X, const float* gain, bf16_t* O, int nrows, unsigned char* O8 = nullptr) {
    int lane = threadIdx.x; asm volatile("" : "+v"(lane)); lane &= 63;
    const int gw = F.vcu * NWAVES + F.wave, NGW = F.G * NWAVES;
    for (int r = gw; r < nrows; r += NGW) rms_row_bf16(X + (size_t)r * DM, gain, O + (size_t)r * DM, lane, O8 ? O8 + (size_t)r * DM : nullptr);
}

__device__ __forceinline__ void rows_rstd_phase(Frame& F, const bf16_t* X, float* RS, unsigned* rsc, int nrows) {
    int lane = threadIdx.x; asm volatile("" : "+v"(lane)); lane &= 63;
    const int gw = F.vcu * NWAVES + F.wave, NGW = F.G * NWAVES;
    for (int r = gw; r < nrows; r += 2 * NGW) {
        const int r1 = r + NGW; const bool two = r1 < nrows;
        u32x4 w[2][4];
#pragma unroll
        for (int j = 0; j < 4; ++j) { w[0][j] = ((const u32x4*)(X + (size_t)r * DM))[lane + 64 * j]; w[1][j] = ((const u32x4*)(X + (size_t)(two ? r1 : r) * DM))[lane + 64 * j]; }
#pragma unroll
        for (int q = 0; q < 2; ++q) { float s = 0.f;
#pragma unroll
            for (int j = 0; j < 4; ++j) { f32x4 v0, v1; pg8::unpack8(w[q][j], v0, v1);
                s += ((v0[0] * v0[0] + v0[1] * v0[1]) + (v0[2] * v0[2] + v0[3] * v0[3])) + ((v1[0] * v1[0] + v1[1] * v1[1]) + (v1[2] * v1[2] + v1[3] * v1[3])); }
            s = wave_sum(s);
            if (lane == 0 && (q == 0 || two)) __hip_atomic_store((unsigned*)RS + (q ? r1 : r), __builtin_bit_cast(unsigned, 1.0f / sqrtf(s * (1.0f / DM) + RMS_EPS)), __ATOMIC_RELAXED, __HIP_MEMORY_SCOPE_AGENT); }
    }
    asm volatile("s_waitcnt vmcnt(0)" ::: "memory");
    if (lane == 0) for (int r = gw; r < nrows; r += NGW) __hip_atomic_fetch_add(rsc + 32 * (r >> 8), 1u, __ATOMIC_RELAXED, __HIP_MEMORY_SCOPE_AGENT);
}

struct TrItem { const float* src; int N; unsigned char* dst; int dpitch; int fp8; const float* gain; };
__device__ __forceinline__ bool tr_decode(Frame& F, int it, TrItem& d) {
    constexpr int I_IN = 32 * 136, I_B = 16 * 32, I_O = 32 * 32, I_CQ = 32 * 8, I_CKV = 32 * 16, I_CO = 8 * 32, I_GU1 = 32 * 64, I_D1 = 32 * 32;
    constexpr int NITEMS = I_IN + 2 * I_B + I_O + I_CQ + I_CKV + I_CO + NE * I_GU1 + NE * I_D1;
    if (it >= NITEMS) return false;
    int r = it; const float* W; int K, N, kb, nb, drow; unsigned char* D; int esz = 2; d.fp8 = 0; d.gain = nullptr;
    if (r < NE * I_GU1) { const int e = r / I_GU1, q = r % I_GU1; kb = q / 128; nb = q % 128; W = F.in[20] + (size_t)e * DM * 2 * DFF; K = DM; N = 2 * DFF; D = WSP(unsigned char, WS_WGU) + (size_t)e * 2 * DFF * DM; drow = 32 * nb; esz = 1; d.fp8 = 1; }
    else if ((r -= NE * I_GU1) < NE * I_D1) { const int e = r / I_D1, q = r % I_D1; kb = q / 64; nb = q % 64; W = F.in[22] + (size_t)e * DFF * DM; K = DFF; N = DM; D = WSP(unsigned char, WS_WD) + (size_t)e * DM * DFF; drow = 32 * nb; esz = 1; d.fp8 = 1; }
    else if ((r -= NE * I_D1) < 32 * 72) { kb = r / 72; nb = r % 72; W = F.in[3]; K = DM; N = 8704; D = WSP(unsigned char, WS_WIN); drow = win_dst_row(64 * nb); }
    else if ((r -= 32 * 72) < 16 * 128) { kb = r / 128; nb = r % 128; d.fp8 = 1; d.src = F.in[3] + (size_t)(128 * kb) * 8704 + 4608 + 32 * nb; d.N = 8704; d.dpitch = DM; d.dst = WSP(unsigned char, WS_WING8) + (size_t)(32 * nb) * DM + 128 * kb; return true; }
    else if ((r -= 16 * 128) < 2 * I_B) { const int n = r / I_B, q = r % I_B; kb = q / 32; nb = q % 32; W = F.in[10] + (size_t)n * 1024 * DM; K = 1024; N = DM; D = WSP(unsigned char, WS_WB) + (size_t)n * DM * 1024 * 2; drow = 64 * nb; }
    else if ((r -= 2 * I_B) < I_O) { kb = r / 32; nb = r % 32; W = F.in[11]; K = DM; N = DM; D = WSP(unsigned char, WS_WO); drow = 64 * nb; }
    else if ((r -= I_O) < I_CQ) { kb = r / 8; nb = r % 8; W = F.in[14]; K = DM; N = 512; D = WSP(unsigned char, WS_WCQ); drow = 64 * nb; d.gain = F.in[12] + 64 * kb; }
    else if ((r -= I_CQ) < I_CKV) { kb = r / 16; nb = r % 16; W = F.in[15]; K = DM; N = 1024; D = WSP(unsigned char, WS_WCKV); drow = 64 * nb; }
    else { r -= I_CKV; kb = r / 32; nb = r % 32; W = F.in[16]; K = 512; N = DM; D = WSP(unsigned char, WS_WCO); drow = 64 * nb; }
    if (d.fp8) { d.src = W + (size_t)(128 * kb) * N + 32 * nb; d.N = N; d.dpitch = K; d.dst = D + (size_t)drow * K + (size_t)(128 * kb); return true; }
    d.src = W + (size_t)(64 * kb) * N + 64 * nb; d.N = N; d.dpitch = K * esz; d.dst = D + (size_t)drow * d.dpitch + (size_t)(64 * kb) * esz;
    return true;
}
constexpr int NMOE_ITEMS = NE * (32 * 64 + 32 * 32);
constexpr int NALL_ITEMS = NMOE_ITEMS + 32 * 136 + 2 * 16 * 32 + 32 * 32 + 32 * 8 + 32 * 16 + 8 * 32;
__device__ __forceinline__ void conv_items(Frame& F, int lane, int it0, int step, int end) {
    LAS float* scr = (LAS float*)(F.lds + F.wave * 16896);
    TrItem cur, nxt; int it = it0;
    bool have = it < end && tr_decode(F, it, cur);
    f32x4 v[16];
#define TR_LOAD(D_) do { if ((D_).fp8) { _Pragma("unroll") for (int i = 0; i < 16; ++i) v[i] = *(const f32x4*)((D_).src + (size_t)((lane >> 3) + 8 * i) * (D_).N + 4 * (lane & 7)); } \
        else { _Pragma("unroll") for (int i = 0; i < 16; ++i) v[i] = *(const f32x4*)((D_).src + (size_t)((lane >> 4) + 4 * i) * (D_).N + 4 * (lane & 15)); } } while (0)
    if (have) TR_LOAD(cur);
    while (have) {
        if (cur.fp8) {
#pragma unroll
            for (int i = 0; i < 16; ++i) { LAS float* s = scr + ((lane >> 3) + 8 * i) * 33 + 4 * (lane & 7); s[0] = v[i][0] * 64.0f; s[1] = v[i][1] * 64.0f; s[2] = v[i][2] * 64.0f; s[3] = v[i][3] * 64.0f; }
        } else {
#pragma unroll
            for (int i = 0; i < 16; ++i) { const float sc = cur.gain ? cur.gain[(lane >> 4) + 4 * i] : 1.0f; LAS float* s = scr + ((lane >> 4) + 4 * i) * 65 + 4 * (lane & 15); s[0] = v[i][0] * sc; s[1] = v[i][1] * sc; s[2] = v[i][2] * sc; s[3] = v[i][3] * sc; }
        }
        it += step;
        const bool hn = it < end && tr_decode(F, it, nxt);
        if (hn) TR_LOAD(nxt);
        LDS_WAIT(); asm volatile("" ::: "memory");
        const int kc = lane >> 3;
        if (cur.fp8) {
#pragma unroll
            for (int j = 0; j < 4; ++j) { const int n = lane & 31, k16 = 2 * j + (lane >> 5); const LAS float* s = scr + (16 * k16) * 33 + n;
                u32x4 o; o.x = pg8::pk4_fp8(s[0], s[33], s[66], s[99]); o.y = pg8::pk4_fp8(s[132], s[165], s[198], s[231]);
                o.z = pg8::pk4_fp8(s[264], s[297], s[330], s[363]); o.w = pg8::pk4_fp8(s[396], s[429], s[462], s[495]);
                *(u32x4*)(cur.dst + (size_t)n * cur.dpitch + 16 * k16) = o; }
        } else {
#pragma unroll
            for (int j = 0; j < 8; ++j) { const int n = (lane & 7) + 8 * j; const LAS float* s = scr + (8 * kc) * 65 + n;
                u32x4 o; o.x = pk2(s[0], s[65]); o.y = pk2(s[130], s[195]); o.z = pk2(s[260], s[325]); o.w = pk2(s[390], s[455]);
                *(u32x4*)(cur.dst + (size_t)n * cur.dpitch + 16 * kc) = o; }
        }
        LDS_WAIT(); asm volatile("" ::: "memory");
        cur = nxt; have = hn;
    }
#undef TR_LOAD
}
template <int BLK>
__device__ __forceinline__ void conv_filler(Frame& F, int phase) {
    int tid = threadIdx.x; asm volatile("" : "+v"(tid)); const int lane = tid & 63;
    volatile LAS unsigned* fl = (volatile LAS unsigned*)(F.lds + LDS_MISC_OFF) + 16;
    asm volatile("s_waitcnt vmcnt(0)" ::: "memory");
    __syncthreads();
    unsigned nbase = (unsigned)NMOE_ITEMS, arrived = 0u;
    if (tid == 0) { if (phase >= 0) arrived = __hip_atomic_fetch_add(F.ctl + CW_DONE + 64 * phase, 1u, __ATOMIC_RELAXED, __HIP_MEMORY_SCOPE_AGENT) + 1u;
                    if (phase < 0 || arrived < (unsigned)F.G) nbase = __hip_atomic_fetch_add(F.ctl + CW_CONV, (unsigned)(NWAVES * BLK), __ATOMIC_RELAXED, __HIP_MEMORY_SCOPE_AGENT); }
    for (;;) {
        if (tid == 0) fl[0] = nbase;
        __syncthreads();
        const unsigned base = fl[0];
        __syncthreads();
        if (base >= (unsigned)NMOE_ITEMS) break;
        if (tid == 0) {
            if (phase >= 0 && arrived >= (unsigned)F.G) nbase = (unsigned)NMOE_ITEMS;
            else { nbase = __hip_atomic_fetch_add(F.ctl + CW_CONV, (unsigned)(NWAVES * BLK), __ATOMIC_RELAXED, __HIP_MEMORY_SCOPE_AGENT);
                   if (phase >= 0) arrived = __hip_atomic_load(F.ctl + CW_DONE + 64 * phase, __ATOMIC_RELAXED, __HIP_MEMORY_SCOPE_AGENT); } }
        const int b0 = (int)base + F.wave * BLK, b1 = b0 + BLK;
        conv_items(F, lane, b0, 1, b1 < NMOE_ITEMS ? b1 : NMOE_ITEMS);
    }
}
__device__ __forceinline__ void p0_prologue(Frame& F) {
    int tid = threadIdx.x; asm volatile("" : "+v"(tid)); const int lane = tid & 63;
    const int gw = F.vcu * NWAVES + F.wave, NGW = F.G * NWAVES;
    conv_items(F, lane, NMOE_ITEMS + gw, NGW, NALL_ITEMS);
    rows_rms_phase(F, F.in[0], F.in[2], WSP(bf16_t, WS_XN), T, WSP(unsigned char, WS_XN8));
    rows_rms_phase(F, F.in[1], F.in[13], WSP(bf16_t, WS_MEMN), BATCH * 256);
    int* rs = WSP(int, WS_ROWSLOT);
    for (int i = blockIdx.x * NTHR + tid; i < XROWS; i += F.G * NTHR) rs[i] = -1;
    { unsigned* rt = WSP(unsigned, WS_ROWTOK); for (int i = blockIdx.x * NTHR + tid; i < XROWS / 2; i += F.G * NTHR) rt[i] = 0u; }
    { bf16_t* WRT = WSP(bf16_t, WS_WRT); const float* Wr = F.in[18]; const float* gffn = F.in[17];
      for (int i = blockIdx.x * NTHR + tid; i < NE * DM; i += F.G * NTHR) { const int e = i >> 11, k = i & (DM - 1);
          const float w = Wr[(size_t)k * NE + e] * gffn[k]; const unsigned h0 = f2bf(w); const float r1 = w - __builtin_bit_cast(float, h0 << 16);
          const unsigned h1 = f2bf(r1); const float r2 = r1 - __builtin_bit_cast(float, h1 << 16); const unsigned h2 = f2bf(r2);
          const int c = k >> 9, wv = (k >> 6) & 7, kk = (k >> 4) & 3, hi_ = (k >> 3) & 1, j = k & 7;
          const size_t d = ((size_t)((wv * 16 + 4 * c + kk) * 3) * 64 + 32 * hi_ + e) * 8 + j;
          WRT[d] = (bf16_t)h0; WRT[d + 512] = (bf16_t)h1; WRT[d + 1024] = (bf16_t)h2; } }
}

__device__ __forceinline__ void route_r1(Frame& F) {
    const bf16_t* H2 = WSP(bf16_t, WS_H); const float* gffn = F.in[17]; const float* br = F.in[19]; const u32x4* WRTF = WSP(u32x4, WS_WRT);
    unsigned char* XN3 = WSP(unsigned char, WS_XN); int* TOPI = WSP(int, WS_TOPI); float* TOPW = WSP(float, WS_TOPW);
    LAS unsigned char* Xb = F.lds;
    LAS float* Lp = (LAS float*)(F.lds + 67584);
    LAS float* rsq = (LAS float*)(F.lds + 100352);
    LAS float* rstd_s = (LAS float*)(F.lds + 100864);
    LAS float* Lg = (LAS float*)(F.lds + 100992);
    LAS int* hist = (LAS int*)(F.lds + 105216);
    int tid = threadIdx.x; asm volatile("" : "+v"(tid)); const int lane = tid & 63;
    const int wave = F.wave, ql = lane & 31, hi = lane >> 5;
    u32x4 pf0[4], pf1[4];
#define R1_LOAD(P_, TASK_, CH_) do { _Pragma("unroll") for (int i = 0; i < 4; ++i) { const int f = tid + 512 * i, row = f >> 6, c8 = f & 63; \
        P_[i] = *(const u32x4*)(H2 + (size_t)((TASK_) * 32 + row) * DM + (CH_) * 512 + 8 * c8); } } while (0)
#define R1_CHUNK(P_, CH_) do { \
            LAS unsigned char* xb = Xb + ((CH_) & 1) * 33280; \
            bf16x8 bfr[4][3];                                     \
            _Pragma("unroll") for (int kk = 0; kk < 4; ++kk) _Pragma("unroll") for (int tm = 0; tm < 3; ++tm) bfr[kk][tm] = __builtin_bit_cast(bf16x8, WRTF[(size_t)((wave * 16 + 4 * (CH_) + kk) * 3 + tm) * 64 + lane]); \
            _Pragma("unroll") for (int i = 0; i < 4; ++i) { const int f = tid + 512 * i, row = f >> 6, c8 = f & 63; \
                f32x4 v0, v1; pg8::unpack8(P_[i], v0, v1); \
                sq[i] += ((v0[0] * v0[0] + v0[1] * v0[1]) + (v0[2] * v0[2] + v0[3] * v0[3])) + ((v1[0] * v1[0] + v1[1] * v1[1]) + (v1[2] * v1[2] + v1[3] * v1[3])); \
                *(LAS u32x4*)(xb + row * 1040 + 16 * c8) = P_[i]; } \
            if ((CH_) < 2) R1_LOAD(P_, task, (CH_) + 2); else if (task + F.G < T / 32) R1_LOAD(P_, task + F.G, (CH_) - 2); \
            __syncthreads();                                      \
            _Pragma("unroll") for (int kk = 0; kk < 4; ++kk) { const bf16x8 a = *(const LAS bf16x8*)(xb + ql * 1040 + (64 * wave + 16 * kk + 8 * hi) * 2); \
                _Pragma("unroll") for (int tm = 0; tm < 3; ++tm) acc = __builtin_amdgcn_mfma_f32_32x32x16_bf16(a, bfr[kk][tm], acc, 0, 0, 0); } } while (0)
    if (F.vcu < T / 32) { R1_LOAD(pf0, F.vcu, 0); R1_LOAD(pf1, F.vcu, 1); }
    for (int task = F.vcu; task < T / 32; task += F.G) {
        const int r0 = task * 32;
        f32x16 acc = {};
        float sq[4];
#pragma unroll
        for (int i = 0; i < 4; ++i) sq[i] = 0.f;
        if (tid < 32) hist[tid] = 0;
#pragma unroll 1
        for (int cp = 0; cp < 4; cp += 2) { R1_CHUNK(pf0, cp); R1_CHUNK(pf1, cp + 1); }
#pragma unroll
        for (int i = 0; i < 4; ++i) { const float s = wave_sum(sq[i]); if (lane == 0) rsq[(wave + 8 * i) * 4] = s; }
#pragma unroll
        for (int r = 0; r < 16; ++r) Lp[wave * 1024 + ((r & 3) + 8 * (r >> 2) + 4 * hi) * 32 + ql] = acc[r];
        __syncthreads();
#pragma unroll
        for (int i = 0; i < 2; ++i) { const int o = tid + 512 * i, tok = o >> 5, e = o & 31; float s = 0.f;
#pragma unroll
            for (int w = 0; w < 8; ++w) s += Lp[w * 1024 + o];
            const float rstd = 1.0f / sqrtf(rsq[tok * 4] * (1.0f / DM) + RMS_EPS);
            if (e == 0) rstd_s[tok] = rstd;
            Lg[tok * 33 + e] = s * rstd + br[e]; }
        __syncthreads();
        { const int tl = lane >> 4, j = lane & 15, tok = 4 * wave + tl; float v0 = Lg[tok * 33 + j], v1 = Lg[tok * 33 + j + 16]; int idx[4]; float val[4];
#pragma unroll
          for (int k = 0; k < 4; ++k) { float bv = v0 >= v1 ? v0 : v1; int bi = v0 >= v1 ? j : j + 16;
#pragma unroll
              for (int m = 1; m < 16; m <<= 1) { const float ov = __shfl_xor(bv, m); const int oi = __shfl_xor(bi, m); const bool take = ov > bv || (ov == bv && oi < bi); bv = take ? ov : bv; bi = take ? oi : bi; }
              idx[k] = bi; val[k] = bv; if (bi == j) v0 = -INFINITY; if (bi == j + 16) v1 = -INFINITY; }
          if (j == 0) { float ex[4], sum = 0.f;
#pragma unroll
              for (int k = 0; k < 4; ++k) { ex[k] = __expf(val[k] - val[0]); sum += ex[k]; }
              const float inv = 1.0f / sum; const int t = r0 + tok;
              *(int __attribute__((ext_vector_type(4)))*)(TOPI + t * 4) = (int __attribute__((ext_vector_type(4)))){idx[0], idx[1], idx[2], idx[3]};
              *(f32x4*)(TOPW + t * 4) = (f32x4){ex[0] * inv, ex[1] * inv, ex[2] * inv, ex[3] * inv};
#pragma unroll
              for (int k = 0; k < 4; ++k) atomicAdd((int*)&hist[idx[k]], 1); } }
#pragma unroll
        for (int rr = 0; rr < 4; ++rr) { const int row = 4 * wave + rr; const float rstd = rstd_s[row];
            const bf16_t* xr = H2 + (size_t)(r0 + row) * DM; unsigned char* orow = XN3 + (size_t)(r0 + row) * DM; const float r8 = rstd * 8.0f;
#pragma unroll
            for (int j = 0; j < 4; ++j) { f32x4 v0, v1; pg8::unpack8(((const u32x4*)xr)[lane + 64 * j], v0, v1);
                const f32x4 o0 = v0 * r8 * ((const f32x4*)gffn)[2 * (lane + 64 * j)], o1 = v1 * r8 * ((const f32x4*)gffn)[2 * (lane + 64 * j) + 1];
                u32x2 w; w.x = pg8::pk4_fp8(o0[0], o0[1], o0[2], o0[3]); w.y = pg8::pk4_fp8(o1[0], o1[1], o1[2], o1[3]); ((u32x2*)orow)[lane + 64 * j] = w; } }
        __syncthreads();
        if (tid < 32) { const int h = hist[tid]; if (h) atomicAdd(F.ctl + CW_CNT + tid, (unsigned)h); }
    }
}
__device__ __forceinline__ void route_r2(Frame& F) {
    const int* TOPI = WSP(int, WS_TOPI); const float* TOPW = WSP(float, WS_TOPW);
    int* ROWSLOT = WSP(int, WS_ROWSLOT); float* ROWW = WSP(float, WS_ROWW); unsigned short* ROWTOK = WSP(unsigned short, WS_ROWTOK);
    LAS int* pst = (LAS int*)F.lds; LAS int* lcnt = pst + 32; LAS int* lbase = pst + 64; LAS int* tmpc = pst + 96;
    int tid = threadIdx.x; asm volatile("" : "+v"(tid));
    if (tid < 32) { const unsigned c = __hip_atomic_load(F.ctl + CW_CNT + tid, __ATOMIC_RELAXED, __HIP_MEMORY_SCOPE_AGENT); tmpc[tid] = (int)((c + 255u) & ~255u); }
    __syncthreads();
    if (tid == 0) { int a = 0; for (int e = 0; e < 32; ++e) { pst[e] = a; a += tmpc[e]; } }
    __syncthreads();
    for (int task = F.vcu; task < T / 64; task += F.G) {
        if (tid < 32) lcnt[tid] = 0;
        __syncthreads();
        int e = 0, rank = 0, t = 0, k = 0; float w = 0.f;
        if (tid < 256) { t = 64 * task + (tid >> 2); k = tid & 3; e = TOPI[t * 4 + k]; w = TOPW[t * 4 + k]; rank = atomicAdd((int*)&lcnt[e], 1); }
        __syncthreads();
        if (tid < 32) { const int n = lcnt[tid]; lbase[tid] = n ? (int)atomicAdd(F.ctl + CW_CUR + tid, (unsigned)n) : 0; }
        __syncthreads();
        if (tid < 256) { const int p = pst[e] + lbase[e] + rank; ROWSLOT[p] = t * 4 + k; ROWW[p] = w; ROWTOK[((p >> 8) * 64 + (p & 63)) * 4 + ((p >> 6) & 3)] = (unsigned short)t; }
        __syncthreads();
    }
}
__device__ __forceinline__ int moe_tile_table(Frame& F) {
    LAS int* tab = (LAS int*)(F.lds + LDS_TAB_OFF); LAS int* pt = tab + 304;
    int tid = threadIdx.x; asm volatile("" : "+v"(tid));
    __syncthreads();
    if (tid < 32) { const unsigned c = __hip_atomic_load(F.ctl + CW_CNT + tid, __ATOMIC_RELAXED, __HIP_MEMORY_SCOPE_AGENT); pt[40 + tid] = (int)((c + 255u) >> 8); }
    __syncthreads();
    if (tid == 0) { int a = 0; for (int e = 0; e < 32; ++e) { pt[e] = a; a += pt[40 + e]; } pt[32] = a; tab[300] = a; }
    __syncthreads();
    const int total = tab[300];
    for (int j = tid; j < total; j += NTHR) { int e = 0; for (int x = 0; x < 32; ++x) if (pt[x + 1] <= j) e = x + 1; tab[j] = e; }
    __syncthreads();
    return total;
}
__device__ __forceinline__ void final_phase(Frame& F) {
    const bf16_t* H2 = WSP(bf16_t, WS_H); const unsigned char* MO = WSP(unsigned char, WS_MOEOUT); const float* gain = F.in[24];
    int lane = threadIdx.x; asm volatile("" : "+v"(lane)); lane &= 63;
    const int gw = F.vcu * NWAVES + F.wave, NGW = F.G * NWAVES;
    for (int r = gw; r < T; r += NGW) {
        f32x4 v[8];
#pragma unroll
        for (int j = 0; j < 8; ++j) { const u32x2 w = ((const u32x2*)(H2 + (size_t)r * DM))[lane + 64 * j]; v[j] = (f32x4){bf_lo(w.x), bf_hi(w.x), bf_lo(w.y), bf_hi(w.y)}; }
#pragma unroll
        for (int k = 0; k < 4; ++k) { const unsigned* mr = (const unsigned*)(MO + (size_t)(4 * r + k) * DM);
#pragma unroll
            for (int j = 0; j < 8; ++j) { const unsigned w = mr[lane + 64 * j]; const f32x2 lo = __builtin_amdgcn_cvt_pk_f32_fp8((int)w, false), hi = __builtin_amdgcn_cvt_pk_f32_fp8((int)w, true);
                v[j][0] += lo[0] * (1.0f / 32.0f); v[j][1] += lo[1] * (1.0f / 32.0f); v[j][2] += hi[0] * (1.0f / 32.0f); v[j][3] += hi[1] * (1.0f / 32.0f); } }
        float s = 0.f;
#pragma unroll
        for (int j = 0; j < 8; ++j) s += (v[j][0] * v[j][0] + v[j][1] * v[j][1]) + (v[j][2] * v[j][2] + v[j][3] * v[j][3]);
        const float rstd = 1.0f / sqrtf(wave_sum(s) * (1.0f / DM) + RMS_EPS);
#pragma unroll
        for (int j = 0; j < 8; ++j) { const f32x4 g = ((const f32x4*)gain)[lane + 64 * j]; ((f32x4*)(F.out + (size_t)r * DM))[lane + 64 * j] = v[j] * rstd * g; }
    }
}

namespace att {
constexpr int VP = 72;
__device__ __forceinline__ int pi32(int m) { return (m & ~12) | ((m & 4) << 1) | ((m & 8) >> 1); }
__device__ __forceinline__ float pmax(float v) { auto rr = __builtin_amdgcn_permlane32_swap(__float_as_uint(v), __float_as_uint(v), false, false); return fmaxf(__uint_as_float(rr[0]), __uint_as_float(rr[1])); }
__device__ __forceinline__ float max3f(float a, float b, float c) { float r; asm("v_max3_f32 %0, %1, %2, %3" : "=v"(r) : "v"(a), "v"(b), "v"(c)); return r; }
__device__ __forceinline__ float psum(float v) { auto rr = __builtin_amdgcn_permlane32_swap(__float_as_uint(v), __float_as_uint(v), false, false); return __uint_as_float(rr[0]) + __uint_as_float(rr[1]); }

template <int DQK, int DV, int MASK>
__device__ __forceinline__ void tile_compute(const LAS bf16_t* Ks, const LAS bf16_t* Vs, const bf16x8 (&qf)[DQK / 16], f32x16 (&cin)[2], f32x16 (&o)[DV / 32], float& l, float& mtot,
                                             bool first, bool domask, int qpos, int kbase, int lane) {
    constexpr int KP = DQK + 8, NDS = DQK / 16, NDB = DV / 32;
    const int ql = lane & 31, hi = lane >> 5;
    f32x16 p[2];
#pragma unroll
    for (int j = 0; j < 2; ++j) { const LAS bf16_t* kr = Ks + (32 * j + pi32(ql)) * KP + 8 * hi;
#pragma unroll
        for (int ds = 0; ds < NDS; ++ds) { const bf16x8 kf = *(const LAS bf16x8*)(kr + 16 * ds);
            p[j] = __builtin_amdgcn_mfma_f32_32x32x16_bf16(kf, qf[ds], ds == 0 ? cin[j] : p[j], 0, 0, 0); } }
    if (MASK != 0 && domask) {
#pragma unroll
        for (int j = 0; j < 2; ++j)
#pragma unroll
            for (int r = 0; r < 16; ++r) { const int key = kbase + 32 * j + 16 * (r >> 3) + 8 * hi + (r & 7);
                bool ok = key <= qpos; if (MASK == 2) ok = ok && (key > qpos - 128);
                p[j][r] = ok ? p[j][r] : -INFINITY; }
    }
    float mx = fmaxf(p[0][0], p[1][0]);
#pragma unroll
    for (int r = 1; r < 16; ++r) mx = fmaxf(mx, fmaxf(p[0][r], p[1][r]));
    mx = pmax(mx);
    if (first || __any(mx > 10.0f)) {
        const float delta = first ? mx : fmaxf(mx, 0.f);
#pragma unroll
        for (int j = 0; j < 2; ++j)
#pragma unroll
            for (int r = 0; r < 16; ++r) { p[j][r] -= delta; cin[j][r] -= delta; }
        mtot += delta;
        if (!first) { const float alpha = __builtin_amdgcn_exp2f(-delta); l *= alpha;
#pragma unroll
            for (int db = 0; db < NDB; ++db)
#pragma unroll
                for (int r = 0; r < 16; ++r) o[db][r] *= alpha; }
    }
    float s = 0.f;
#pragma unroll
    for (int j = 0; j < 2; ++j)
#pragma unroll
        for (int r = 0; r < 16; ++r) { p[j][r] = __builtin_amdgcn_exp2f(p[j][r]); s += p[j][r]; }
    l += s;
#pragma unroll
    for (int st = 0; st < 4; ++st) { const int j = st >> 1, a = st & 1;
        u32x4 pw; pw.x = pk2(p[j][8 * a + 0], p[j][8 * a + 1]); pw.y = pk2(p[j][8 * a + 2], p[j][8 * a + 3]); pw.z = pk2(p[j][8 * a + 4], p[j][8 * a + 5]); pw.w = pk2(p[j][8 * a + 6], p[j][8 * a + 7]);
        const bf16x8 pf = __builtin_bit_cast(bf16x8, pw);
#pragma unroll
        for (int db = 0; db < NDB; ++db) { const bf16x8 vf = *(const LAS bf16x8*)(Vs + (32 * db + ql) * VP + 16 * st + 8 * hi);
            o[db] = __builtin_amdgcn_mfma_f32_32x32x16_bf16(vf, pf, o[db], 0, 0, 0); } }
}
template <bool ALIBI>
__device__ __forceinline__ void cin_init(f32x16 (&cin)[2], float slope2, int kbase, int qpos, int hi) {
#pragma unroll
    for (int j = 0; j < 2; ++j)
#pragma unroll
        for (int r = 0; r < 16; ++r) cin[j][r] = ALIBI ? slope2 * (float)(kbase + 32 * j + 16 * (r >> 3) + 8 * hi + (r & 7) - qpos) : 0.f;
}

__device__ __forceinline__ int swz7(int row) { return (row ^ (row >> 3)) & 7; }
template <int MASK, int NKM = 1>
__device__ __forceinline__ void tile_compute_sw(unsigned slot, int kmat, const unsigned (&krow)[2], const unsigned (&kswz)[2], const unsigned (&vrow)[4], const unsigned (&vswz)[4],
                                                const bf16x8 (&qf)[4 * NKM], float slope2, f32x16 (&o)[4], float& l, float& mtot, bool first, bool domask, int qpos, int kbase, int lane) {
    const int hi = lane >> 5;
    const float base = slope2 * (float)(kbase - qpos + 8 * hi) - mtot;
    f32x16 p[2];
#pragma unroll
    for (int km = 0; km < NKM; ++km) {
        bf16x8 kf[2][4];
#pragma unroll
        for (int j = 0; j < 2; ++j)
#pragma unroll
            for (int ds = 0; ds < 4; ++ds) kf[j][ds] = *(const LAS bf16x8*)(unsigned long)(slot + (kmat + km) * 8192 + krow[j] + ((unsigned)(32 * ds + 16 * hi) ^ kswz[j]));
        __builtin_amdgcn_sched_barrier(0);
        if (km == 0) {
#pragma unroll
            for (int j = 0; j < 2; ++j)
#pragma unroll
                for (int r = 0; r < 16; ++r) p[j][r] = __builtin_fmaf(slope2, (float)(32 * j + 16 * (r >> 3) + (r & 7)), base);
        }
#pragma unroll
        for (int j = 0; j < 2; ++j)
#pragma unroll
            for (int ds = 0; ds < 4; ++ds) p[j] = __builtin_amdgcn_mfma_f32_32x32x16_bf16(kf[j][ds], qf[4 * km + ds], p[j], 0, 0, 0);
    }
    asm volatile("s_nop 15\n\ts_nop 7" : "+v"(p[0]), "+v"(p[1]));
    bf16x8 vf[4];
#pragma unroll
    for (int db = 0; db < 4; ++db) vf[db] = *(const LAS bf16x8*)(unsigned long)(slot + 16384 + vrow[db] + ((unsigned)(16 * hi) ^ vswz[db]));
    if (MASK != 0 && domask) {
#pragma unroll
        for (int j = 0; j < 2; ++j)
#pragma unroll
            for (int r = 0; r < 16; ++r) { const int key = kbase + 32 * j + 16 * (r >> 3) + 8 * hi + (r & 7); p[j][r] = key <= qpos ? p[j][r] : -INFINITY; }
    }
    float mx = max3f(p[0][0], p[1][0], p[0][1]);
#pragma unroll
    for (int r = 1; r < 15; ++r) mx = max3f(mx, p[1][r], p[0][r + 1]);
    mx = max3f(mx, p[1][15], mx);
    mx = pmax(mx);
    if (first || __any(mx > 10.0f)) {
        const float delta = first ? mx : fmaxf(mx, 0.f);
#pragma unroll
        for (int j = 0; j < 2; ++j)
#pragma unroll
            for (int r = 0; r < 16; ++r) p[j][r] -= delta;
        mtot += delta;
        if (!first) { const float alpha = __builtin_amdgcn_exp2f(-delta); l *= alpha;
#pragma unroll
            for (int db = 0; db < 4; ++db)
#pragma unroll
                for (int r = 0; r < 16; ++r) o[db][r] *= alpha; }
    }
    float s = 0.f;
    u32x4 pw;
#define EXPPACK(st_) do { const int j_ = (st_) >> 1, a_ = (st_) & 1; \
        _Pragma("unroll") for (int r = 0; r < 8; ++r) { p[j_][8 * a_ + r] = __builtin_amdgcn_exp2f(p[j_][8 * a_ + r]); s += p[j_][8 * a_ + r]; } \
        pw.x = pk2(p[j_][8 * a_ + 0], p[j_][8 * a_ + 1]); pw.y = pk2(p[j_][8 * a_ + 2], p[j_][8 * a_ + 3]); pw.z = pk2(p[j_][8 * a_ + 4], p[j_][8 * a_ + 5]); pw.w = pk2(p[j_][8 * a_ + 6], p[j_][8 * a_ + 7]); } while (0)
    EXPPACK(0);
#pragma unroll
    for (int st = 0; st < 4; ++st) {
        const bf16x8 pf = __builtin_bit_cast(bf16x8, pw);
        bf16x8 vn[4];
        if (st < 3) {
#pragma unroll
            for (int db = 0; db < 4; ++db) vn[db] = *(const LAS bf16x8*)(unsigned long)(slot + 16384 + vrow[db] + ((unsigned)(32 * (st + 1) + 16 * hi) ^ vswz[db])); }
        __builtin_amdgcn_sched_barrier(0);
#pragma unroll
        for (int db = 0; db < 4; ++db) o[db] = __builtin_amdgcn_mfma_f32_32x32x16_bf16(vf[db], pf, o[db], 0, 0, 0);
        if (st < 3) { EXPPACK(st + 1);
#pragma unroll
            for (int db = 0; db < 4; ++db) vf[db] = vn[db]; } }
#undef EXPPACK
    l += s;
}
__device__ __forceinline__ void diff_unit(LAS unsigned char* lds, const bf16_t* PROJ, const bf16_t* VT, bf16_t* YD, const float* subg, float lam, const unsigned* kmax2, int b, int h, int i) {
    int tid = threadIdx.x; asm volatile("" : "+v"(tid)); const int lane = tid & 63, wid = __builtin_amdgcn_readfirstlane(tid >> 6), ql = lane & 31, hi = lane >> 5, c = wid >> 2, w4 = wid & 3;
    const int qw0 = 128 * i + 32 * w4, qpos = qw0 + ql;
    const size_t rowbase = (size_t)b * SEQ;
    constexpr unsigned SLOT = 32768;
    const unsigned lds0 = (unsigned)(unsigned long)lds;
    LAS unsigned* flags = (LAS unsigned*)(lds + LDS_FLAG_OFF);
    if (lane == 0) { flags[wid] = 0u; flags[8 + wid] = 0u; }
    bool wdone = false;
    const int R = 8 * wid + (lane >> 3), cp = lane & 7;
    const unsigned voffK = (unsigned)(R * NPROJ + 8 * (cp ^ swz7(R))) * 2u;
    const unsigned voffV0 = (unsigned)(R * T + 8 * (cp ^ swz7(R))) * 2u, voffV1 = (unsigned)((R + 64) * T + 8 * (cp ^ swz7(R + 64))) * 2u;
    const char* Kbase = (const char*)(PROJ + rowbase * NPROJ + PC_KD + h * 128);
    const char* Vbase = (const char*)(VT + (size_t)(256 + h * 128) * T + rowbase);
    const unsigned pdst = lds0 + (unsigned)wid * 1024u;
#define DIFF_DMA(t, so) do { const char* kb_ = Kbase + (size_t)(t) * (64 * NPROJ * 2); const char* vb_ = Vbase + (size_t)(t) * 128; \
        pg8::glds16_s(kb_, voffK, pdst + (so)); pg8::glds16_s(kb_ + 128, voffK, pdst + (so) + 8192u); \
        pg8::glds16_s(vb_, voffV0, pdst + (so) + 16384u); pg8::glds16_s(vb_, voffV1, pdst + (so) + 24576u); } while (0)
    unsigned krow[2], kswz[2], vrow[4], vswz[4];
#pragma unroll
    for (int j = 0; j < 2; ++j) { const int row = 32 * j + pi32(ql); krow[j] = (unsigned)row * 128u; kswz[j] = (unsigned)swz7(row) * 16u; }
#pragma unroll
    for (int db = 0; db < 4; ++db) { const int row = 32 * db + ql; vrow[db] = (unsigned)row * 128u; vswz[db] = (unsigned)swz7(row) * 16u; }
    const float slope2 = __builtin_amdgcn_exp2f(-(float)(h + 1)) * LOG2E;
    f32x16 o[4]; float l = 0.f, mtot = 0.f;
#pragma unroll
    for (int db = 0; db < 4; ++db) o[db] = f32x16{};
    const int thi = 2 * i + 1;
    DIFF_DMA(thi, 0u);
    DIFF_DMA(thi - 1, SLOT);
    bf16x8 qf[4];
    { const bf16_t* Qp = PROJ + (rowbase + qpos) * NPROJ + PC_QD + h * 128 + c * 64 + 8 * hi;
#pragma unroll
      for (int ds = 0; ds < 4; ++ds) qf[ds] = *(const bf16x8*)(Qp + 16 * ds); }
    unsigned kmx_bits = __hip_atomic_load(kmax2 + (b * 8 + h) * 2 + c, __ATOMIC_RELAXED, __HIP_MEMORY_SCOPE_AGENT);
    asm volatile("s_waitcnt vmcnt(0)" ::: "memory");
    asm volatile("" : "+v"(qf[0]), "+v"(qf[1]), "+v"(qf[2]), "+v"(qf[3]), "+v"(kmx_bits));
    const float kmx = sqrtf(__uint_as_float(kmx_bits)) * 1.001f;
    float qk_bound;
    { float s2 = 0.f;
#pragma unroll
      for (int ds = 0; ds < 4; ++ds) { const u32x4 w = __builtin_bit_cast(u32x4, qf[ds]);
#pragma unroll
          for (int e = 0; e < 4; ++e) { const float a = bf_lo(w[e]), b2 = bf_hi(w[e]); s2 += a * a + b2 * b2; } }
      qk_bound = sqrtf(psum(s2)) * 1.001f * kmx; }
    unsigned so = 0u; bool first = true;
    if (wid >= 4) __builtin_amdgcn_s_setprio(1);
    for (int t = thi; t >= 0; --t) {
        if (t >= 1) asm volatile("s_waitcnt vmcnt(4) lgkmcnt(0)\n\ts_barrier" ::: "memory"); else asm volatile("s_waitcnt vmcnt(0) lgkmcnt(0)\n\ts_barrier" ::: "memory");
        { const LAS unsigned* fs = flags + ((t + 1) & 1) * 8; const u32x4 f0 = *(const LAS u32x4*)fs, f1 = *(const LAS u32x4*)(fs + 4);
          if ((f0.x & f0.y & f0.z & f0.w & f1.x & f1.y & f1.z & f1.w) != 0u) break; }
        if (t >= 2) { const unsigned sn = so >= SLOT ? so - SLOT : so + 2 * SLOT; DIFF_DMA(t - 2, sn); }
        const int kbase = 64 * t;
        if (kbase <= qw0 + 31 && !wdone) {
            tile_compute_sw<1>(lds0 + so, c, krow, kswz, vrow, vswz, qf, slope2, o, l, mtot, first, kbase + 63 > qw0, qpos, kbase, lane);
            first = false;
            const float emax = qk_bound - slope2 * (float)(qpos - kbase + 1) - mtot;
            if (__all(emax < -127.0f)) wdone = true;
        }
        if (lane == 0) flags[(t & 1) * 8 + wid] = wdone ? 1u : 0u;
        so = so >= 2 * SLOT ? 0u : so + SLOT;
    }
    asm volatile("s_waitcnt vmcnt(0)" ::: "memory");
#undef DIFF_DMA
    __builtin_amdgcn_s_setprio(0);
    const float inv = 1.0f / psum(l);
    __syncthreads();
    LAS float* X = (LAS float*)lds + w4 * 4096;
    if (c == 1) {
#pragma unroll
        for (int db = 0; db < 4; ++db)
#pragma unroll
            for (int r = 0; r < 16; ++r) X[(db * 16 + r) * 64 + lane] = o[db][r] * inv;
    }
    __syncthreads();
    if (c == 0) {
        float ss = 0.f;
#pragma unroll
        for (int db = 0; db < 4; ++db)
#pragma unroll
            for (int r = 0; r < 16; ++r) { const float d = o[db][r] * inv - lam * X[(db * 16 + r) * 64 + lane]; o[db][r] = d; ss += d * d; }
        ss = psum(ss);
        const float rstd = 0.8f / sqrtf(ss * (1.0f / 128.0f) + RMS_EPS);
        bf16_t* yp = YD + (rowbase + qpos) * 1024 + h * 128 + 4 * hi;
#pragma unroll
        for (int db = 0; db < 4; ++db)
#pragma unroll
            for (int g4 = 0; g4 < 4; ++g4) { const f32x4 g = *(const f32x4*)(subg + 32 * db + 8 * g4 + 4 * hi);
                u32x2 w; w.x = pk2(o[db][4 * g4] * rstd * g[0], o[db][4 * g4 + 1] * rstd * g[1]); w.y = pk2(o[db][4 * g4 + 2] * rstd * g[2], o[db][4 * g4 + 3] * rstd * g[3]);
                *(u32x2*)(yp + 32 * db + 8 * g4) = w; }
    }
    __syncthreads();
}

__device__ __forceinline__ void swa_unit(LAS unsigned char* lds, const bf16_t* PROJ, const bf16_t* VT, bf16_t* YA, const float* sinks, int b, int hk, int i) {
    int tid = threadIdx.x; asm volatile("" : "+v"(tid)); const int lane = tid & 63, wid = __builtin_amdgcn_readfirstlane(tid >> 6), ql = lane & 31, hi = lane >> 5;
    const int hq = hk * 4 + (wid >> 1), qw0 = 64 * i + 32 * (wid & 1), qpos = qw0 + ql;
    const size_t rowbase = (size_t)b * SEQ;
    constexpr int BUF = 18432, VOFF = 9216;
    bf16x8 qf[4];
    { const bf16_t* Qp = PROJ + (rowbase + qpos) * NPROJ + PC_QA + hq * 64 + 8 * hi;
#pragma unroll
      for (int ds = 0; ds < 4; ++ds) qf[ds] = *(const bf16x8*)(Qp + 16 * ds); }
    const int krow = tid >> 3, kch = tid & 7;
    const bf16_t* Kg = PROJ + (rowbase + krow) * NPROJ + PC_KA + hk * 64 + kch * 8;
    const bf16_t* Vg = VT + (size_t)(hk * 64 + krow) * T + rowbase + kch * 8;
    const int sdst = (krow * 72 + kch * 8) * 2;
    const float slope2 = __builtin_amdgcn_exp2f(-0.5f * (float)(hq + 1)) * LOG2E;
    f32x16 cin[2], o[2]; float l = 0.f, mtot = 0.f;
    o[0] = f32x16{}; o[1] = f32x16{};
    u32x4 sk, sv;
    const int thi = i, tlo = i >= 2 ? i - 2 : 0;
    sk = *(const u32x4*)(Kg + (size_t)thi * 64 * NPROJ); sv = *(const u32x4*)(Vg + thi * 64);
    int bo = 0; bool first = true;
    for (int t = thi; t >= tlo; --t) {
        *(LAS u32x4*)(lds + bo + sdst) = sk; *(LAS u32x4*)(lds + bo + VOFF + sdst) = sv;
        __syncthreads();
        if (t > tlo) { sk = *(const u32x4*)(Kg + (size_t)(t - 1) * 64 * NPROJ); sv = *(const u32x4*)(Vg + (t - 1) * 64); }
        const int kbase = 64 * t;
        if (first) cin_init<true>(cin, slope2, kbase, qpos, hi);
        tile_compute<64, 64, 2>((const LAS bf16_t*)(lds + bo), (const LAS bf16_t*)(lds + bo + VOFF), qf, cin, o, l, mtot, first, true, qpos, kbase, lane);
        first = false;
        const float step = 64.f * slope2;
#pragma unroll
        for (int j = 0; j < 2; ++j)
#pragma unroll
            for (int r = 0; r < 16; ++r) cin[j][r] -= step;
        bo ^= BUF;
    }
    const float lt = psum(l), sink2 = sinks[hq] * LOG2E, M = fmaxf(mtot, sink2), f = __builtin_amdgcn_exp2f(mtot - M);
    const float sc = f / (lt * f + __builtin_amdgcn_exp2f(sink2 - M));
    bf16_t* yp = YA + (rowbase + qpos) * 1024 + hq * 64 + 4 * hi;
#pragma unroll
    for (int db = 0; db < 2; ++db)
#pragma unroll
        for (int g4 = 0; g4 < 4; ++g4) { u32x2 w; w.x = pk2(o[db][4 * g4] * sc, o[db][4 * g4 + 1] * sc); w.y = pk2(o[db][4 * g4 + 2] * sc, o[db][4 * g4 + 3] * sc);
            *(u32x2*)(yp + 32 * db + 8 * g4) = w; }
    __syncthreads();
}

__device__ __forceinline__ void cross_unit(LAS unsigned char* lds, const bf16_t* QC, const bf16_t* KM, const bf16_t* VMT, bf16_t* OC, int b, int h, int i) {
    int tid = threadIdx.x; asm volatile("" : "+v"(tid)); const int lane = tid & 63, wid = __builtin_amdgcn_readfirstlane(tid >> 6), ql = lane & 31, hi = lane >> 5;
    const int qpos = 256 * i + 32 * wid + ql;
    const size_t rowbase = (size_t)b * SEQ;
    const unsigned lds0 = (unsigned)(unsigned long)lds;
    bf16x8 qf[8];
    { const bf16_t* Qp = QC + (rowbase + qpos) * 512 + h * 128 + 8 * hi;
#pragma unroll
      for (int ds = 0; ds < 8; ++ds) qf[ds] = *(const bf16x8*)(Qp + 16 * ds); }
    const int kr0 = tid >> 4, kc0 = tid & 15, vr0 = tid >> 3, vc0 = tid & 7;
    const bf16_t* Kg = KM + (size_t)(b * 256 + kr0) * 512 + h * 128 + kc0 * 8;
    const bf16_t* Vg = VMT + (size_t)(h * 128 + vr0) * 512 + b * 256 + vc0 * 8;
    const unsigned kd0 = (unsigned)((kc0 >> 3) * 8192 + kr0 * 128 + (((kc0 & 7) ^ swz7(kr0)) * 16)), kd1 = (unsigned)((kc0 >> 3) * 8192 + (kr0 + 32) * 128 + (((kc0 & 7) ^ swz7(kr0 + 32)) * 16));
    const unsigned vd0 = (unsigned)(16384 + vr0 * 128 + ((vc0 ^ swz7(vr0)) * 16)), vd1 = (unsigned)(16384 + (vr0 + 64) * 128 + ((vc0 ^ swz7(vr0 + 64)) * 16));
    unsigned krow[2], kswz[2], vrow[4], vswz[4];
#pragma unroll
    for (int j = 0; j < 2; ++j) { const int row = 32 * j + pi32(ql); krow[j] = (unsigned)row * 128u; kswz[j] = (unsigned)swz7(row) * 16u; }
#pragma unroll
    for (int db = 0; db < 4; ++db) { const int row = 32 * db + ql; vrow[db] = (unsigned)row * 128u; vswz[db] = (unsigned)swz7(row) * 16u; }
    f32x16 o[4]; float l = 0.f, mtot = 0.f;
#pragma unroll
    for (int db = 0; db < 4; ++db) o[db] = f32x16{};
    u32x4 sk0, sk1, sv0, sv1;
#define CR_LOAD(t) do { sk0 = *(const u32x4*)(Kg + (size_t)(t) * 64 * 512); sk1 = *(const u32x4*)(Kg + (size_t)((t) * 64 + 32) * 512); \
        sv0 = *(const u32x4*)(Vg + (t) * 64); sv1 = *(const u32x4*)(Vg + (size_t)64 * 512 + (t) * 64); } while (0)
    CR_LOAD(3);
    unsigned so = 0u; bool first = true;
    for (int t = 3; t >= 0; --t) {
        *(LAS u32x4*)(lds + so + kd0) = sk0; *(LAS u32x4*)(lds + so + kd1) = sk1;
        *(LAS u32x4*)(lds + so + vd0) = sv0; *(LAS u32x4*)(lds + so + vd1) = sv1;
        __syncthreads();
        if (t > 0) CR_LOAD(t - 1);
        tile_compute_sw<0, 2>(lds0 + so, 0, krow, kswz, vrow, vswz, qf, 0.f, o, l, mtot, first, false, qpos, 64 * t, lane);
        first = false;
        so ^= 32768u;
    }
#undef CR_LOAD
    const float inv = 1.0f / psum(l);
    bf16_t* yp = OC + (rowbase + qpos) * 512 + h * 128 + 4 * hi;
#pragma unroll
    for (int db = 0; db < 4; ++db)
#pragma unroll
        for (int g4 = 0; g4 < 4; ++g4) { u32x2 w; w.x = pk2(o[db][4 * g4] * inv, o[db][4 * g4 + 1] * inv); w.y = pk2(o[db][4 * g4 + 2] * inv, o[db][4 * g4 + 3] * inv);
            *(u32x2*)(yp + 32 * db + 8 * g4) = w; }
    __syncthreads();
}
}

constexpr int NPHASES = 14;
struct Args { const float* in[25]; float* out; unsigned char* ws; int ph_lo, ph_hi; };

__global__ void __launch_bounds__(NTHR, 2) mk_fwd(Args args) {
    extern __shared__ __attribute__((aligned(16))) unsigned char lds_raw[];
    Frame F;
    F.lds = (LAS unsigned char*)lds_raw;
    F.wave = __builtin_amdgcn_readfirstlane(threadIdx.x >> 6);
    F.G = gridDim.x; { const int bx = blockIdx.x; F.vcu = (F.G % 8 == 0) ? (bx % 8) * (F.G / 8) + bx / 8 : bx; }
    F.ws = args.ws; F.ctl = (unsigned*)(args.ws + WS_CTL); F.out = args.out;
#pragma unroll
    for (int i = 0; i < 25; ++i) F.in[i] = args.in[i];
    volatile LAS unsigned* MISC = (volatile LAS unsigned*)(F.lds + LDS_MISC_OFF);
    if (threadIdx.x < 64) MISC[threadIdx.x] = 0u;
    __syncthreads();
    XcdBarrier bar; bar.bar = F.ctl + CW_BAR; bar.x = 0; bar.st = nullptr;
    const int lo = args.ph_lo, hi = args.ph_hi;
    if (hi - lo > 1) bar = xcd_barrier_post(F.ctl + CW_BAR, MISC + 8);
#define IN(k) (lo <= (k) && (k) < hi)
#define SEAM(k) do { if (IN(k) && IN((k) + 1)) xcd_barrier(bar); } while (0)
    LAS unsigned char* lds = F.lds;
    const int bid = blockIdx.x;
    bf16_t* XN = WSP(bf16_t, WS_XN); bf16_t* PROJ = WSP(bf16_t, WS_PROJ); bf16_t* VT = WSP(bf16_t, WS_VT); bf16_t* YA = WSP(bf16_t, WS_YA); bf16_t* YD = WSP(bf16_t, WS_YD);
    bf16_t* MERGED = WSP(bf16_t, WS_MERGED); bf16_t* H = WSP(bf16_t, WS_H); bf16_t* MEMN = WSP(bf16_t, WS_MEMN); bf16_t* KM = WSP(bf16_t, WS_KM); bf16_t* VMT = WSP(bf16_t, WS_VMT);
    bf16_t* QC = WSP(bf16_t, WS_QC); bf16_t* OC = WSP(bf16_t, WS_OC);

    if (IN(0)) { p0_prologue(F); }
    SEAM(0);
    if (IN(1)) {
        const pg8::Gemm g{DM, (size_t)128 * DM * 2};
        pg8::ProjOrder S{XN, WSP(bf16_t, WS_WIN), MEMN, WSP(bf16_t, WS_WCKV), F.G, bid}; pg8::EpiProjAll E{PROJ, VT, KM, VMT};
        pg8::gemm_phase<pg8::EpiProjAll, pg8::ProjOrder, true, true>(lds, g, S, E);
        { const pg8::Gemm g8{DM / 2, (size_t)128 * DM};
          pg8::StaticOrder S8; S8.init(WSP(bf16_t, WS_XN8), WSP(bf16_t, WS_WING8), T, 4096, DM / 2, F.G, bid); pg8::EpiGate E8{WSP(unsigned char, WS_G8)};
          pg8::gemm_phase<pg8::EpiGate, pg8::StaticOrder, true, true, true>(lds, g8, S8, E8); }
    }
    if (IN(1) && IN(2)) conv_filler<8>(F, 1);
    SEAM(1);
    if (IN(2)) {
        { int l_ = threadIdx.x; asm volatile("" : "+v"(l_)); l_ &= 63; float mx0 = 0.f, mx1 = 0.f;
          const int rs = F.G * NWAVES;
          for (int r = F.vcu * NWAVES + F.wave; r < T; r += 4 * rs) {
              u32x4 w0[4], w1[4];
#pragma unroll
              for (int q = 0; q < 4; ++q) { const int rq = r + q * rs; const u32x4* kp = (const u32x4*)(PROJ + (size_t)(rq < T ? rq : r) * NPROJ + PC_KD + 16 * l_); w0[q] = kp[0]; w1[q] = kp[1]; }
#pragma unroll
              for (int q = 0; q < 4; ++q) { const int rq = r + q * rs; float s2 = 0.f;
#pragma unroll
                  for (int e = 0; e < 4; ++e) { const float a0 = bf_lo(w0[q][e]), a1 = bf_hi(w0[q][e]), a2 = bf_lo(w1[q][e]), a3 = bf_hi(w1[q][e]); s2 += (a0 * a0 + a1 * a1) + (a2 * a2 + a3 * a3); }
                  s2 += __shfl_xor(s2, 1); s2 += __shfl_xor(s2, 2);
                  if (rq < T) { if (rq < SEQ) mx0 = fmaxf(mx0, s2); else mx1 = fmaxf(mx1, s2); } } }
          if ((l_ & 3) == 0) { atomicMax(F.ctl + CW_KMAX + (l_ >> 2), __float_as_uint(mx0)); atomicMax(F.ctl + CW_KMAX + 16 + (l_ >> 2), __float_as_uint(mx1)); } }
        asm volatile("s_waitcnt vmcnt(0)" ::: "memory");
        __syncthreads();
        if (threadIdx.x == 0) __hip_atomic_fetch_add(F.ctl + CW_KDONE, 1u, __ATOMIC_RELAXED, __HIP_MEMORY_SCOPE_AGENT);
        for (int n = F.vcu; n < 1024; n += F.G) { const int i = n & 127, bhk = n >> 7; att::swa_unit(lds, PROJ, VT, YA, F.in[4], bhk >> 2, bhk & 3, i); }
        if (threadIdx.x == 0) { while (__hip_atomic_load(F.ctl + CW_KDONE, __ATOMIC_RELAXED, __HIP_MEMORY_SCOPE_AGENT) < (unsigned)F.G) __builtin_amdgcn_s_sleep(4); }
        __syncthreads();
        float lam;
        { int l_ = threadIdx.x; asm volatile("" : "+v"(l_)); l_ &= 63; const float a = F.in[5][l_] * F.in[6][l_], b2 = F.in[7][l_] * F.in[8][l_];
          lam = __expf(wave_sum(a)) - __expf(wave_sum(b2)) + 0.2f; }
        { LAS int* qs = (LAS int*)(lds + LDS_FLAG_OFF + 128); LAS int* cost = qs + 32; LAS int* order = cost + 128;
          const int nq = (F.G % 8 == 0 && F.G >= 8) ? 8 : 1, x0 = (nq == 8) ? F.vcu / (F.G / 8) : 0, per = 1024 / nq;
          for (int qi = 0; qi < 1; ++qi) {
              const int x = (x0 + qi) % nq;
              __syncthreads();
              for (int u = threadIdx.x; u < per && nq == 8; u += NTHR) {
                  const int bh = (x >> 2) * 8 + ((u >> 6) ? 7 - (x & 3) : (x & 3)), i = u & 63;
                  const float s2 = __builtin_amdgcn_exp2f(-(float)((bh & 7) + 1)) * LOG2E; const int cut = (int)(146.0f / (s2 * 64.0f)) + 3;
                  const int c0 = 2 * i + 2; cost[u] = c0 < cut ? c0 : cut; }
              __syncthreads();
              if (nq == 8 && threadIdx.x < 128) { const int me = cost[threadIdx.x]; int r = 0; for (int u = 0; u < 128; ++u) { const int cu = cost[u]; r += (cu > me || (cu == me && u < (int)threadIdx.x)) ? 1 : 0; } order[r] = threadIdx.x; }
              int nxt = 0;
              if (threadIdx.x == 0) qs[0] = (int)atomicAdd(F.ctl + CW_QHEAD + 64 * x, 1u);
              __syncthreads();
              int n = qs[0];
              while (n < per) {
                  if (threadIdx.x == 0) nxt = (int)atomicAdd(F.ctl + CW_QHEAD + 64 * x, 1u);
                  int bh, i;
                  if (nq == 8) { const int u = order[n]; bh = (x >> 2) * 8 + ((u >> 6) ? 7 - (x & 3) : (x & 3)); i = u & 63; } else { bh = n & 15; i = 63 - (n >> 4); }
                  att::diff_unit(lds, PROJ, VT, YD, F.in[9], lam, F.ctl + CW_KMAX, bh >> 3, bh & 7, i);
                  if (threadIdx.x == 0) qs[0] = nxt;
                  __syncthreads();
                  n = qs[0];
              }
          } }
    }
    if (IN(2) && IN(3)) conv_filler<4>(F, 2);
    SEAM(2);
    if (IN(3)) {
        const pg8::Gemm g{1024, (size_t)128 * 1024 * 2};
        pg8::BranchOrder S{YA, YD, WSP(bf16_t, WS_WB), F.G, bid}; pg8::EpiBranchAll E{WSP(unsigned char, WS_G8), MERGED};
        pg8::gemm_phase<pg8::EpiBranchAll, pg8::BranchOrder, true, true>(lds, g, S, E);
    }
    SEAM(3);
    if (IN(4)) {
        const pg8::Gemm g{DM, (size_t)128 * DM * 2};
        pg8::StaticOrder S; S.init(MERGED, WSP(bf16_t, WS_WO), T, DM, DM, F.G, bid); pg8::EpiResid<false> E{F.in[0], H};
        pg8::gemm_phase<pg8::EpiResid<false>, pg8::StaticOrder, true, true>(lds, g, S, E);
    }
    SEAM(4);
    if (IN(5)) { rows_rstd_phase(F, H, WSP(float, WS_ROWSQP), F.ctl + CW_RSC, T); }
    if (IN(6)) {
        const pg8::Gemm g{DM, (size_t)128 * DM * 2};
        pg8::StaticOrder S; S.init(H, WSP(bf16_t, WS_WCQ), T, 512, DM, F.G, bid); pg8::EpiRowScale E{QC, 512, C2_128, WSP(float, WS_ROWSQP), F.ctl + CW_RSC};
        pg8::gemm_phase<pg8::EpiRowScale, pg8::StaticOrder, true, true>(lds, g, S, E);
    }
    if (IN(6) && IN(7)) conv_filler<8>(F, 6);
    SEAM(6);
    if (IN(7)) {
        for (int n = F.vcu; n < 256; n += F.G) att::cross_unit(lds, QC, KM, VMT, OC, n >> 7, (n >> 5) & 3, n & 31);
    }
    SEAM(7);
    if (IN(8)) {
        const pg8::Gemm g{512, (size_t)128 * 512 * 2};
        pg8::StaticOrder S; S.init(OC, WSP(bf16_t, WS_WCO), T, DM, 512, F.G, bid); pg8::EpiResid<true> E{H, H};
        pg8::gemm_phase<pg8::EpiResid<true>, pg8::StaticOrder, true, true>(lds, g, S, E);
    }
    SEAM(8);
    if (IN(9)) { route_r1(F); }
    SEAM(9);
    if (IN(10)) { route_r2(F); conv_filler<16>(F, -1); }
    SEAM(10);
    if (IN(11)) {
        const int ntiles = moe_tile_table(F);
        const pg8::Gemm g{DM / 2, (size_t)DFF * DM};
        pg8::MoeOrder<true> S{WSP(void, WS_XN), WSP(void, WS_WGU), (const LAS int*)(F.lds + LDS_TAB_OFF), ntiles, 16, F.G, F.vcu, (size_t)256 * DM, (size_t)2 * DFF * DM, (size_t)128 * DM, WSP(unsigned short, WS_ROWTOK)};
        pg8::EpiGlu E{F.in[21], WSP(unsigned char, WS_ACT)};
        pg8::gemm_phase<pg8::EpiGlu, pg8::MoeOrder<true>, true, true, true>(lds, g, S, E);
    }
    SEAM(11);
    if (IN(12)) {
        const int ntiles = moe_tile_table(F);
        const pg8::Gemm g{DFF / 2, (size_t)128 * DFF};
        pg8::MoeOrder<false> S{WSP(void, WS_ACT), WSP(void, WS_WD), (const LAS int*)(F.lds + LDS_TAB_OFF), ntiles, 8, F.G, F.vcu, (size_t)256 * DFF, (size_t)DM * DFF, (size_t)256 * DFF, nullptr};
        pg8::EpiDown E{F.in[23], WSP(int, WS_ROWSLOT), WSP(float, WS_ROWW), WSP(unsigned char, WS_MOEOUT)};
        pg8::gemm_phase<pg8::EpiDown, pg8::MoeOrder<false>, true, true, true>(lds, g, S, E);
    }
    SEAM(12);
    if (IN(13)) { final_phase(F); }
#undef IN
#undef SEAM
}

extern "C" void kernel_launch(void* const* d_in, const int* in_sizes, int n_in, void* d_out, int out_size, void* d_ws, size_t ws_size, hipStream_t stream) {
    static int grid = 0;
    if (grid == 0) {
        if (n_in != 25 || out_size != T * DM || ws_size < WS_END) { fprintf(stderr, "kernel_launch: unexpected shapes (n_in %d out %d ws %zu need %zu)\n", n_in, out_size, ws_size, (size_t)WS_END); grid = -1; return; }
        int dev = 0, cus = 0, per_cu = 0;
        if (hipGetDevice(&dev) != hipSuccess || hipDeviceGetAttribute(&cus, hipDeviceAttributeMultiprocessorCount, dev) != hipSuccess) { grid = -1; return; }
        if (hipFuncSetAttribute((const void*)mk_fwd, hipFuncAttributeMaxDynamicSharedMemorySize, LDS_BYTES) != hipSuccess) { fprintf(stderr, "kernel_launch: hipFuncSetAttribute failed\n"); grid = -1; return; }
        if (hipOccupancyMaxActiveBlocksPerMultiprocessor(&per_cu, (const void*)mk_fwd, NTHR, LDS_BYTES) != hipSuccess || per_cu < 1) { fprintf(stderr, "kernel_launch: occupancy query says %d\n", per_cu); (void)hipGetLastError(); }
        grid = cus;
    }
    if (grid < 0) return;
    (void)hipMemsetAsync((char*)d_ws + WS_CTL, 0, CTL_ZERO_BYTES, stream);
    Args a{};
    for (int i = 0; i < 25; ++i) a.in[i] = (const float*)d_in[i];
    a.out = (float*)d_out; a.ws = (unsigned char*)d_ws;
    a.ph_lo = 0; a.ph_hi = NPHASES;
    hipLaunchKernelGGL(mk_fwd, dim3(grid), dim3(NTHR), LDS_BYTES, stream, a);
}
```

```cpp
#include <hip/hip_runtime.h>
#include <cstdio>
#include <cstdint>

#define LAS __attribute__((address_space(3)))
#define GAS __attribute__((address_space(1)))
typedef unsigned short bf16_t;
typedef short bf16x8 __attribute__((ext_vector_type(8)));
typedef float f32x4 __attribute__((ext_vector_type(4)));
typedef float f32x2 __attribute__((ext_vector_type(2)));
typedef float f32x16 __attribute__((ext_vector_type(16)));
typedef unsigned u32x4 __attribute__((ext_vector_type(4)));
typedef unsigned u32x2 __attribute__((ext_vector_type(2)));

constexpr int BATCH = 2, SEQ = 8192, T = BATCH * SEQ, DM = 2048;
constexpr int NPROJ = 7424;
constexpr int PC_QA = 0, PC_KA = 1024, PC_QD = 1280, PC_KD = 2304, PC_G = 3328;
constexpr int NVT = 1280;
constexpr int NE = 32, TOPK = 4, DFF = 2048;
constexpr int XROWS = 73728;
constexpr int MAXTILES = XROWS / 256;
constexpr float RMS_EPS = 1e-5f;
constexpr float LOG2E = 1.4426950408889634f;
constexpr float C2_64 = 0.125f * LOG2E;
constexpr float C2_128 = 0.08838834764831845f * LOG2E;

constexpr size_t MiB = 1u << 20;
constexpr size_t WS_CTL = 0, CTL_ZERO_BYTES = 1 * MiB;
constexpr size_t WS_WIN = 2 * MiB;
constexpr size_t WS_WB = WS_WIN + 34 * MiB;
constexpr size_t WS_WO = WS_WB + 8 * MiB;
constexpr size_t WS_WCQ = WS_WO + 8 * MiB;
constexpr size_t WS_WCKV = WS_WCQ + 2 * MiB;
constexpr size_t WS_WCO = WS_WCKV + 4 * MiB;
constexpr size_t WS_WGU = WS_WCO + 2 * MiB;
constexpr size_t WS_WD = WS_WGU + 512 * MiB;
constexpr size_t WS_XN = WS_WD + 256 * MiB;
constexpr size_t WS_PROJ = WS_XN + 64 * MiB;
constexpr size_t WS_VT = WS_PROJ + 232 * MiB;
constexpr size_t WS_YA = WS_VT + 40 * MiB;
constexpr size_t WS_YD = WS_YA + 32 * MiB;
constexpr size_t WS_MERGED = WS_YD + 32 * MiB;
constexpr size_t WS_H = WS_MERGED + 64 * MiB;
constexpr size_t WS_MEMN = WS_H + 128 * MiB;
constexpr size_t WS_KM = WS_MEMN + 2 * MiB;
constexpr size_t WS_VMT = WS_KM + 1 * MiB;
constexpr size_t WS_QC = WS_VMT + 1 * MiB;
constexpr size_t WS_OC = WS_QC + 16 * MiB;
constexpr size_t WS_TOPI = WS_OC + 16 * MiB;
constexpr size_t WS_TOPW = WS_TOPI + 1 * MiB;
constexpr size_t WS_ROWSLOT = WS_TOPW + 1 * MiB;
constexpr size_t WS_ROWW = WS_ROWSLOT + 1 * MiB;
constexpr size_t WS_XG = WS_ROWW + 1 * MiB;
constexpr size_t WS_ACT = WS_XG + 288 * MiB;
constexpr size_t WS_MOEOUT = WS_ACT + 288 * MiB;
constexpr size_t WS_ROWSQP = WS_MOEOUT + 256 * MiB;
constexpr size_t WS_WING8 = WS_ROWSQP + 2 * MiB;
constexpr size_t WS_XN8 = WS_WING8 + 8 * MiB;
constexpr size_t WS_G8 = WS_XN8 + 32 * MiB;
constexpr size_t WS_WRT = WS_G8 + 64 * MiB;
constexpr size_t WS_ROWTOK = WS_WRT + 1 * MiB;
constexpr size_t WS_END = WS_ROWTOK + 1 * MiB;
constexpr int CW_CNT = 64;
constexpr int CW_CUR = 128;
constexpr int CW_QHEAD = 1024;
constexpr int CW_KMAX = 192;
constexpr int CW_KDONE = 448;
constexpr int CW_RSC = 16384;
constexpr int CW_CONV = 1920;
constexpr int CW_DONE = 2048;
constexpr int CW_BAR = 4096;

constexpr int RING_BYTES = 131072;
constexpr int LDS_FLAG_OFF = 131072;
constexpr int LDS_TAB_OFF = 134144;
constexpr int LDS_MISC_OFF = 136192;
constexpr int LDS_BYTES = 147456;
constexpr int NWAVES = 8, NTHR = 512;

__device__ __forceinline__ unsigned f2bf(float f) { unsigned u = __builtin_bit_cast(unsigned, f); return (u + 0x7fffu + ((u >> 16) & 1u)) >> 16; }
__device__ __forceinline__ unsigned pk2(float lo, float hi) { typedef __bf16 bf2 __attribute__((ext_vector_type(2))); f32x2 v = {lo, hi}; bf2 b = __builtin_convertvector(v, bf2); return __builtin_bit_cast(unsigned, b); }
__device__ __forceinline__ float bf_lo(unsigned w) { return __builtin_bit_cast(float, w << 16); }
__device__ __forceinline__ float bf_hi(unsigned w) { return __builtin_bit_cast(float, w & 0xffff0000u); }
__device__ __forceinline__ float wave_sum(float v) {
#pragma unroll
    for (int o = 1; o < 64; o <<= 1) v += __shfl_xor(v, o);
    return v;
}
#define LDS_WAIT() asm volatile("s_waitcnt lgkmcnt(0)" ::: "memory")
#define VM_WAIT() asm volatile("s_waitcnt vmcnt(0)" ::: "memory")
namespace pg8 {
#define PG8_LAS __attribute__((address_space(3)))
constexpr int BM = 256, BK = 64, HALF = 128, HTB = HALF * BK * 2  , STAGE_BYTES = 8 * HTB, NXCD = 8, WGM = 4;

__host__ __device__ __forceinline__ int lds_byte(int r, int c) { const int st = (r >> 4) * 2 + (c >> 5), rr = r & 15, cc = c & 31, ob = rr * 64 + cc * 2; return st * 1024 + (ob ^ (((ob >> 9) & 1) << 5)); }
__host__ __device__ __forceinline__ void stage_rc(int b, int& R, int& C) { const int st = b / 1024, sb = b % 1024, swz = sb ^ (((sb >> 9) & 1) << 5); R = (st >> 1) * 16 + swz / 64; C = (st & 1) * 32 + (swz % 64) / 2; }
__host__ __device__ __forceinline__ int perm32(int rho) { const int n = rho >> 4, i = rho & 15; return 8 * (i >> 2) + 4 * n + (i & 3); }

typedef int v8i_t __attribute__((ext_vector_type(8)));
__device__ __forceinline__ v8i_t cat16(bf16x8 a, bf16x8 b) { typedef int v4i_t __attribute__((ext_vector_type(4))); const v4i_t x = __builtin_bit_cast(v4i_t, a), y = __builtin_bit_cast(v4i_t, b); return (v8i_t){x[0], x[1], x[2], x[3], y[0], y[1], y[2], y[3]}; }
__device__ __forceinline__ void glds16_s(const char* sbase, unsigned voff, unsigned ldsdst) {
    unsigned keep;
    asm volatile("s_mov_b32 %0, m0\n\ts_mov_b32 m0, %3\n\ts_nop 2\n\tglobal_load_lds_dwordx4 %1, %2\n\ts_mov_b32 m0, %0" : "=&s"(keep) : "v"(voff), "s"(sbase), "s"(ldsdst) : "memory");
}
struct Unit { int pm, pn, e; };
struct Gemm { int K; size_t bhstep; };

struct StaticOrder {
    static constexpr bool GATHER = false;
    const bf16_t* A; const bf16_t* Bt; int K;
    int nM, nN, nwg, G, c;
    __device__ void init(const bf16_t* A_, const bf16_t* Bt_, int M, int N, int K_, int G_, int c_) { A = A_; Bt = Bt_; K = K_; nM = M / BM; nN = N / BM; nwg = nM * nN; G = G_; c = c_; }
    __device__ bool next(int i, Unit& u) const {
        const long L = (long)i * G + c; if (L >= nwg) return false;
        int wgid = (int)L; { const int q = nwg / NXCD, r = nwg % NXCD, xcd = wgid % NXCD, off = wgid / NXCD; wgid = (xcd < r ? xcd * (q + 1) : r * (q + 1) + (xcd - r) * q) + off; }
        const int nig = WGM * nN, gid = wgid / nig, fm = gid * WGM, gsz = (nM - fm) < WGM ? (nM - fm) : WGM;
        u.pm = fm + ((wgid % nig) % gsz); u.pn = (wgid % nig) / gsz; u.e = 0; return true;
    }
    __device__ __forceinline__ void ptrs(const Unit& u, const char*& a, const char*& b) const {
        a = (const char*)A + (size_t)u.pm * (size_t)(BM * 2) * K; b = (const char*)Bt + (size_t)u.pn * (size_t)(BM * 2) * K; }
    __device__ __forceinline__ void a_ready(const Unit&) const {}
    __device__ __forceinline__ void done(const Unit&) const {}
};
__device__ __forceinline__ void grid_map(int L, int nM, int nN, int& pm, int& pn) {
    const int nwg = nM * nN; int wgid = L; { const int q = nwg / NXCD, r = nwg % NXCD, xcd = wgid % NXCD, off = wgid / NXCD; wgid = (xcd < r ? xcd * (q + 1) : r * (q + 1) + (xcd - r) * q) + off; }
    const int nig = WGM * nN, gid = wgid / nig, fm = gid * WGM, gsz = (nM - fm) < WGM ? (nM - fm) : WGM;
    pm = fm + ((wgid % nig) % gsz); pn = (wgid % nig) / gsz;
}
struct ProjOrder {
    static constexpr bool GATHER = false;
    const bf16_t* XN; const bf16_t* WIN; const bf16_t* MEMN; const bf16_t* WCKV; int G, c;
    static constexpr int N0 = 64 * 13, N1 = 5 * 64, N2 = 4, N3 = 4, NTOT = N0 + N1 + N2 + N3;
    __device__ bool next(int i, Unit& u) const {
        int L = i * G + c; if (L >= NTOT) return false;
        if (L < N0) { u.e = 0; grid_map(L, 64, 13, u.pm, u.pn); return true; } L -= N0;
        if (L < N1) { u.e = 1; grid_map(L, 5, 64, u.pm, u.pn); return true; } L -= N1;
        if (L < N2) { u.e = 2; u.pm = L >> 1; u.pn = L & 1; return true; } L -= N2;
        u.e = 3; u.pm = L >> 1; u.pn = L & 1; return true;
    }
    __device__ __forceinline__ void ptrs(const Unit& u, const char*& a, const char*& b) const {
        const size_t ts = (size_t)(BM * 2) * 2048;
        const bf16_t* A = u.e == 0 ? XN : (u.e == 1 ? WIN + (size_t)NPROJ * 2048 : (u.e == 2 ? MEMN : WCKV + (size_t)512 * 2048));
        const bf16_t* B = u.e == 0 ? WIN : (u.e == 1 ? XN : (u.e == 2 ? WCKV : MEMN));
        a = (const char*)A + (size_t)u.pm * ts; b = (const char*)B + (size_t)u.pn * ts; }
    __device__ __forceinline__ void a_ready(const Unit&) const {}
    __device__ __forceinline__ void done(const Unit&) const {}
};
struct BranchOrder {
    static constexpr bool GATHER = false;
    const bf16_t* YA; const bf16_t* YD; const bf16_t* WB; int G, c;
    __device__ bool next(int i, Unit& u) const {
        const int L = (i >> 1) * G + c; if (L >= 64 * 8) return false;
        u.e = i & 1; grid_map(L, 64, 8, u.pm, u.pn); return true;
    }
    __device__ __forceinline__ void ptrs(const Unit& u, const char*& a, const char*& b) const {
        const size_t ts = (size_t)(BM * 2) * 1024;
        a = (const char*)(u.e ? YD : YA) + (size_t)u.pm * ts; b = (const char*)(WB + (size_t)u.e * 2048 * 1024) + (size_t)u.pn * ts; }
    __device__ __forceinline__ void a_ready(const Unit&) const {}
    __device__ __forceinline__ void done(const Unit&) const {}
};
template <bool GATHER_>
struct MoeOrder {
    static constexpr bool GATHER = GATHER_;
    const void* A; const void* Bt; const PG8_LAS int* tile_e; int ntiles, nN, G, c; size_t a_tstride, b_estride, b_tstride;
    const unsigned short* rowtok;
    __device__ bool next(int i, Unit& u) const {
        if (G == 256) {
            const int x = c >> 5, w = c & 31, mpr = 256 / nN;
            const int m = (nN == 16) ? 4 * (x >> 1) + (w >> 3) : 4 * x + (w >> 3), n = (nN == 16) ? 8 * (x & 1) + (w & 7) : (w & 7);
            u.pm = i * mpr + m; u.pn = n; if (u.pm >= ntiles) return false;
        } else { const long L = (long)i * G + c; if (L >= (long)ntiles * nN) return false; u.pm = (int)(L / nN); u.pn = (int)(L % nN); }
        u.e = __builtin_amdgcn_readfirstlane(tile_e[u.pm]); return true;
    }
    __device__ __forceinline__ void ptrs(const Unit& u, const char*& a, const char*& b) const {
        a = GATHER_ ? (const char*)A : (const char*)A + (size_t)u.pm * a_tstride; b = (const char*)Bt + (size_t)u.e * b_estride + (size_t)u.pn * b_tstride; }
    __device__ __forceinline__ const unsigned short* rows(const Unit& u) const { return rowtok + u.pm * 256; }
    __device__ __forceinline__ void a_ready(const Unit&) const {}
    __device__ __forceinline__ void done(const Unit&) const {}
};

#define EPI_ROWS_BEGIN const int row0 = u.pm * BM + wr * 64 + fr; \
    _Pragma("unroll") for (int ai = 0; ai < 2; ++ai) _Pragma("unroll") for (int m = 0; m < 4; ++m) { const int row = row0 + ai * HALF + m * 16;
#define EPI_ROWS_END }
__device__ __forceinline__ u32x4 pack8(f32x4 v0, f32x4 v1) { u32x4 w; w.x = pk2(v0[0], v0[1]); w.y = pk2(v0[2], v0[3]); w.z = pk2(v1[0], v1[1]); w.w = pk2(v1[2], v1[3]); return w; }
__device__ __forceinline__ void unpack8(u32x4 w, f32x4& v0, f32x4& v1) { v0 = (f32x4){bf_lo(w.x), bf_hi(w.x), bf_lo(w.y), bf_hi(w.y)}; v1 = (f32x4){bf_lo(w.z), bf_hi(w.z), bf_lo(w.w), bf_hi(w.w)}; }
__device__ __forceinline__ float sigm(float x) { return __builtin_amdgcn_rcpf(1.0f + __builtin_amdgcn_exp2f(-LOG2E * x)); }

struct EpiPlain {
    static constexpr bool PERM = true, AFTER_DRAIN = false;
    bf16_t* O; int ldc; float scale;
    __device__ __forceinline__ void operator()(const f32x4 (&acc)[2][2][4][2], const Unit& u, int wr, int wc, int fr, int fq) const {
        const int col0 = u.pn * BM + wc * 32 + 8 * fq;
        EPI_ROWS_BEGIN
            bf16_t* rowp = O + (size_t)row * ldc + col0;
#pragma unroll
            for (int bj = 0; bj < 2; ++bj) *(u32x4*)(rowp + bj * HALF) = pack8(acc[ai][bj][m][0] * scale, acc[ai][bj][m][1] * scale);
        EPI_ROWS_END
    }
};
struct EpiRowScale {
    static constexpr bool PERM = true, AFTER_DRAIN = false;
    bf16_t* O; int ldc; float scale; const float* RS; const unsigned* rsc;
    __device__ __forceinline__ void operator()(const f32x4 (&acc)[2][2][4][2], const Unit& u, int wr, int wc, int fr, int fq) const {
        const int col0 = u.pn * BM + wc * 32 + 8 * fq;
        if (fr == 0 && fq == 0) { while (__hip_atomic_load(rsc + 32 * u.pm, __ATOMIC_RELAXED, __HIP_MEMORY_SCOPE_AGENT) < 256u) __builtin_amdgcn_s_sleep(4); }
        asm volatile("" ::: "memory");
        EPI_ROWS_BEGIN
            bf16_t* rowp = O + (size_t)row * ldc + col0;
            const float s = scale * __builtin_bit_cast(float, __hip_atomic_load((const unsigned*)RS + row, __ATOMIC_RELAXED, __HIP_MEMORY_SCOPE_AGENT));
#pragma unroll
            for (int bj = 0; bj < 2; ++bj) *(u32x4*)(rowp + bj * HALF) = pack8(acc[ai][bj][m][0] * s, acc[ai][bj][m][1] * s);
        EPI_ROWS_END
    }
};
struct EpiProj {
    static constexpr bool PERM = true, AFTER_DRAIN = false;
    bf16_t* O;
    __device__ __forceinline__ void operator()(const f32x4 (&acc)[2][2][4][2], const Unit& u, int wr, int wc, int fr, int fq) const {
        const int col0 = u.pn * BM + wc * 32 + 8 * fq; const int pn = u.pn;
        const int mode = (pn < 4 || (pn >= 5 && pn < 9)) ? 1 : (pn >= 13 ? 2 : 0);
        EPI_ROWS_BEGIN
            bf16_t* rowp = O + (size_t)row * NPROJ + col0;
#pragma unroll
            for (int bj = 0; bj < 2; ++bj) { f32x4 v0 = acc[ai][bj][m][0], v1 = acc[ai][bj][m][1];
                if (mode == 1) { v0 = v0 * C2_64; v1 = v1 * C2_64; }
                else if (mode == 2) {
#pragma unroll
                    for (int i = 0; i < 4; ++i) { v0[i] = sigm(v0[i]); v1[i] = sigm(v1[i]); } }
                *(u32x4*)(rowp + bj * HALF) = pack8(v0, v1); }
        EPI_ROWS_END
    }
};
__device__ __forceinline__ unsigned q4_u8(f32x4 v) { const unsigned a = (unsigned)(v[0] * 255.0f + 0.5f), b = (unsigned)(v[1] * 255.0f + 0.5f), c = (unsigned)(v[2] * 255.0f + 0.5f), d = (unsigned)(v[3] * 255.0f + 0.5f); return a | (b << 8) | (c << 16) | (d << 24); }
__device__ __forceinline__ f32x4 u8_f4(unsigned w) { return (f32x4){(float)(w & 0xffu), (float)((w >> 8) & 0xffu), (float)((w >> 16) & 0xffu), (float)(w >> 24)} * (1.0f / 255.0f); }
struct EpiBranch0 {
    static constexpr bool PERM = true, AFTER_DRAIN = false;
    const unsigned char* G8; bf16_t* O;
    __device__ __forceinline__ void operator()(const f32x4 (&acc)[2][2][4][2], const Unit& u, int wr, int wc, int fr, int fq) const {
        const int col0 = u.pn * BM + wc * 32 + 8 * fq;
        EPI_ROWS_BEGIN
#pragma unroll
            for (int bj = 0; bj < 2; ++bj) { const int col = col0 + bj * HALF;
                const u32x2 gw = *(const u32x2*)(G8 + (size_t)row * 4096 + col); const f32x4 g0 = u8_f4(gw.x), g1 = u8_f4(gw.y);
                *(u32x4*)(O + (size_t)row * DM + col) = pack8(g0 * acc[ai][bj][m][0], g1 * acc[ai][bj][m][1]); }
        EPI_ROWS_END
    }
};
struct EpiBranch1 {
    static constexpr bool PERM = true, AFTER_DRAIN = false;
    const unsigned char* G8; bf16_t* O;
    __device__ __forceinline__ void operator()(const f32x4 (&acc)[2][2][4][2], const Unit& u, int wr, int wc, int fr, int fq) const {
        const int col0 = u.pn * BM + wc * 32 + 8 * fq;
        EPI_ROWS_BEGIN
#pragma unroll
            for (int bj = 0; bj < 2; ++bj) { const int col = col0 + bj * HALF;
                const u32x2 gw = *(const u32x2*)(G8 + (size_t)row * 4096 + DM + col); const f32x4 g0 = u8_f4(gw.x), g1 = u8_f4(gw.y);
                f32x4 t0, t1; unpack8(*(const u32x4*)(O + (size_t)row * DM + col), t0, t1);
                *(u32x4*)(O + (size_t)row * DM + col) = pack8(t0 + g0 * acc[ai][bj][m][0], t1 + g1 * acc[ai][bj][m][1]); }
        EPI_ROWS_END
    }
};
template <bool BASE_BF16>
struct EpiResid {
    static constexpr bool PERM = true, AFTER_DRAIN = false;
    const void* BASE; bf16_t* OUT;
    __device__ __forceinline__ void operator()(const f32x4 (&acc)[2][2][4][2], const Unit& u, int wr, int wc, int fr, int fq) const {
        const int col0 = u.pn * BM + wc * 32 + 8 * fq;
        EPI_ROWS_BEGIN
#pragma unroll
            for (int bj = 0; bj < 2; ++bj) { const size_t off = (size_t)row * DM + col0 + bj * HALF;
                f32x4 b0, b1;
                if (BASE_BF16) unpack8(*(const u32x4*)((const bf16_t*)BASE + off), b0, b1);
                else { b0 = *(const f32x4*)((const float*)BASE + off); b1 = *(const f32x4*)((const float*)BASE + off + 4); }
                *(u32x4*)(OUT + off) = pack8(b0 + acc[ai][bj][m][0], b1 + acc[ai][bj][m][1]); }
        EPI_ROWS_END
    }
};
__device__ __forceinline__ unsigned pk4_fp8(float a, float b, float c, float d) { int w = 0; w = __builtin_amdgcn_cvt_pk_fp8_f32(a, b, w, false); w = __builtin_amdgcn_cvt_pk_fp8_f32(c, d, w, true); return (unsigned)w; }
struct EpiGlu {
    static constexpr bool PERM = true, AFTER_DRAIN = false;
    const float* bgu; unsigned char* ACT;
    __device__ __forceinline__ void operator()(const f32x4 (&acc)[2][2][4][2], const Unit& u, int wr, int wc, int fr, int fq) const {
        const int col = u.pn * HALF + wc * 32 + 8 * fq;
        const float* bg = bgu + (size_t)u.e * (2 * DFF) + col; const float* bl = bg + DFF;
        const f32x4 bg0 = *(const f32x4*)bg, bg1 = *(const f32x4*)(bg + 4), bl0 = *(const f32x4*)bl, bl1 = *(const f32x4*)(bl + 4);
        EPI_ROWS_BEGIN
            f32x4 a[2];
#pragma unroll
            for (int n = 0; n < 2; ++n) {
                const f32x4 G = acc[ai][0][m][n], L = acc[ai][1][m][n], BG = n ? bg1 : bg0, BL = n ? bl1 : bl0;
#pragma unroll
                for (int h = 0; h < 2; ++h) {
                    const f32x2 g = (h ? G.hi : G.lo) * (1.0f / 512.0f) + (h ? BG.hi : BG.lo), l = (h ? L.hi : L.lo) * (1.0f / 512.0f) + (h ? BL.hi : BL.lo);
                    const f32x2 gl = {fminf(g.x, 7.0f), fminf(g.y, 7.0f)}, li = {fminf(fmaxf(l.x, -7.0f), 7.0f), fminf(fmaxf(l.y, -7.0f), 7.0f)};
                    const f32x2 t = gl * (-1.702f * LOG2E);
                    const f32x2 d = (f32x2){__builtin_amdgcn_exp2f(t.x), __builtin_amdgcn_exp2f(t.y)} + 1.0f;
                    const f32x2 r = {__builtin_amdgcn_rcpf(d.x), __builtin_amdgcn_rcpf(d.y)};
                    const f32x2 av = (gl * r) * (li * 4.0f + 4.0f);
                    a[n][2 * h] = av.x; a[n][2 * h + 1] = av.y; } }
            u32x2 w; w.x = pk4_fp8(a[0][0], a[0][1], a[0][2], a[0][3]); w.y = pk4_fp8(a[1][0], a[1][1], a[1][2], a[1][3]);
            *(u32x2*)(ACT + (size_t)row * DFF + col) = w;
        EPI_ROWS_END
    }
};
struct EpiDown {
    static constexpr bool PERM = true, AFTER_DRAIN = false;
    const float* bd; const int* rowslot; const float* roww; unsigned char* OUT;
    __device__ __forceinline__ void operator()(const f32x4 (&acc)[2][2][4][2], const Unit& u, int wr, int wc, int fr, int fq) const {
        const int col0 = u.pn * BM + wc * 32 + 8 * fq;
        const float* bp = bd + (size_t)u.e * DM + col0;
        f32x4 bv[2][2];
#pragma unroll
        for (int bj = 0; bj < 2; ++bj) { bv[bj][0] = *(const f32x4*)(bp + bj * HALF); bv[bj][1] = *(const f32x4*)(bp + bj * HALF + 4); }
        EPI_ROWS_BEGIN
            const int slot = rowslot[row]; const float w = roww[row];
            if (slot >= 0) {
#pragma unroll
                for (int bj = 0; bj < 2; ++bj)
                { const float w32 = 32.0f * w; f32x4 y0, y1;
                    y0.lo = (acc[ai][bj][m][0].lo * (1.0f / 256.0f) + bv[bj][0].lo) * w32; y0.hi = (acc[ai][bj][m][0].hi * (1.0f / 256.0f) + bv[bj][0].hi) * w32;
                    y1.lo = (acc[ai][bj][m][1].lo * (1.0f / 256.0f) + bv[bj][1].lo) * w32; y1.hi = (acc[ai][bj][m][1].hi * (1.0f / 256.0f) + bv[bj][1].hi) * w32;
                    u32x2 q; q.x = pk4_fp8(y0[0], y0[1], y0[2], y0[3]); q.y = pk4_fp8(y1[0], y1[1], y1[2], y1[3]); *(u32x2*)(OUT + (size_t)slot * DM + col0 + bj * HALF) = q; }
            }
        EPI_ROWS_END
    }
};


struct EpiGate {
    static constexpr bool PERM = true, AFTER_DRAIN = false;
    unsigned char* G8;
    __device__ __forceinline__ void operator()(const f32x4 (&acc)[2][2][4][2], const Unit& u, int wr, int wc, int fr, int fq) const {
        const int col0 = u.pn * BM + wc * 32 + 8 * fq;
        EPI_ROWS_BEGIN
            unsigned char* rowp = G8 + (size_t)row * 4096 + col0;
#pragma unroll
            for (int bj = 0; bj < 2; ++bj) { u32x2 w;
#pragma unroll
                for (int n = 0; n < 2; ++n) { const f32x4 A = acc[ai][bj][m][n]; unsigned q[4];
#pragma unroll
                    for (int h = 0; h < 2; ++h) {
                        const f32x2 t = (h ? A.hi : A.lo) * (-LOG2E / 512.0f);
                        const f32x2 d = (f32x2){__builtin_amdgcn_exp2f(t.x), __builtin_amdgcn_exp2f(t.y)} + 1.0f;
                        const f32x2 r = (f32x2){__builtin_amdgcn_rcpf(d.x), __builtin_amdgcn_rcpf(d.y)} * 255.0f + 0.5f;
                        q[2 * h] = (unsigned)r.x; q[2 * h + 1] = (unsigned)r.y; }
                    const unsigned pk = q[0] | (q[1] << 8) | (q[2] << 16) | (q[3] << 24); if (n) w.y = pk; else w.x = pk; }
                *(u32x2*)(rowp + bj * HALF) = w; }
        EPI_ROWS_END
    }
};

struct EpiProjAll {
    static constexpr bool PERM = true, AFTER_DRAIN = false;
    bf16_t* PROJ; bf16_t* VT; bf16_t* KM; bf16_t* VMT;
    __device__ __forceinline__ void operator()(const f32x4 (&acc)[2][2][4][2], const Unit& u, int wr, int wc, int fr, int fq) const {
        if (u.e == 0) { EpiProj E{PROJ}; E(acc, u, wr, wc, fr, fq); }
        else { EpiPlain E{u.e == 1 ? VT : (u.e == 2 ? KM : VMT), u.e == 1 ? T : 512, 1.0f}; E(acc, u, wr, wc, fr, fq); }
    }
};
struct EpiBranchAll {
    static constexpr bool PERM = true, AFTER_DRAIN = false;
    const unsigned char* PROJ; bf16_t* O;
    __device__ __forceinline__ void operator()(const f32x4 (&acc)[2][2][4][2], const Unit& u, int wr, int wc, int fr, int fq) const {
        if (u.e == 0) { EpiBranch0 E{PROJ, O}; E(acc, u, wr, wc, fr, fq); }
        else { asm volatile("s_waitcnt vmcnt(0)" ::: "memory");
               EpiBranch1 E{PROJ, O}; E(acc, u, wr, wc, fr, fq); }
    }
};
template <class Epi, class Sched, bool ALIGN_EPI = false, bool SP2 = false, bool FP8 = false>
__device__ __forceinline__ void gemm_phase(PG8_LAS unsigned char* lds, const Gemm g, const Sched& S, const Epi& E) {
    int tid = threadIdx.x; asm volatile("" : "+v"(tid)); const int wid = __builtin_amdgcn_readfirstlane(tid >> 6), lane = tid & 63, wr = wid >> 2, wc = wid & 3, fr = lane & 15, fq = lane >> 4;
    const int K = g.K, nt = K / BK;
    unsigned voffA[2], voffB[2];
#pragma unroll
    for (int i = 0; i < 2; ++i) { int R, C; stage_rc(tid * 16 + i * 8192, R, C); const int Rb = Epi::PERM ? ((R & ~31) + perm32(R & 31)) : R;
        voffA[i] = (unsigned)(R * K + C) * 2u; voffB[i] = (unsigned)(Rb * K + C) * 2u; }
    u32x2 vgc = {0u, 0u}, vgn = {0u, 0u};
    auto gather_issue = [&](const unsigned short* rp, u32x2& dst) { int t4 = threadIdx.x; asm volatile("" : "+v"(t4)); int R, C; stage_rc(t4 * 16, R, C); const unsigned o = (unsigned)R * 8u;
        asm volatile("s_nop 4\n\tglobal_load_dwordx2 %0, %1, %2" : "=&v"(dst) : "v"(o), "s"(rp) : "memory"); };
#define PG8_GOFF(v, h, i) ((((i) ? ((h) ? (v).y >> 16 : (v).x >> 16) : ((h) ? (v).y & 0xffffu : (v).x & 0xffffu)) * (unsigned)(K * 2)) + (voffB[0] & (unsigned)(K * 2 - 1)))
    const size_t kstep = (size_t)(BK * 2);
    const size_t hstep = Sched::GATHER ? (size_t)0 : (size_t)HALF * K * 2;
    const size_t bhs = g.bhstep;
    const unsigned lds0 = (unsigned)(unsigned long)lds;
    const unsigned ldsw = (unsigned)wid * 1024u;
    const int aoff = lds_byte(wr * 64 + fr, fq * 8), boff = lds_byte(wc * 32 + fr, fq * 8);
#define PG8_SA(b, h) (((b) * 2 + (h)) * HTB)
#define PG8_SB(b, h) ((4 + (b) * 2 + (h)) * HTB)
#define PG8_STAGE(bufoff, gbase, voff) do { _Pragma("unroll") for (int _i = 0; _i < 2; ++_i) \
        glds16_s((const char*)(gbase), (voff)[_i], lds0 + (unsigned)(bufoff) + ldsw + (unsigned)(_i * 8192)); } while (0)
#define PG8_STAGE_A(bufoff, gbase, h, nx) do { if constexpr (Sched::GATHER) { u32x2 vv_ = (nx) ? vgn : vgc; asm volatile("" : "+v"(vv_));        const unsigned vs_[2] = {PG8_GOFF(vv_, h, 0), PG8_GOFF(vv_, h, 1)}; PG8_STAGE(bufoff, gbase, vs_); } else PG8_STAGE(bufoff, gbase, voffA); } while (0)
#define PG8_LDA(dst, b, h) do { _Pragma("unroll") for (int m = 0; m < 4; ++m) _Pragma("unroll") for (int k = 0; k < 2; ++k) dst[m][k] = *(const PG8_LAS bf16x8*)(lds + PG8_SA(b, h) + aoff + m * 2048 + k * 1024); } while (0)
#define PG8_LDB(dst, b, h) do { _Pragma("unroll") for (int n = 0; n < 2; ++n) _Pragma("unroll") for (int k = 0; k < 2; ++k) dst[n][k] = *(const PG8_LAS bf16x8*)(lds + PG8_SB(b, h) + boff + n * 2048 + k * 1024); } while (0)
#define PG8_MMA(ai, bj, At, Bt) do { __builtin_amdgcn_s_setprio(1); _Pragma("unroll") for (int m = 0; m < 4; ++m) _Pragma("unroll") for (int n = 0; n < 2; ++n) { \
        if constexpr (FP8) acc[ai][bj][m][n] = __builtin_amdgcn_mfma_scale_f32_16x16x128_f8f6f4(cat16(Bt[n][0], Bt[n][1]), cat16(At[m][0], At[m][1]), acc[ai][bj][m][n], 0, 0, 0, 0, 0, 0); \
        else { _Pragma("unroll") for (int k = 0; k < 2; ++k) acc[ai][bj][m][n] = __builtin_amdgcn_mfma_f32_16x16x32_bf16(Bt[n][k], At[m][k], acc[ai][bj][m][n], 0, 0, 0); } } __builtin_amdgcn_s_setprio(0); } while (0)
#define PG8_WAIT_V(n) asm volatile("s_waitcnt vmcnt(" #n ")" ::: "memory")
#define PG8_WAIT_L(n) asm volatile("s_waitcnt lgkmcnt(" #n ")" ::: "memory")
#define PG8_BAR __builtin_amdgcn_s_barrier()
#define PG8_SCHED __builtin_amdgcn_sched_barrier(0)
    Unit cur, nxt; int ui = 0;
    if (!S.next(0, cur)) return;
    f32x4 acc[2][2][4][2];
#pragma unroll
    for (int a = 0; a < 2; ++a)
#pragma unroll
        for (int b = 0; b < 2; ++b)
#pragma unroll
            for (int m = 0; m < 4; ++m)
#pragma unroll
                for (int n = 0; n < 2; ++n) acc[a][b][m][n] = (f32x4){0.f, 0.f, 0.f, 0.f};
    bf16x8 At[4][2], B0[2][2], B1[2][2];
    const char* cA; const char* cB; S.ptrs(cur, cA, cB);
    S.a_ready(cur);
    if constexpr (Sched::GATHER) { static_assert(SP2, "gather is written for the SP2 loop"); gather_issue(S.rows(cur), vgc); asm volatile("s_waitcnt vmcnt(0)" : "+v"(vgc) :: "memory"); vgn = vgc; }
    if constexpr (SP2) {
        PG8_STAGE(PG8_SB(0, 0), cB, voffB); PG8_STAGE(PG8_SB(0, 1), cB + bhs, voffB); PG8_STAGE_A(PG8_SA(0, 0), cA, 0, false); PG8_STAGE_A(PG8_SA(0, 1), cA + hstep, 1, false);
        if (wr == 1) PG8_BAR;
        PG8_WAIT_V(2); PG8_BAR;
        PG8_STAGE(PG8_SB(1, 0), cB + kstep, voffB); PG8_STAGE_A(PG8_SA(1, 0), cA + kstep, 0, false); PG8_STAGE(PG8_SB(1, 1), cB + bhs + kstep, voffB);
        PG8_WAIT_V(6); PG8_BAR;
    } else {
        PG8_STAGE(PG8_SB(0, 0), cB, voffB); PG8_STAGE(PG8_SA(0, 0), cA, voffA); PG8_STAGE(PG8_SB(0, 1), cB + bhs, voffB); PG8_STAGE(PG8_SA(0, 1), cA + hstep, voffA);
        if (wr == 1) PG8_BAR;
        PG8_WAIT_V(4); PG8_BAR;
        PG8_STAGE(PG8_SB(1, 0), cB + kstep, voffB); PG8_STAGE(PG8_SA(1, 0), cA + kstep, voffA); PG8_STAGE(PG8_SB(1, 1), cB + bhs + kstep, voffB);
        PG8_WAIT_V(6); PG8_BAR;
    }
    for (;;) {
        const bool has_next = S.next(ui + 1, nxt);
        const char* nA = cA; const char* nB = cB; if (has_next) S.ptrs(nxt, nA, nB);
        if constexpr (Sched::GATHER) { if (has_next) gather_issue(S.rows(nxt), vgn); }
        for (int t = 0; t < nt; t += 2) {
            const bool last = (t == nt - 2);
            const char* a1 = cA + (size_t)(t + 1) * kstep;
            const char* a2 = last ? nA : cA + (size_t)(t + 2) * kstep; const char* b2 = last ? nB : cB + (size_t)(t + 2) * kstep;
            const char* a3 = a2 + kstep; const char* b3 = b2 + kstep;
            if (last && has_next) S.a_ready(nxt);
            if constexpr (SP2) {
            PG8_LDB(B0, 0, 0); PG8_LDB(B1, 0, 1); PG8_SCHED; PG8_LDA(At, 0, 0); PG8_STAGE_A(PG8_SA(1, 1), a1 + hstep, 1, false);
            PG8_WAIT_V(8); PG8_WAIT_L(0); PG8_BAR; PG8_MMA(0, 0, At, B0); PG8_MMA(0, 1, At, B1); PG8_BAR; PG8_SCHED;
            PG8_LDA(At, 0, 1); PG8_STAGE(PG8_SB(0, 0), b2, voffB); PG8_STAGE(PG8_SB(0, 1), b2 + bhs, voffB); PG8_STAGE_A(PG8_SA(0, 0), a2, 0, last);
            PG8_WAIT_V(8); PG8_WAIT_L(0); PG8_BAR;
            PG8_MMA(1, 0, At, B0); PG8_MMA(1, 1, At, B1); PG8_BAR; PG8_SCHED;
            PG8_LDB(B0, 1, 0); PG8_LDB(B1, 1, 1); PG8_SCHED; PG8_LDA(At, 1, 0); PG8_STAGE_A(PG8_SA(0, 1), a2 + hstep, 1, last);
            PG8_WAIT_V(8); PG8_WAIT_L(0); PG8_BAR; PG8_MMA(0, 0, At, B0); PG8_MMA(0, 1, At, B1); PG8_BAR; PG8_SCHED;
            PG8_LDA(At, 1, 1); PG8_STAGE(PG8_SB(1, 0), b3, voffB); PG8_STAGE(PG8_SB(1, 1), b3 + bhs, voffB); PG8_STAGE_A(PG8_SA(1, 0), a3, 0, last);
            PG8_WAIT_V(8); PG8_WAIT_L(0); PG8_BAR; PG8_MMA(1, 0, At, B0); PG8_MMA(1, 1, At, B1); PG8_BAR; PG8_SCHED;
            } else {
            PG8_LDB(B0, 0, 0); PG8_SCHED; PG8_LDA(At, 0, 0); PG8_STAGE(PG8_SA(1, 1), a1 + hstep, voffA);
            PG8_WAIT_L(8); PG8_BAR; PG8_WAIT_L(0); PG8_MMA(0, 0, At, B0); PG8_BAR; PG8_SCHED;
            PG8_LDB(B1, 0, 1); PG8_STAGE(PG8_SB(0, 0), b2, voffB);
            PG8_BAR; PG8_WAIT_L(0); PG8_MMA(0, 1, At, B1); PG8_BAR;
            PG8_LDA(At, 0, 1); PG8_STAGE(PG8_SA(0, 0), a2, voffA);
            PG8_BAR; PG8_WAIT_L(0); PG8_MMA(1, 0, At, B0); PG8_BAR; PG8_SCHED;
            PG8_STAGE(PG8_SB(0, 1), b2 + bhs, voffB);
            PG8_WAIT_V(6); PG8_BAR; PG8_MMA(1, 1, At, B1); PG8_BAR;
            PG8_LDB(B0, 1, 0); PG8_SCHED; PG8_LDA(At, 1, 0); PG8_STAGE(PG8_SA(0, 1), a2 + hstep, voffA);
            PG8_WAIT_L(8); PG8_BAR; PG8_WAIT_L(0); PG8_MMA(0, 0, At, B0); PG8_BAR; PG8_SCHED;
            PG8_LDB(B1, 1, 1); PG8_STAGE(PG8_SB(1, 0), b3, voffB);
            PG8_BAR; PG8_WAIT_L(0); PG8_MMA(0, 1, At, B1); PG8_BAR;
            PG8_LDA(At, 1, 1); PG8_STAGE(PG8_SA(1, 0), a3, voffA);
            PG8_BAR; PG8_WAIT_L(0); PG8_MMA(1, 0, At, B0); PG8_BAR; PG8_SCHED;
            PG8_STAGE(PG8_SB(1, 1), b3 + bhs, voffB);
            PG8_WAIT_V(6); PG8_BAR; PG8_MMA(1, 1, At, B1); PG8_BAR;
            }
        }
        if constexpr (ALIGN_EPI) { if (wr == 0) PG8_BAR; }
        if constexpr (!Epi::AFTER_DRAIN) { int t2 = threadIdx.x; asm volatile("" : "+v"(t2)); const int l2 = t2 & 63, w2 = __builtin_amdgcn_readfirstlane(t2 >> 6); E(acc, cur, w2 >> 2, w2 & 3, l2 & 15, l2 >> 4); S.done(cur); }
        if (!has_next) break;
#pragma unroll
        for (int a = 0; a < 2; ++a)
#pragma unroll
            for (int b = 0; b < 2; ++b)
#pragma unroll
                for (int m = 0; m < 4; ++m)
#pragma unroll
                    for (int n = 0; n < 2; ++n) acc[a][b][m][n] = (f32x4){0.f, 0.f, 0.f, 0.f};
        cur = nxt; cA = nA; cB = nB; ++ui;
        if constexpr (Sched::GATHER) vgc = vgn;
        if constexpr (ALIGN_EPI) { if (wr == 1) PG8_BAR; }
    }
    PG8_WAIT_V(0);
    if constexpr (!ALIGN_EPI) { if (wr == 0) PG8_BAR; }
    PG8_BAR;
    if constexpr (Epi::AFTER_DRAIN) { E.fused(acc, cur, wr, wc, fr, fq, lds, wid, lane); S.done(cur); }
#undef PG8_SA
#undef PG8_SB
#undef PG8_STAGE
#undef PG8_STAGE_A
#undef PG8_GOFF
#undef PG8_LDA
#undef PG8_LDB
#undef PG8_MMA
#undef PG8_WAIT_V
#undef PG8_WAIT_L
#undef PG8_BAR
#undef PG8_SCHED
}
}

#define XB_TMO      128
#define XB_XCNT(j)  (256  + 64 * (j))
#define XB_XSUB(j)  (1280 + 64 * (j))
#define XB_XGEN(j)  (2304 + 64 * (j))
#define XB_TOP      3328
#define XB_TOPGEN   3392
#define XCD_BAR_WORDS 3456
#define XB_SPIN_CAP (1u << 18)
#define LAS __attribute__((address_space(3)))

__device__ __forceinline__ unsigned xb_ld(unsigned* p)              { return __hip_atomic_load(p, __ATOMIC_RELAXED, __HIP_MEMORY_SCOPE_AGENT); }
__device__ __forceinline__ unsigned xb_add(unsigned* p, unsigned v) { return __hip_atomic_fetch_add(p, v, __ATOMIC_RELAXED, __HIP_MEMORY_SCOPE_AGENT); }
__device__ __forceinline__ unsigned xb_xcc_id() { return (unsigned)__builtin_amdgcn_s_getreg((3 << 11) | 20) & 0xFu; }
#define XB_SPIN(cond, bar) do { unsigned _sp = 0; while (cond) { __builtin_amdgcn_s_sleep(1); \
    if ((++_sp & 255u) == 0u) { if (xb_ld(&(bar)[XB_TMO])) break; if (_sp > XB_SPIN_CAP) { atomicAdd(&(bar)[XB_TMO], 1u); break; } } } } while (0)

struct XcdBarrier {
    unsigned* bar; unsigned x;
    volatile LAS unsigned* st;
};

__device__ __forceinline__ XcdBarrier xcd_barrier_post(unsigned* bar, volatile LAS unsigned* st) {
    XcdBarrier b; b.bar = bar; b.x = xb_xcc_id(); b.st = st;
    if (threadIdx.x == 0) (void)xb_add(&bar[XB_XCNT(b.x)], 1u);
    return b;
}
__device__ __forceinline__ void xcd_barrier_complete(unsigned* bar, unsigned x, unsigned& nloc, unsigned& nx) {
    const unsigned G = gridDim.x * gridDim.y * gridDim.z;
    unsigned sum, cnt, mine, sp = 0u;
    for (;;) {
        sum = 0u; cnt = 0u; mine = 0u;
#pragma unroll
        for (unsigned j = 0; j < 16; ++j) { const unsigned c = xb_ld(&bar[XB_XCNT(j)]); sum += c; cnt += (c > 0u) ? 1u : 0u; mine = (j == x) ? c : mine; }
        if (sum == G) break;
        __builtin_amdgcn_s_sleep(1);
        if ((++sp & 255u) == 0u) { if (xb_ld(&bar[XB_TMO])) break; if (sp > XB_SPIN_CAP) { atomicAdd(&bar[XB_TMO], 1u); break; } }
    }
    nloc = mine > 0u ? mine : 1u; nx = cnt > 0u ? cnt : 1u;
}

__device__ __forceinline__ void xcd_barrier(const XcdBarrier& b) {
    asm volatile("s_waitcnt vmcnt(0)" ::: "memory");
    __syncthreads();
    if (threadIdx.x == 0) {
        unsigned* bar = b.bar;
        __builtin_amdgcn_s_waitcnt(0);
        unsigned nloc = b.st[0], nx = b.st[1];
        if (nloc == 0u) { xcd_barrier_complete(bar, b.x, nloc, nx); b.st[0] = nloc; b.st[1] = nx; }
        const unsigned old = xb_add(&bar[XB_XSUB(b.x)], 1u);
        const unsigned gen = old / nloc;
        if (old + 1u == (gen + 1u) * nloc) {
            __builtin_amdgcn_fence(__ATOMIC_RELEASE, "agent");
            asm volatile("s_waitcnt vmcnt(0)" ::: "memory");
            const unsigned og = xb_add(&bar[XB_TOP], 1u);
            const unsigned tg = og / nx;
            if (og + 1u == (tg + 1u) * nx) xb_add(&bar[XB_TOPGEN], 1u);
            else XB_SPIN(xb_ld(&bar[XB_TOPGEN]) == tg, bar);
            __builtin_amdgcn_fence(__ATOMIC_ACQUIRE, "agent");
            xb_add(&bar[XB_XGEN(b.x)], 1u);
            asm volatile("s_waitcnt vmcnt(0)" ::: "memory");
        } else {
            XB_SPIN(xb_ld(&bar[XB_XGEN(b.x)]) == gen, bar);
            __builtin_amdgcn_fence(__ATOMIC_ACQUIRE, "agent");
            asm volatile("s_waitcnt vmcnt(0)" ::: "memory");
        }
    }
    __syncthreads();
}


struct Frame {
    LAS unsigned char* lds;
    unsigned* ctl;
    int wave, vcu, G;
    const float* in[25];
    float* out;
    unsigned char* ws;
};
#define WSP(type, off) ((type*)(F.ws + (off)))

__device__ __forceinline__ int win_dst_row(int n0) {
    if (n0 < 1280) return n0;
    if (n0 < 1536) return NPROJ + (n0 - 1280);
    if (n0 < 2560) return PC_QD + (n0 - 1536);
    if (n0 < 3584) return PC_KD + (n0 - 2560);
    if (n0 < 4608) return NPROJ + 256 + (n0 - 3584);
    return PC_G + (n0 - 4608);
}
__device__ __forceinline__ void rms_row_bf16(const float* xrow, const float* gain, bf16_t* orow, int lane, unsigned char* o8 = nullptr) {
    f32x4 v[8]; float s = 0.f;
#pragma unroll
    for (int j = 0; j < 8; ++j) { v[j] = ((const f32x4*)xrow)[lane + 64 * j]; s += (v[j][0] * v[j][0] + v[j][1] * v[j][1]) + (v[j][2] * v[j][2] + v[j][3] * v[j][3]); }
    const float rstd = 1.0f / sqrtf(wave_sum(s) * (1.0f / DM) + RMS_EPS);
#pragma unroll
    for (int j = 0; j < 8; ++j) { const f32x4 g = ((const f32x4*)gain)[lane + 64 * j]; const f32x4 o = v[j] * rstd * g;
        u32x2 w; w.x = pk2(o[0], o[1]); w.y = pk2(o[2], o[3]); ((u32x2*)orow)[lane + 64 * j] = w;
        if (o8) ((unsigned*)o8)[lane + 64 * j] = pg8::pk4_fp8(o[0] * 8.0f, o[1] * 8.0f, o[2] * 8.0f, o[3] * 8.0f); }
}
__device__ __forceinline__ void rows_rms_phase(Frame& F, const float* X, const float* gain, bf16_t* O, int nrows, unsigned char* O8 = nullptr) {
    int lane = threadIdx.x; asm volatile("" : "+v"(lane)); lane &= 63;
    const int gw = F.vcu * NWAVES + F.wave, NGW = F.G * NWAVES;
    for (int r = gw; r < nrows; r += NGW) rms_row_bf16(X + (size_t)r * DM, gain, O + (size_t)r * DM, lane, O8 ? O8 + (size_t)r * DM : nullptr);
}

__device__ __forceinline__ void rows_rstd_phase(Frame& F, const bf16_t* X, float* RS, unsigned* rsc, int nrows) {
    int lane = threadIdx.x; asm volatile("" : "+v"(lane)); lane &= 63;
    const int gw = F.vcu * NWAVES + F.wave, NGW = F.G * NWAVES;
    for (int r = gw; r < nrows; r += 2 * NGW) {
        const int r1 = r + NGW; const bool two = r1 < nrows;
        u32x4 w[2][4];
#pragma unroll
        for (int j = 0; j < 4; ++j) { w[0][j] = ((const u32x4*)(X + (size_t)r * DM))[lane + 64 * j]; w[1][j] = ((const u32x4*)(X + (size_t)(two ? r1 : r) * DM))[lane + 64 * j]; }
#pragma unroll
        for (int q = 0; q < 2; ++q) { float s = 0.f;
#pragma unroll
            for (int j = 0; j < 4; ++j) { f32x4 v0, v1; pg8::unpack8(w[q][j], v0, v1);
                s += ((v0[0] * v0[0] + v0[1] * v0[1]) + (v0[2] * v0[2] + v0[3] * v0[3])) + ((v1[0] * v1[0] + v1[1] * v1[1]) + (v1[2] * v1[2] + v1[3] * v1[3])); }
            s = wave_sum(s);
            if (lane == 0 && (q == 0 || two)) __hip_atomic_store((unsigned*)RS + (q ? r1 : r), __builtin_bit_cast(unsigned, 1.0f / sqrtf(s * (1.0f / DM) + RMS_EPS)), __ATOMIC_RELAXED, __HIP_MEMORY_SCOPE_AGENT); }
    }
    asm volatile("s_waitcnt vmcnt(0)" ::: "memory");
    if (lane == 0) for (int r = gw; r < nrows; r += NGW) __hip_atomic_fetch_add(rsc + 32 * (r >> 8), 1u, __ATOMIC_RELAXED, __HIP_MEMORY_SCOPE_AGENT);
}

struct TrItem { const float* src; int N; unsigned char* dst; int dpitch; int fp8; const float* gain; };
__device__ __forceinline__ bool tr_decode(Frame& F, int it, TrItem& d) {
    constexpr int I_IN = 32 * 136, I_B = 16 * 32, I_O = 32 * 32, I_CQ = 32 * 8, I_CKV = 32 * 16, I_CO = 8 * 32, I_GU1 = 32 * 64, I_D1 = 32 * 32;
    constexpr int NITEMS = I_IN + 2 * I_B + I_O + I_CQ + I_CKV + I_CO + NE * I_GU1 + NE * I_D1;
    if (it >= NITEMS) return false;
    int r = it; const float* W; int K, N, kb, nb, drow; unsigned char* D; int esz = 2; d.fp8 = 0; d.gain = nullptr;
    if (r < NE * I_GU1) { const int e = r / I_GU1, q = r % I_GU1; kb = q / 128; nb = q % 128; W = F.in[20] + (size_t)e * DM * 2 * DFF; K = DM; N = 2 * DFF; D = WSP(unsigned char, WS_WGU) + (size_t)e * 2 * DFF * DM; drow = 32 * nb; esz = 1; d.fp8 = 1; }
    else if ((r -= NE * I_GU1) < NE * I_D1) { const int e = r / I_D1, q = r % I_D1; kb = q / 64; nb = q % 64; W = F.in[22] + (size_t)e * DFF * DM; K = DFF; N = DM; D = WSP(unsigned char, WS_WD) + (size_t)e * DM * DFF; drow = 32 * nb; esz = 1; d.fp8 = 1; }
    else if ((r -= NE * I_D1) < 32 * 72) { kb = r / 72; nb = r % 72; W = F.in[3]; K = DM; N = 8704; D = WSP(unsigned char, WS_WIN); drow = win_dst_row(64 * nb); }
    else if ((r -= 32 * 72) < 16 * 128) { kb = r / 128; nb = r % 128; d.fp8 = 1; d.src = F.in[3] + (size_t)(128 * kb) * 8704 + 4608 + 32 * nb; d.N = 8704; d.dpitch = DM; d.dst = WSP(unsigned char, WS_WING8) + (size_t)(32 * nb) * DM + 128 * kb; return true; }
    else if ((r -= 16 * 128) < 2 * I_B) { const int n = r / I_B, q = r % I_B; kb = q / 32; nb = q % 32; W = F.in[10] + (size_t)n * 1024 * DM; K = 1024; N = DM; D = WSP(unsigned char, WS_WB) + (size_t)n * DM * 1024 * 2; drow = 64 * nb; }
    else if ((r -= 2 * I_B) < I_O) { kb = r / 32; nb = r % 32; W = F.in[11]; K = DM; N = DM; D = WSP(unsigned char, WS_WO); drow = 64 * nb; }
    else if ((r -= I_O) < I_CQ) { kb = r / 8; nb = r % 8; W = F.in[14]; K = DM; N = 512; D = WSP(unsigned char, WS_WCQ); drow = 64 * nb; d.gain = F.in[12] + 64 * kb; }
    else if ((r -= I_CQ) < I_CKV) { kb = r / 16; nb = r % 16; W = F.in[15]; K = DM; N = 1024; D = WSP(unsigned char, WS_WCKV); drow = 64 * nb; }
    else { r -= I_CKV; kb = r / 32; nb = r % 32; W = F.in[16]; K = 512; N = DM; D = WSP(unsigned char, WS_WCO); drow = 64 * nb; }
    if (d.fp8) { d.src = W + (size_t)(128 * kb) * N + 32 * nb; d.N = N; d.dpitch = K; d.dst = D + (size_t)drow * K + (size_t)(128 * kb); return true; }
    d.src = W + (size_t)(64 * kb) * N + 64 * nb; d.N = N; d.dpitch = K * esz; d.dst = D + (size_t)drow * d.dpitch + (size_t)(64 * kb) * esz;
    return true;
}
constexpr int NMOE_ITEMS = NE * (32 * 64 + 32 * 32);
constexpr int NALL_ITEMS = NMOE_ITEMS + 32 * 136 + 2 * 16 * 32 + 32 * 32 + 32 * 8 + 32 * 16 + 8 * 32;
__device__ __forceinline__ void conv_items(Frame& F, int lane, int it0, int step, int end) {
    LAS float* scr = (LAS float*)(F.lds + F.wave * 16896);
    TrItem cur, nxt; int it = it0;
    bool have = it < end && tr_decode(F, it, cur);
    f32x4 v[16];
#define TR_LOAD(D_) do { if ((D_).fp8) { _Pragma("unroll") for (int i = 0; i < 16; ++i) v[i] = *(const f32x4*)((D_).src + (size_t)((lane >> 3) + 8 * i) * (D_).N + 4 * (lane & 7)); } \
        else { _Pragma("unroll") for (int i = 0; i < 16; ++i) v[i] = *(const f32x4*)((D_).src + (size_t)((lane >> 4) + 4 * i) * (D_).N + 4 * (lane & 15)); } } while (0)
    if (have) TR_LOAD(cur);
    while (have) {
        if (cur.fp8) {
#pragma unroll
            for (int i = 0; i < 16; ++i) { LAS float* s = scr + ((lane >> 3) + 8 * i) * 33 + 4 * (lane & 7); s[0] = v[i][0] * 64.0f; s[1] = v[i][1] * 64.0f; s[2] = v[i][2] * 64.0f; s[3] = v[i][3] * 64.0f; }
        } else {
#pragma unroll
            for (int i = 0; i < 16; ++i) { const float sc = cur.gain ? cur.gain[(lane >> 4) + 4 * i] : 1.0f; LAS float* s = scr + ((lane >> 4) + 4 * i) * 65 + 4 * (lane & 15); s[0] = v[i][0] * sc; s[1] = v[i][1] * sc; s[2] = v[i][2] * sc; s[3] = v[i][3] * sc; }
        }
        it += step;
        const bool hn = it < end && tr_decode(F, it, nxt);
        if (hn) TR_LOAD(nxt);
        LDS_WAIT(); asm volatile("" ::: "memory");
        const int kc = lane >> 3;
        if (cur.fp8) {
#pragma unroll
            for (int j = 0; j < 4; ++j) { const int n = lane & 31, k16 = 2 * j + (lane >> 5); const LAS float* s = scr + (16 * k16) * 33 + n;
                u32x4 o; o.x = pg8::pk4_fp8(s[0], s[33], s[66], s[99]); o.y = pg8::pk4_fp8(s[132], s[165], s[198], s[231]);
                o.z = pg8::pk4_fp8(s[264], s[297], s[330], s[363]); o.w = pg8::pk4_fp8(s[396], s[429], s[462], s[495]);
                *(u32x4*)(cur.dst + (size_t)n * cur.dpitch + 16 * k16) = o; }
        } else {
#pragma unroll
            for (int j = 0; j < 8; ++j) { const int n = (lane & 7) + 8 * j; const LAS float* s = scr + (8 * kc) * 65 + n;
                u32x4 o; o.x = pk2(s[0], s[65]); o.y = pk2(s[130], s[195]); o.z = pk2(s[260], s[325]); o.w = pk2(s[390], s[455]);
                *(u32x4*)(cur.dst + (size_t)n * cur.dpitch + 16 * kc) = o; }
        }
        LDS_WAIT(); asm volatile("" ::: "memory");
        cur = nxt; have = hn;
    }
#undef TR_LOAD
}
template <int BLK>
__device__ __forceinline__ void conv_filler(Frame& F, int phase) {
    int tid = threadIdx.x; asm volatile("" : "+v"(tid)); const int lane = tid & 63;
    volatile LAS unsigned* fl = (volatile LAS unsigned*)(F.lds + LDS_MISC_OFF) + 16;
    asm volatile("s_waitcnt vmcnt(0)" ::: "memory");
    __syncthreads();
    unsigned nbase = (unsigned)NMOE_ITEMS, arrived = 0u;
    if (tid == 0) { if (phase >= 0) arrived = __hip_atomic_fetch_add(F.ctl + CW_DONE + 64 * phase, 1u, __ATOMIC_RELAXED, __HIP_MEMORY_SCOPE_AGENT) + 1u;
                    if (phase < 0 || arrived < (unsigned)F.G) nbase = __hip_atomic_fetch_add(F.ctl + CW_CONV, (unsigned)(NWAVES * BLK), __ATOMIC_RELAXED, __HIP_MEMORY_SCOPE_AGENT); }
    for (;;) {
        if (tid == 0) fl[0] = nbase;
        __syncthreads();
        const unsigned base = fl[0];
        __syncthreads();
        if (base >= (unsigned)NMOE_ITEMS) break;
        if (tid == 0) {
            if (phase >= 0 && arrived >= (unsigned)F.G) nbase = (unsigned)NMOE_ITEMS;
            else { nbase = __hip_atomic_fetch_add(F.ctl + CW_CONV, (unsigned)(NWAVES * BLK), __ATOMIC_RELAXED, __HIP_MEMORY_SCOPE_AGENT);
                   if (phase >= 0) arrived = __hip_atomic_load(F.ctl + CW_DONE + 64 * phase, __ATOMIC_RELAXED, __HIP_MEMORY_SCOPE_AGENT); } }
        const int b0 = (int)base + F.wave * BLK, b1 = b0 + BLK;
        conv_items(F, lane, b0, 1, b1 < NMOE_ITEMS ? b1 : NMOE_ITEMS);
    }
}
__device__ __forceinline__ void p0_prologue(Frame& F) {
    int tid = threadIdx.x; asm volatile("" : "+v"(tid)); const int lane = tid & 63;
    const int gw = F.vcu * NWAVES + F.wave, NGW = F.G * NWAVES;
    conv_items(F, lane, NMOE_ITEMS + gw, NGW, NALL_ITEMS);
    rows_rms_phase(F, F.in[0], F.in[2], WSP(bf16_t, WS_XN), T, WSP(unsigned char, WS_XN8));
    rows_rms_phase(F, F.in[1], F.in[13], WSP(bf16_t, WS_MEMN), BATCH * 256);
    int* rs = WSP(int, WS_ROWSLOT);
    for (int i = blockIdx.x * NTHR + tid; i < XROWS; i += F.G * NTHR) rs[i] = -1;
    { unsigned* rt = WSP(unsigned, WS_ROWTOK); for (int i = blockIdx.x * NTHR + tid; i < XROWS / 2; i += F.G * NTHR) rt[i] = 0u; }
    { bf16_t* WRT = WSP(bf16_t, WS_WRT); const float* Wr = F.in[18]; const float* gffn = F.in[17];
      for (int i = blockIdx.x * NTHR + tid; i < NE * DM; i += F.G * NTHR) { const int e = i >> 11, k = i & (DM - 1);
          const float w = Wr[(size_t)k * NE + e] * gffn[k]; const unsigned h0 = f2bf(w); const float r1 = w - __builtin_bit_cast(float, h0 << 16);
          const unsigned h1 = f2bf(r1); const float r2 = r1 - __builtin_bit_cast(float, h1 << 16); const unsigned h2 = f2bf(r2);
          const int c = k >> 9, wv = (k >> 6) & 7, kk = (k >> 4) & 3, hi_ = (k >> 3) & 1, j = k & 7;
          const size_t d = ((size_t)((wv * 16 + 4 * c + kk) * 3) * 64 + 32 * hi_ + e) * 8 + j;
          WRT[d] = (bf16_t)h0; WRT[d + 512] = (bf16_t)h1; WRT[d + 1024] = (bf16_t)h2; } }
}

__device__ __forceinline__ void route_r1(Frame& F) {
    const bf16_t* H2 = WSP(bf16_t, WS_H); const float* gffn = F.in[17]; const float* br = F.in[19]; const u32x4* WRTF = WSP(u32x4, WS_WRT);
    unsigned char* XN3 = WSP(unsigned char, WS_XN); int* TOPI = WSP(int, WS_TOPI); float* TOPW = WSP(float, WS_TOPW);
    LAS unsigned char* Xb = F.lds;
    LAS float* Lp = (LAS float*)(F.lds + 67584);
    LAS float* rsq = (LAS float*)(F.lds + 100352);
    LAS float* rstd_s = (LAS float*)(F.lds + 100864);
    LAS float* Lg = (LAS float*)(F.lds + 100992);
    LAS int* hist = (LAS int*)(F.lds + 105216);
    int tid = threadIdx.x; asm volatile("" : "+v"(tid)); const int lane = tid & 63;
    const int wave = F.wave, ql = lane & 31, hi = lane >> 5;
    u32x4 pf0[4], pf1[4];
#define R1_LOAD(P_, TASK_, CH_) do { _Pragma("unroll") for (int i = 0; i < 4; ++i) { const int f = tid + 512 * i, row = f >> 6, c8 = f & 63; \
        P_[i] = *(const u32x4*)(H2 + (size_t)((TASK_) * 32 + row) * DM + (CH_) * 512 + 8 * c8); } } while (0)
#define R1_CHUNK(P_, CH_) do { \
            LAS unsigned char* xb = Xb + ((CH_) & 1) * 33280; \
            bf16x8 bfr[4][3];                                     \
            _Pragma("unroll") for (int kk = 0; kk < 4; ++kk) _Pragma("unroll") for (int tm = 0; tm < 3; ++tm) bfr[kk][tm] = __builtin_bit_cast(bf16x8, WRTF[(size_t)((wave * 16 + 4 * (CH_) + kk) * 3 + tm) * 64 + lane]); \
            _Pragma("unroll") for (int i = 0; i < 4; ++i) { const int f = tid + 512 * i, row = f >> 6, c8 = f & 63; \
                f32x4 v0, v1; pg8::unpack8(P_[i], v0, v1); \
                sq[i] += ((v0[0] * v0[0] + v0[1] * v0[1]) + (v0[2] * v0[2] + v0[3] * v0[3])) + ((v1[0] * v1[0] + v1[1] * v1[1]) + (v1[2] * v1[2] + v1[3] * v1[3])); \
                *(LAS u32x4*)(xb + row * 1040 + 16 * c8) = P_[i]; } \
            if ((CH_) < 2) R1_LOAD(P_, task, (CH_) + 2); else if (task + F.G < T / 32) R1_LOAD(P_, task + F.G, (CH_) - 2); \
            __syncthreads();                                      \
            _Pragma("unroll") for (int kk = 0; kk < 4; ++kk) { const bf16x8 a = *(const LAS bf16x8*)(xb + ql * 1040 + (64 * wave + 16 * kk + 8 * hi) * 2); \
                _Pragma("unroll") for (int tm = 0; tm < 3; ++tm) acc = __builtin_amdgcn_mfma_f32_32x32x16_bf16(a, bfr[kk][tm], acc, 0, 0, 0); } } while (0)
    if (F.vcu < T / 32) { R1_LOAD(pf0, F.vcu, 0); R1_LOAD(pf1, F.vcu, 1); }
    for (int task = F.vcu; task < T / 32; task += F.G) {
        const int r0 = task * 32;
        f32x16 acc = {};
        float sq[4];
#pragma unroll
        for (int i = 0; i < 4; ++i) sq[i] = 0.f;
        if (tid < 32) hist[tid] = 0;
#pragma unroll 1
        for (int cp = 0; cp < 4; cp += 2) { R1_CHUNK(pf0, cp); R1_CHUNK(pf1, cp + 1); }
#pragma unroll
        for (int i = 0; i < 4; ++i) { const float s = wave_sum(sq[i]); if (lane == 0) rsq[(wave + 8 * i) * 4] = s; }
#pragma unroll
        for (int r = 0; r < 16; ++r) Lp[wave * 1024 + ((r & 3) + 8 * (r >> 2) + 4 * hi) * 32 + ql] = acc[r];
        __syncthreads();
#pragma unroll
        for (int i = 0; i < 2; ++i) { const int o = tid + 512 * i, tok = o >> 5, e = o & 31; float s = 0.f;
#pragma unroll
            for (int w = 0; w < 8; ++w) s += Lp[w * 1024 + o];
            const float rstd = 1.0f / sqrtf(rsq[tok * 4] * (1.0f / DM) + RMS_EPS);
            if (e == 0) rstd_s[tok] = rstd;
            Lg[tok * 33 + e] = s * rstd + br[e]; }
        __syncthreads();
        { const int tl = lane >> 4, j = lane & 15, tok = 4 * wave + tl; float v0 = Lg[tok * 33 + j], v1 = Lg[tok * 33 + j + 16]; int idx[4]; float val[4];
#pragma unroll
          for (int k = 0; k < 4; ++k) { float bv = v0 >= v1 ? v0 : v1; int bi = v0 >= v1 ? j : j + 16;
#pragma unroll
              for (int m = 1; m < 16; m <<= 1) { const float ov = __shfl_xor(bv, m); const int oi = __shfl_xor(bi, m); const bool take = ov > bv || (ov == bv && oi < bi); bv = take ? ov : bv; bi = take ? oi : bi; }
              idx[k] = bi; val[k] = bv; if (bi == j) v0 = -INFINITY; if (bi == j + 16) v1 = -INFINITY; }
          if (j == 0) { float ex[4], sum = 0.f;
#pragma unroll
              for (int k = 0; k < 4; ++k) { ex[k] = __expf(val[k] - val[0]); sum += ex[k]; }
              const float inv = 1.0f / sum; const int t = r0 + tok;
              *(int __attribute__((ext_vector_type(4)))*)(TOPI + t * 4) = (int __attribute__((ext_vector_type(4)))){idx[0], idx[1], idx[2], idx[3]};
              *(f32x4*)(TOPW + t * 4) = (f32x4){ex[0] * inv, ex[1] * inv, ex[2] * inv, ex[3] * inv};
#pragma unroll
              for (int k = 0; k < 4; ++k) atomicAdd((int*)&hist[idx[k]], 1); } }
#pragma unroll
        for (int rr = 0; rr < 4; ++rr) { const int row = 4 * wave + rr; const float rstd = rstd_s[row];
            const bf16_t* xr = H2 + (size_t)(r0 + row) * DM; unsigned char* orow = XN3 + (size_t)(r0 + row) * DM; const float r8 = rstd * 8.0f;
#pragma unroll
            for (int j = 0; j < 4; ++j) { f32x4 v0, v1; pg8::unpack8(((const u32x4*)xr)[lane + 64 * j], v0, v1);
                const f32x4 o0 = v0 * r8 * ((const f32x4*)gffn)[2 * (lane + 64 * j)], o1 = v1 * r8 * ((const f32x4*)gffn)[2 * (lane + 64 * j) + 1];
                u32x2 w; w.x = pg8::pk4_fp8(o0[0], o0[1], o0[2], o0[3]); w.y = pg8::pk4_fp8(o1[0], o1[1], o1[2], o1[3]); ((u32x2*)orow)[lane + 64 * j] = w; } }
        __syncthreads();
        if (tid < 32) { const int h = hist[tid]; if (h) atomicAdd(F.ctl + CW_CNT + tid, (unsigned)h); }
    }
}
__device__ __forceinline__ void route_r2(Frame& F) {
    const int* TOPI = WSP(int, WS_TOPI); const float* TOPW = WSP(float, WS_TOPW);
    int* ROWSLOT = WSP(int, WS_ROWSLOT); float* ROWW = WSP(float, WS_ROWW); unsigned short* ROWTOK = WSP(unsigned short, WS_ROWTOK);
    LAS int* pst = (LAS int*)F.lds; LAS int* lcnt = pst + 32; LAS int* lbase = pst + 64; LAS int* tmpc = pst + 96;
    int tid = threadIdx.x; asm volatile("" : "+v"(tid));
    if (tid < 32) { const unsigned c = __hip_atomic_load(F.ctl + CW_CNT + tid, __ATOMIC_RELAXED, __HIP_MEMORY_SCOPE_AGENT); tmpc[tid] = (int)((c + 255u) & ~255u); }
    __syncthreads();
    if (tid == 0) { int a = 0; for (int e = 0; e < 32; ++e) { pst[e] = a; a += tmpc[e]; } }
    __syncthreads();
    for (int task = F.vcu; task < T / 64; task += F.G) {
        if (tid < 32) lcnt[tid] = 0;
        __syncthreads();
        int e = 0, rank = 0, t = 0, k = 0; float w = 0.f;
        if (tid < 256) { t = 64 * task + (tid >> 2); k = tid & 3; e = TOPI[t * 4 + k]; w = TOPW[t * 4 + k]; rank = atomicAdd((int*)&lcnt[e], 1); }
        __syncthreads();
        if (tid < 32) { const int n = lcnt[tid]; lbase[tid] = n ? (int)atomicAdd(F.ctl + CW_CUR + tid, (unsigned)n) : 0; }
        __syncthreads();
        if (tid < 256) { const int p = pst[e] + lbase[e] + rank; ROWSLOT[p] = t * 4 + k; ROWW[p] = w; ROWTOK[((p >> 8) * 64 + (p & 63)) * 4 + ((p >> 6) & 3)] = (unsigned short)t; }
        __syncthreads();
    }
}
__device__ __forceinline__ int moe_tile_table(Frame& F) {
    LAS int* tab = (LAS int*)(F.lds + LDS_TAB_OFF); LAS int* pt = tab + 304;
    int tid = threadIdx.x; asm volatile("" : "+v"(tid));
    __syncthreads();
    if (tid < 32) { const unsigned c = __hip_atomic_load(F.ctl + CW_CNT + tid, __ATOMIC_RELAXED, __HIP_MEMORY_SCOPE_AGENT); pt[40 + tid] = (int)((c + 255u) >> 8); }
    __syncthreads();
    if (tid == 0) { int a = 0; for (int e = 0; e < 32; ++e) { pt[e] = a; a += pt[40 + e]; } pt[32] = a; tab[300] = a; }
    __syncthreads();
    const int total = tab[300];
    for (int j = tid; j < total; j += NTHR) { int e = 0; for (int x = 0; x < 32; ++x) if (pt[x + 1] <= j) e = x + 1; tab[j] = e; }
    __syncthreads();
    return total;
}
__device__ __forceinline__ void final_phase(Frame& F) {
    const bf16_t* H2 = WSP(bf16_t, WS_H); const unsigned char* MO = WSP(unsigned char, WS_MOEOUT); const float* gain = F.in[24];
    int lane = threadIdx.x; asm volatile("" : "+v"(lane)); lane &= 63;
    const int gw = F.vcu * NWAVES + F.wave, NGW = F.G * NWAVES;
    for (int r = gw; r < T; r += NGW) {
        f32x4 v[8];
#pragma unroll
        for (int j = 0; j < 8; ++j) { const u32x2 w = ((const u32x2*)(H2 + (size_t)r * DM))[lane + 64 * j]; v[j] = (f32x4){bf_lo(w.x), bf_hi(w.x), bf_lo(w.y), bf_hi(w.y)}; }
#pragma unroll
        for (int k = 0; k < 4; ++k) { const unsigned* mr = (const unsigned*)(MO + (size_t)(4 * r + k) * DM);
#pragma unroll
            for (int j = 0; j < 8; ++j) { const unsigned w = mr[lane + 64 * j]; const f32x2 lo = __builtin_amdgcn_cvt_pk_f32_fp8((int)w, false), hi = __builtin_amdgcn_cvt_pk_f32_fp8((int)w, true);
                v[j][0] += lo[0] * (1.0f / 32.0f); v[j][1] += lo[1] * (1.0f / 32.0f); v[j][2] += hi[0] * (1.0f / 32.0f); v[j][3] += hi[1] * (1.0f / 32.0f); } }
        float s = 0.f;
#pragma unroll
        for (int j = 0; j < 8; ++j) s += (v[j][0] * v[j][0] + v[j][1] * v[j][1]) + (v[j][2] * v[j][2] + v[j][3] * v[j][3]);
        const float rstd = 1.0f / sqrtf(wave_sum(s) * (1.0f / DM) + RMS_EPS);
#pragma unroll
        for (int j = 0; j < 8; ++j) { const f32x4 g = ((const f32x4*)gain)[lane + 64 * j]; ((f32x4*)(F.out + (size_t)r * DM))[lane + 64 * j] = v[j] * rstd * g; }
    }
}

namespace att {
constexpr int VP = 72;
__device__ __forceinline__ int pi32(int m) { return (m & ~12) | ((m & 4) << 1) | ((m & 8) >> 1); }
__device__ __forceinline__ float pmax(float v) { auto rr = __builtin_amdgcn_permlane32_swap(__float_as_uint(v), __float_as_uint(v), false, false); return fmaxf(__uint_as_float(rr[0]), __uint_as_float(rr[1])); }
__device__ __forceinline__ float max3f(float a, float b, float c) { float r; asm("v_max3_f32 %0, %1, %2, %3" : "=v"(r) : "v"(a), "v"(b), "v"(c)); return r; }
__device__ __forceinline__ float psum(float v) { auto rr = __builtin_amdgcn_permlane32_swap(__float_as_uint(v), __float_as_uint(v), false, false); return __uint_as_float(rr[0]) + __uint_as_float(rr[1]); }

template <int DQK, int DV, int MASK>
__device__ __forceinline__ void tile_compute(const LAS bf16_t* Ks, const LAS bf16_t* Vs, const bf16x8 (&qf)[DQK / 16], f32x16 (&cin)[2], f32x16 (&o)[DV / 32], float& l, float& mtot,
                                             bool first, bool domask, int qpos, int kbase, int lane) {
    constexpr int KP = DQK + 8, NDS = DQK / 16, NDB = DV / 32;
    const int ql = lane & 31, hi = lane >> 5;
    f32x16 p[2];
#pragma unroll
    for (int j = 0; j < 2; ++j) { const LAS bf16_t* kr = Ks + (32 * j + pi32(ql)) * KP + 8 * hi;
#pragma unroll
        for (int ds = 0; ds < NDS; ++ds) { const bf16x8 kf = *(const LAS bf16x8*)(kr + 16 * ds);
            p[j] = __builtin_amdgcn_mfma_f32_32x32x16_bf16(kf, qf[ds], ds == 0 ? cin[j] : p[j], 0, 0, 0); } }
    if (MASK != 0 && domask) {
#pragma unroll
        for (int j = 0; j < 2; ++j)
#pragma unroll
            for (int r = 0; r < 16; ++r) { const int key = kbase + 32 * j + 16 * (r >> 3) + 8 * hi + (r & 7);
                bool ok = key <= qpos; if (MASK == 2) ok = ok && (key > qpos - 128);
                p[j][r] = ok ? p[j][r] : -INFINITY; }
    }
    float mx = fmaxf(p[0][0], p[1][0]);
#pragma unroll
    for (int r = 1; r < 16; ++r) mx = fmaxf(mx, fmaxf(p[0][r], p[1][r]));
    mx = pmax(mx);
    if (first || __any(mx > 10.0f)) {
        const float delta = first ? mx : fmaxf(mx, 0.f);
#pragma unroll
        for (int j = 0; j < 2; ++j)
#pragma unroll
            for (int r = 0; r < 16; ++r) { p[j][r] -= delta; cin[j][r] -= delta; }
        mtot += delta;
        if (!first) { const float alpha = __builtin_amdgcn_exp2f(-delta); l *= alpha;
#pragma unroll
            for (int db = 0; db < NDB; ++db)
#pragma unroll
                for (int r = 0; r < 16; ++r) o[db][r] *= alpha; }
    }
    float s = 0.f;
#pragma unroll
    for (int j = 0; j < 2; ++j)
#pragma unroll
        for (int r = 0; r < 16; ++r) { p[j][r] = __builtin_amdgcn_exp2f(p[j][r]); s += p[j][r]; }
    l += s;
#pragma unroll
    for (int st = 0; st < 4; ++st) { const int j = st >> 1, a = st & 1;
        u32x4 pw; pw.x = pk2(p[j][8 * a + 0], p[j][8 * a + 1]); pw.y = pk2(p[j][8 * a + 2], p[j][8 * a + 3]); pw.z = pk2(p[j][8 * a + 4], p[j][8 * a + 5]); pw.w = pk2(p[j][8 * a + 6], p[j][8 * a + 7]);
        const bf16x8 pf = __builtin_bit_cast(bf16x8, pw);
#pragma unroll
        for (int db = 0; db < NDB; ++db) { const bf16x8 vf = *(const LAS bf16x8*)(Vs + (32 * db + ql) * VP + 16 * st + 8 * hi);
            o[db] = __builtin_amdgcn_mfma_f32_32x32x16_bf16(vf, pf, o[db], 0, 0, 0); } }
}
template <bool ALIBI>
__device__ __forceinline__ void cin_init(f32x16 (&cin)[2], float slope2, int kbase, int qpos, int hi) {
#pragma unroll
    for (int j = 0; j < 2; ++j)
#pragma unroll
        for (int r = 0; r < 16; ++r) cin[j][r] = ALIBI ? slope2 * (float)(kbase + 32 * j + 16 * (r >> 3) + 8 * hi + (r & 7) - qpos) : 0.f;
}

__device__ __forceinline__ int swz7(int row) { return (row ^ (row >> 3)) & 7; }
template <int MASK>
__device__ __forceinline__ void tile_compute_sw(unsigned slot, int kmat, const unsigned (&krow)[2], const unsigned (&kswz)[2], const unsigned (&vrow)[4], const unsigned (&vswz)[4],
                                                const bf16x8 (&qf)[4], float slope2, f32x16 (&o)[4], float& l, float& mtot, bool first, bool domask, int qpos, int kbase, int lane) {
    const int hi = lane >> 5;
    const float base = slope2 * (float)(kbase - qpos + 8 * hi) - mtot;
    f32x16 p[2];
    bf16x8 kf[2][4];
#pragma unroll
    for (int j = 0; j < 2; ++j)
#pragma unroll
        for (int ds = 0; ds < 4; ++ds) kf[j][ds] = *(const LAS bf16x8*)(unsigned long)(slot + kmat * 8192 + krow[j] + ((unsigned)(32 * ds + 16 * hi) ^ kswz[j]));
    __builtin_amdgcn_sched_barrier(0);
#pragma unroll
    for (int j = 0; j < 2; ++j)
#pragma unroll
        for (int r = 0; r < 16; ++r) p[j][r] = __builtin_fmaf(slope2, (float)(32 * j + 16 * (r >> 3) + (r & 7)), base);
#pragma unroll
    for (int j = 0; j < 2; ++j)
#pragma unroll
        for (int ds = 0; ds < 4; ++ds) p[j] = __builtin_amdgcn_mfma_f32_32x32x16_bf16(kf[j][ds], qf[ds], p[j], 0, 0, 0);
    asm volatile("s_nop 15\n\ts_nop 7" : "+v"(p[0]), "+v"(p[1]));
    bf16x8 vf[4];
#pragma unroll
    for (int db = 0; db < 4; ++db) vf[db] = *(const LAS bf16x8*)(unsigned long)(slot + 16384 + vrow[db] + ((unsigned)(16 * hi) ^ vswz[db]));
    if (MASK != 0 && domask) {
#pragma unroll
        for (int j = 0; j < 2; ++j)
#pragma unroll
            for (int r = 0; r < 16; ++r) { const int key = kbase + 32 * j + 16 * (r >> 3) + 8 * hi + (r & 7); p[j][r] = key <= qpos ? p[j][r] : -INFINITY; }
    }
    float mx = max3f(p[0][0], p[1][0], p[0][1]);
#pragma unroll
    for (int r = 1; r < 15; ++r) mx = max3f(mx, p[1][r], p[0][r + 1]);
    mx = max3f(mx, p[1][15], mx);
    mx = pmax(mx);
    if (first || __any(mx > 10.0f)) {
        const float delta = first ? mx : fmaxf(mx, 0.f);
#pragma unroll
        for (int j = 0; j < 2; ++j)
#pragma unroll
            for (int r = 0; r < 16; ++r) p[j][r] -= delta;
        mtot += delta;
        if (!first) { const float alpha = __builtin_amdgcn_exp2f(-delta); l *= alpha;
#pragma unroll
            for (int db = 0; db < 4; ++db)
#pragma unroll
                for (int r = 0; r < 16; ++r) o[db][r] *= alpha; }
    }
    float s = 0.f;
    u32x4 pw;
#define EXPPACK(st_) do { const int j_ = (st_) >> 1, a_ = (st_) & 1; \
        _Pragma("unroll") for (int r = 0; r < 8; ++r) { p[j_][8 * a_ + r] = __builtin_amdgcn_exp2f(p[j_][8 * a_ + r]); s += p[j_][8 * a_ + r]; } \
        pw.x = pk2(p[j_][8 * a_ + 0], p[j_][8 * a_ + 1]); pw.y = pk2(p[j_][8 * a_ + 2], p[j_][8 * a_ + 3]); pw.z = pk2(p[j_][8 * a_ + 4], p[j_][8 * a_ + 5]); pw.w = pk2(p[j_][8 * a_ + 6], p[j_][8 * a_ + 7]); } while (0)
    EXPPACK(0);
#pragma unroll
    for (int st = 0; st < 4; ++st) {
        const bf16x8 pf = __builtin_bit_cast(bf16x8, pw);
        bf16x8 vn[4];
        if (st < 3) {
#pragma unroll
            for (int db = 0; db < 4; ++db) vn[db] = *(const LAS bf16x8*)(unsigned long)(slot + 16384 + vrow[db] + ((unsigned)(32 * (st + 1) + 16 * hi) ^ vswz[db])); }
        __builtin_amdgcn_sched_barrier(0);
#pragma unroll
        for (int db = 0; db < 4; ++db) o[db] = __builtin_amdgcn_mfma_f32_32x32x16_bf16(vf[db], pf, o[db], 0, 0, 0);
        if (st < 3) { EXPPACK(st + 1);
#pragma unroll
            for (int db = 0; db < 4; ++db) vf[db] = vn[db]; } }
#undef EXPPACK
    l += s;
}
__device__ __forceinline__ void diff_unit(LAS unsigned char* lds, const bf16_t* PROJ, const bf16_t* VT, bf16_t* YD, const float* subg, float lam, const unsigned* kmax2, int b, int h, int i) {
    int tid = threadIdx.x; asm volatile("" : "+v"(tid)); const int lane = tid & 63, wid = __builtin_amdgcn_readfirstlane(tid >> 6), ql = lane & 31, hi = lane >> 5, c = wid >> 2, w4 = wid & 3;
    const int qw0 = 128 * i + 32 * w4, qpos = qw0 + ql;
    const size_t rowbase = (size_t)b * SEQ;
    constexpr unsigned SLOT = 32768;
    const unsigned lds0 = (unsigned)(unsigned long)lds;
    LAS unsigned* flags = (LAS unsigned*)(lds + LDS_FLAG_OFF);
    if (lane == 0) { flags[wid] = 0u; flags[8 + wid] = 0u; }
    bool wdone = false;
    const int R = 8 * wid + (lane >> 3), cp = lane & 7;
    const unsigned voffK = (unsigned)(R * NPROJ + 8 * (cp ^ swz7(R))) * 2u;
    const unsigned voffV0 = (unsigned)(R * T + 8 * (cp ^ swz7(R))) * 2u, voffV1 = (unsigned)((R + 64) * T + 8 * (cp ^ swz7(R + 64))) * 2u;
    const char* Kbase = (const char*)(PROJ + rowbase * NPROJ + PC_KD + h * 128);
    const char* Vbase = (const char*)(VT + (size_t)(256 + h * 128) * T + rowbase);
    const unsigned pdst = lds0 + (unsigned)wid * 1024u;
#define DIFF_DMA(t, so) do { const char* kb_ = Kbase + (size_t)(t) * (64 * NPROJ * 2); const char* vb_ = Vbase + (size_t)(t) * 128; \
        pg8::glds16_s(kb_, voffK, pdst + (so)); pg8::glds16_s(kb_ + 128, voffK, pdst + (so) + 8192u); \
        pg8::glds16_s(vb_, voffV0, pdst + (so) + 16384u); pg8::glds16_s(vb_, voffV1, pdst + (so) + 24576u); } while (0)
    unsigned krow[2], kswz[2], vrow[4], vswz[4];
#pragma unroll
    for (int j = 0; j < 2; ++j) { const int row = 32 * j + pi32(ql); krow[j] = (unsigned)row * 128u; kswz[j] = (unsigned)swz7(row) * 16u; }
#pragma unroll
    for (int db = 0; db < 4; ++db) { const int row = 32 * db + ql; vrow[db] = (unsigned)row * 128u; vswz[db] = (unsigned)swz7(row) * 16u; }
    const float slope2 = __builtin_amdgcn_exp2f(-(float)(h + 1)) * LOG2E;
    f32x16 o[4]; float l = 0.f, mtot = 0.f;
#pragma unroll
    for (int db = 0; db < 4; ++db) o[db] = f32x16{};
    const int thi = 2 * i + 1;
    DIFF_DMA(thi, 0u);
    DIFF_DMA(thi - 1, SLOT);
    bf16x8 qf[4];
    { const bf16_t* Qp = PROJ + (rowbase + qpos) * NPROJ + PC_QD + h * 128 + c * 64 + 8 * hi;
#pragma unroll
      for (int ds = 0; ds < 4; ++ds) qf[ds] = *(const bf16x8*)(Qp + 16 * ds); }
    unsigned kmx_bits = __hip_atomic_load(kmax2 + (b * 8 + h) * 2 + c, __ATOMIC_RELAXED, __HIP_MEMORY_SCOPE_AGENT);
    asm volatile("s_waitcnt vmcnt(0)" ::: "memory");
    asm volatile("" : "+v"(qf[0]), "+v"(qf[1]), "+v"(qf[2]), "+v"(qf[3]), "+v"(kmx_bits));
    const float kmx = sqrtf(__uint_as_float(kmx_bits)) * 1.001f;
    float qk_bound;
    { float s2 = 0.f;
#pragma unroll
      for (int ds = 0; ds < 4; ++ds) { const u32x4 w = __builtin_bit_cast(u32x4, qf[ds]);
#pragma unroll
          for (int e = 0; e < 4; ++e) { const float a = bf_lo(w[e]), b2 = bf_hi(w[e]); s2 += a * a + b2 * b2; } }
      qk_bound = sqrtf(psum(s2)) * 1.001f * kmx; }
    unsigned so = 0u; bool first = true;
    if (wid >= 4) __builtin_amdgcn_s_setprio(1);
    for (int t = thi; t >= 0; --t) {
        if (t >= 1) asm volatile("s_waitcnt vmcnt(4) lgkmcnt(0)\n\ts_barrier" ::: "memory"); else asm volatile("s_waitcnt vmcnt(0) lgkmcnt(0)\n\ts_barrier" ::: "memory");
        { const LAS unsigned* fs = flags + ((t + 1) & 1) * 8; const u32x4 f0 = *(const LAS u32x4*)fs, f1 = *(const LAS u32x4*)(fs + 4);
          if ((f0.x & f0.y & f0.z & f0.w & f1.x & f1.y & f1.z & f1.w) != 0u) break; }
        if (t >= 2) { const unsigned sn = so >= SLOT ? so - SLOT : so + 2 * SLOT; DIFF_DMA(t - 2, sn); }
        const int kbase = 64 * t;
        if (kbase <= qw0 + 31 && !wdone) {
            tile_compute_sw<1>(lds0 + so, c, krow, kswz, vrow, vswz, qf, slope2, o, l, mtot, first, kbase + 63 > qw0, qpos, kbase, lane);
            first = false;
            const float emax = qk_bound - slope2 * (float)(qpos - kbase + 1) - mtot;
            if (__all(emax < -127.0f)) wdone = true;
        }
        if (lane == 0) flags[(t & 1) * 8 + wid] = wdone ? 1u : 0u;
        so = so >= 2 * SLOT ? 0u : so + SLOT;
    }
    asm volatile("s_waitcnt vmcnt(0)" ::: "memory");
#undef DIFF_DMA
    __builtin_amdgcn_s_setprio(0);
    const float inv = 1.0f / psum(l);
    __syncthreads();
    LAS float* X = (LAS float*)lds + w4 * 4096;
    if (c == 1) {
#pragma unroll
        for (int db = 0; db < 4; ++db)
#pragma unroll
            for (int r = 0; r < 16; ++r) X[(db * 16 + r) * 64 + lane] = o[db][r] * inv;
    }
    __syncthreads();
    if (c == 0) {
        float ss = 0.f;
#pragma unroll
        for (int db = 0; db < 4; ++db)
#pragma unroll
            for (int r = 0; r < 16; ++r) { const float d = o[db][r] * inv - lam * X[(db * 16 + r) * 64 + lane]; o[db][r] = d; ss += d * d; }
        ss = psum(ss);
        const float rstd = 0.8f / sqrtf(ss * (1.0f / 128.0f) + RMS_EPS);
        bf16_t* yp = YD + (rowbase + qpos) * 1024 + h * 128 + 4 * hi;
#pragma unroll
        for (int db = 0; db < 4; ++db)
#pragma unroll
            for (int g4 = 0; g4 < 4; ++g4) { const f32x4 g = *(const f32x4*)(subg + 32 * db + 8 * g4 + 4 * hi);
                u32x2 w; w.x = pk2(o[db][4 * g4] * rstd * g[0], o[db][4 * g4 + 1] * rstd * g[1]); w.y = pk2(o[db][4 * g4 + 2] * rstd * g[2], o[db][4 * g4 + 3] * rstd * g[3]);
                *(u32x2*)(yp + 32 * db + 8 * g4) = w; }
    }
    __syncthreads();
}

__device__ __forceinline__ void swa_unit(LAS unsigned char* lds, const bf16_t* PROJ, const bf16_t* VT, bf16_t* YA, const float* sinks, int b, int hk, int i) {
    int tid = threadIdx.x; asm volatile("" : "+v"(tid)); const int lane = tid & 63, wid = __builtin_amdgcn_readfirstlane(tid >> 6), ql = lane & 31, hi = lane >> 5;
    const int hq = hk * 4 + (wid >> 1), qw0 = 64 * i + 32 * (wid & 1), qpos = qw0 + ql;
    const size_t rowbase = (size_t)b * SEQ;
    constexpr int BUF = 18432, VOFF = 9216;
    bf16x8 qf[4];
    { const bf16_t* Qp = PROJ + (rowbase + qpos) * NPROJ + PC_QA + hq * 64 + 8 * hi;
#pragma unroll
      for (int ds = 0; ds < 4; ++ds) qf[ds] = *(const bf16x8*)(Qp + 16 * ds); }
    const int krow = tid >> 3, kch = tid & 7;
    const bf16_t* Kg = PROJ + (rowbase + krow) * NPROJ + PC_KA + hk * 64 + kch * 8;
    const bf16_t* Vg = VT + (size_t)(hk * 64 + krow) * T + rowbase + kch * 8;
    const int sdst = (krow * 72 + kch * 8) * 2;
    const float slope2 = __builtin_amdgcn_exp2f(-0.5f * (float)(hq + 1)) * LOG2E;
    f32x16 cin[2], o[2]; float l = 0.f, mtot = 0.f;
    o[0] = f32x16{}; o[1] = f32x16{};
    u32x4 sk, sv;
    const int thi = i, tlo = i >= 2 ? i - 2 : 0;
    sk = *(const u32x4*)(Kg + (size_t)thi * 64 * NPROJ); sv = *(const u32x4*)(Vg + thi * 64);
    int bo = 0; bool first = true;
    for (int t = thi; t >= tlo; --t) {
        *(LAS u32x4*)(lds + bo + sdst) = sk; *(LAS u32x4*)(lds + bo + VOFF + sdst) = sv;
        __syncthreads();
        if (t > tlo) { sk = *(const u32x4*)(Kg + (size_t)(t - 1) * 64 * NPROJ); sv = *(const u32x4*)(Vg + (t - 1) * 64); }
        const int kbase = 64 * t;
        if (first) cin_init<true>(cin, slope2, kbase, qpos, hi);
        tile_compute<64, 64, 2>((const LAS bf16_t*)(lds + bo), (const LAS bf16_t*)(lds + bo + VOFF), qf, cin, o, l, mtot, first, true, qpos, kbase, lane);
        first = false;
        const float step = 64.f * slope2;
#pragma unroll
        for (int j = 0; j < 2; ++j)
#pragma unroll
            for (int r = 0; r < 16; ++r) cin[j][r] -= step;
        bo ^= BUF;
    }
    const float lt = psum(l), sink2 = sinks[hq] * LOG2E, M = fmaxf(mtot, sink2), f = __builtin_amdgcn_exp2f(mtot - M);
    const float sc = f / (lt * f + __builtin_amdgcn_exp2f(sink2 - M));
    bf16_t* yp = YA + (rowbase + qpos) * 1024 + hq * 64 + 4 * hi;
#pragma unroll
    for (int db = 0; db < 2; ++db)
#pragma unroll
        for (int g4 = 0; g4 < 4; ++g4) { u32x2 w; w.x = pk2(o[db][4 * g4] * sc, o[db][4 * g4 + 1] * sc); w.y = pk2(o[db][4 * g4 + 2] * sc, o[db][4 * g4 + 3] * sc);
            *(u32x2*)(yp + 32 * db + 8 * g4) = w; }
    __syncthreads();
}

__device__ __forceinline__ void cross_unit(LAS unsigned char* lds, const bf16_t* QC, const bf16_t* KM, const bf16_t* VMT, bf16_t* OC, int b, int h, int i) {
    int tid = threadIdx.x; asm volatile("" : "+v"(tid)); const int lane = tid & 63, wid = __builtin_amdgcn_readfirstlane(tid >> 6), ql = lane & 31, hi = lane >> 5;
    const int qpos = 256 * i + 32 * wid + ql;
    const size_t rowbase = (size_t)b * SEQ;
    constexpr int BUF = 35840, VOFF = 17408;
    bf16x8 qf[8];
    { const bf16_t* Qp = QC + (rowbase + qpos) * 512 + h * 128 + 8 * hi;
#pragma unroll
      for (int ds = 0; ds < 8; ++ds) qf[ds] = *(const bf16x8*)(Qp + 16 * ds); }
    const int kr0 = tid >> 4, kc0 = tid & 15, vr0 = tid >> 3, vc0 = tid & 7;
    const bf16_t* Kg = KM + (size_t)(b * 256 + kr0) * 512 + h * 128 + kc0 * 8;
    const bf16_t* Vg = VMT + (size_t)(h * 128 + vr0) * 512 + b * 256 + vc0 * 8;
    const int kdst = (kr0 * 136 + kc0 * 8) * 2, vdst = (vr0 * 72 + vc0 * 8) * 2;
    f32x16 cin[2], o[4]; float l = 0.f, mtot = 0.f;
#pragma unroll
    for (int db = 0; db < 4; ++db) o[db] = f32x16{};
    cin_init<false>(cin, 0.f, 0, 0, 0);
    u32x4 sk0, sk1, sv0, sv1;
#define CR_LOAD(t) do { sk0 = *(const u32x4*)(Kg + (size_t)(t) * 64 * 512); sk1 = *(const u32x4*)(Kg + (size_t)((t) * 64 + 32) * 512); \
        sv0 = *(const u32x4*)(Vg + (t) * 64); sv1 = *(const u32x4*)(Vg + (size_t)64 * 512 + (t) * 64); } while (0)
    CR_LOAD(3);
    int bo = 0; bool first = true;
    for (int t = 3; t >= 0; --t) {
        *(LAS u32x4*)(lds + bo + kdst) = sk0; *(LAS u32x4*)(lds + bo + kdst + 32 * 136 * 2) = sk1;
        *(LAS u32x4*)(lds + bo + VOFF + vdst) = sv0; *(LAS u32x4*)(lds + bo + VOFF + vdst + 64 * 72 * 2) = sv1;
        __syncthreads();
        if (t > 0) CR_LOAD(t - 1);
        tile_compute<128, 128, 0>((const LAS bf16_t*)(lds + bo), (const LAS bf16_t*)(lds + bo + VOFF), qf, cin, o, l, mtot, first, false, qpos, 64 * t, lane);
        first = false;
        bo ^= BUF;
    }
#undef CR_LOAD
    const float inv = 1.0f / psum(l);
    bf16_t* yp = OC + (rowbase + qpos) * 512 + h * 128 + 4 * hi;
#pragma unroll
    for (int db = 0; db < 4; ++db)
#pragma unroll
        for (int g4 = 0; g4 < 4; ++g4) { u32x2 w; w.x = pk2(o[db][4 * g4] * inv, o[db][4 * g4 + 1] * inv); w.y = pk2(o[db][4 * g4 + 2] * inv, o[db][4 * g4 + 3] * inv);
            *(u32x2*)(yp + 32 * db + 8 * g4) = w; }
    __syncthreads();
}
}

constexpr int NPHASES = 14;
struct Args { const float* in[25]; float* out; unsigned char* ws; int ph_lo, ph_hi; };

__global__ void __launch_bounds__(NTHR, 2) mk_fwd(Args args) {
    extern __shared__ __attribute__((aligned(16))) unsigned char lds_raw[];
    Frame F;
    F.lds = (LAS unsigned char*)lds_raw;
    F.wave = __builtin_amdgcn_readfirstlane(threadIdx.x >> 6);
    F.G = gridDim.x; { const int bx = blockIdx.x; F.vcu = (F.G % 8 == 0) ? (bx % 8) * (F.G / 8) + bx / 8 : bx; }
    F.ws = args.ws; F.ctl = (unsigned*)(args.ws + WS_CTL); F.out = args.out;
#pragma unroll
    for (int i = 0; i < 25; ++i) F.in[i] = args.in[i];
    volatile LAS unsigned* MISC = (volatile LAS unsigned*)(F.lds + LDS_MISC_OFF);
    if (threadIdx.x < 64) MISC[threadIdx.x] = 0u;
    __syncthreads();
    XcdBarrier bar; bar.bar = F.ctl + CW_BAR; bar.x = 0; bar.st = nullptr;
    const int lo = args.ph_lo, hi = args.ph_hi;
    if (hi - lo > 1) bar = xcd_barrier_post(F.ctl + CW_BAR, MISC + 8);
#define IN(k) (lo <= (k) && (k) < hi)
#define SEAM(k) do { if (IN(k) && IN((k) + 1)) xcd_barrier(bar); } while (0)
    LAS unsigned char* lds = F.lds;
    const int bid = blockIdx.x;
    bf16_t* XN = WSP(bf16_t, WS_XN); bf16_t* PROJ = WSP(bf16_t, WS_PROJ); bf16_t* VT = WSP(bf16_t, WS_VT); bf16_t* YA = WSP(bf16_t, WS_YA); bf16_t* YD = WSP(bf16_t, WS_YD);
    bf16_t* MERGED = WSP(bf16_t, WS_MERGED); bf16_t* H = WSP(bf16_t, WS_H); bf16_t* MEMN = WSP(bf16_t, WS_MEMN); bf16_t* KM = WSP(bf16_t, WS_KM); bf16_t* VMT = WSP(bf16_t, WS_VMT);
    bf16_t* QC = WSP(bf16_t, WS_QC); bf16_t* OC = WSP(bf16_t, WS_OC);

    if (IN(0)) { p0_prologue(F); }
    SEAM(0);
    if (IN(1)) {
        const pg8::Gemm g{DM, (size_t)128 * DM * 2};
        pg8::ProjOrder S{XN, WSP(bf16_t, WS_WIN), MEMN, WSP(bf16_t, WS_WCKV), F.G, bid}; pg8::EpiProjAll E{PROJ, VT, KM, VMT};
        pg8::gemm_phase<pg8::EpiProjAll, pg8::ProjOrder, true, true>(lds, g, S, E);
        { const pg8::Gemm g8{DM / 2, (size_t)128 * DM};
          pg8::StaticOrder S8; S8.init(WSP(bf16_t, WS_XN8), WSP(bf16_t, WS_WING8), T, 4096, DM / 2, F.G, bid); pg8::EpiGate E8{WSP(unsigned char, WS_G8)};
          pg8::gemm_phase<pg8::EpiGate, pg8::StaticOrder, true, true, true>(lds, g8, S8, E8); }
    }
    if (IN(1) && IN(2)) conv_filler<8>(F, 1);
    SEAM(1);
    if (IN(2)) {
        { int l_ = threadIdx.x; asm volatile("" : "+v"(l_)); l_ &= 63; float mx0 = 0.f, mx1 = 0.f;
          const int rs = F.G * NWAVES;
          for (int r = F.vcu * NWAVES + F.wave; r < T; r += 4 * rs) {
              u32x4 w0[4], w1[4];
#pragma unroll
              for (int q = 0; q < 4; ++q) { const int rq = r + q * rs; const u32x4* kp = (const u32x4*)(PROJ + (size_t)(rq < T ? rq : r) * NPROJ + PC_KD + 16 * l_); w0[q] = kp[0]; w1[q] = kp[1]; }
#pragma unroll
              for (int q = 0; q < 4; ++q) { const int rq = r + q * rs; float s2 = 0.f;
#pragma unroll
                  for (int e = 0; e < 4; ++e) { const float a0 = bf_lo(w0[q][e]), a1 = bf_hi(w0[q][e]), a2 = bf_lo(w1[q][e]), a3 = bf_hi(w1[q][e]); s2 += (a0 * a0 + a1 * a1) + (a2 * a2 + a3 * a3); }
                  s2 += __shfl_xor(s2, 1); s2 += __shfl_xor(s2, 2);
                  if (rq < T) { if (rq < SEQ) mx0 = fmaxf(mx0, s2); else mx1 = fmaxf(mx1, s2); } } }
          if ((l_ & 3) == 0) { atomicMax(F.ctl + CW_KMAX + (l_ >> 2), __float_as_uint(mx0)); atomicMax(F.ctl + CW_KMAX + 16 + (l_ >> 2), __float_as_uint(mx1)); } }
        asm volatile("s_waitcnt vmcnt(0)" ::: "memory");
        __syncthreads();
        if (threadIdx.x == 0) __hip_atomic_fetch_add(F.ctl + CW_KDONE, 1u, __ATOMIC_RELAXED, __HIP_MEMORY_SCOPE_AGENT);
        for (int n = F.vcu; n < 1024; n += F.G) { const int i = n & 127, bhk = n >> 7; att::swa_unit(lds, PROJ, VT, YA, F.in[4], bhk >> 2, bhk & 3, i); }
        if (threadIdx.x == 0) { while (__hip_atomic_load(F.ctl + CW_KDONE, __ATOMIC_RELAXED, __HIP_MEMORY_SCOPE_AGENT) < (unsigned)F.G) __builtin_amdgcn_s_sleep(4); }
        __syncthreads();
        float lam;
        { int l_ = threadIdx.x; asm volatile("" : "+v"(l_)); l_ &= 63; const float a = F.in[5][l_] * F.in[6][l_], b2 = F.in[7][l_] * F.in[8][l_];
          lam = __expf(wave_sum(a)) - __expf(wave_sum(b2)) + 0.2f; }
        { LAS int* qs = (LAS int*)(lds + LDS_FLAG_OFF + 128); LAS int* cost = qs + 32; LAS int* order = cost + 128;
          const int nq = (F.G % 8 == 0 && F.G >= 8) ? 8 : 1, x0 = (nq == 8) ? F.vcu / (F.G / 8) : 0, per = 1024 / nq;
          for (int qi = 0; qi < 1; ++qi) {
              const int x = (x0 + qi) % nq;
              __syncthreads();
              for (int u = threadIdx.x; u < per && nq == 8; u += NTHR) {
                  const int bh = (x >> 2) * 8 + ((u >> 6) ? 7 - (x & 3) : (x & 3)), i = u & 63;
                  const float s2 = __builtin_amdgcn_exp2f(-(float)((bh & 7) + 1)) * LOG2E; const int cut = (int)(146.0f / (s2 * 64.0f)) + 3;
                  const int c0 = 2 * i + 2; cost[u] = c0 < cut ? c0 : cut; }
              __syncthreads();
              if (nq == 8 && threadIdx.x < 128) { const int me = cost[threadIdx.x]; int r = 0; for (int u = 0; u < 128; ++u) { const int cu = cost[u]; r += (cu > me || (cu == me && u < (int)threadIdx.x)) ? 1 : 0; } order[r] = threadIdx.x; }
              int nxt = 0;
              if (threadIdx.x == 0) qs[0] = (int)atomicAdd(F.ctl + CW_QHEAD + 64 * x, 1u);
              __syncthreads();
              int n = qs[0];
              while (n < per) {
                  if (threadIdx.x == 0) nxt = (int)atomicAdd(F.ctl + CW_QHEAD + 64 * x, 1u);
                  int bh, i;
                  if (nq == 8) { const int u = order[n]; bh = (x >> 2) * 8 + ((u >> 6) ? 7 - (x & 3) : (x & 3)); i = u & 63; } else { bh = n & 15; i = 63 - (n >> 4); }
                  att::diff_unit(lds, PROJ, VT, YD, F.in[9], lam, F.ctl + CW_KMAX, bh >> 3, bh & 7, i);
                  if (threadIdx.x == 0) qs[0] = nxt;
                  __syncthreads();
                  n = qs[0];
              }
          } }
    }
    if (IN(2) && IN(3)) conv_filler<4>(F, 2);
    SEAM(2);
    if (IN(3)) {
        const pg8::Gemm g{1024, (size_t)128 * 1024 * 2};
        pg8::BranchOrder S{YA, YD, WSP(bf16_t, WS_WB), F.G, bid}; pg8::EpiBranchAll E{WSP(unsigned char, WS_G8), MERGED};
        pg8::gemm_phase<pg8::EpiBranchAll, pg8::BranchOrder, true, true>(lds, g, S, E);
    }
    SEAM(3);
    if (IN(4)) {
        const pg8::Gemm g{DM, (size_t)128 * DM * 2};
        pg8::StaticOrder S; S.init(MERGED, WSP(bf16_t, WS_WO), T, DM, DM, F.G, bid); pg8::EpiResid<false> E{F.in[0], H};
        pg8::gemm_phase<pg8::EpiResid<false>, pg8::StaticOrder, true, true>(lds, g, S, E);
    }
    SEAM(4);
    if (IN(5)) { rows_rstd_phase(F, H, WSP(float, WS_ROWSQP), F.ctl + CW_RSC, T); }
    if (IN(6)) {
        const pg8::Gemm g{DM, (size_t)128 * DM * 2};
        pg8::StaticOrder S; S.init(H, WSP(bf16_t, WS_WCQ), T, 512, DM, F.G, bid); pg8::EpiRowScale E{QC, 512, C2_128, WSP(float, WS_ROWSQP), F.ctl + CW_RSC};
        pg8::gemm_phase<pg8::EpiRowScale, pg8::StaticOrder, true, true>(lds, g, S, E);
    }
    if (IN(6) && IN(7)) conv_filler<8>(F, 6);
    SEAM(6);
    if (IN(7)) {
        for (int n = F.vcu; n < 256; n += F.G) att::cross_unit(lds, QC, KM, VMT, OC, n >> 7, (n >> 5) & 3, n & 31);
    }
    SEAM(7);
    if (IN(8)) {
        const pg8::Gemm g{512, (size_t)128 * 512 * 2};
        pg8::StaticOrder S; S.init(OC, WSP(bf16_t, WS_WCO), T, DM, 512, F.G, bid); pg8::EpiResid<true> E{H, H};
        pg8::gemm_phase<pg8::EpiResid<true>, pg8::StaticOrder, true, true>(lds, g, S, E);
    }
    SEAM(8);
    if (IN(9)) { route_r1(F); }
    SEAM(9);
    if (IN(10)) { route_r2(F); conv_filler<16>(F, -1); }
    SEAM(10);
    if (IN(11)) {
        const int ntiles = moe_tile_table(F);
        const pg8::Gemm g{DM / 2, (size_t)DFF * DM};
        pg8::MoeOrder<true> S{WSP(void, WS_XN), WSP(void, WS_WGU), (const LAS int*)(F.lds + LDS_TAB_OFF), ntiles, 16, F.G, F.vcu, (size_t)256 * DM, (size_t)2 * DFF * DM, (size_t)128 * DM, WSP(unsigned short, WS_ROWTOK)};
        pg8::EpiGlu E{F.in[21], WSP(unsigned char, WS_ACT)};
        pg8::gemm_phase<pg8::EpiGlu, pg8::MoeOrder<true>, true, true, true>(lds, g, S, E);
    }
    SEAM(11);
    if (IN(12)) {
        const int ntiles = moe_tile_table(F);
        const pg8::Gemm g{DFF / 2, (size_t)128 * DFF};
        pg8::MoeOrder<false> S{WSP(void, WS_ACT), WSP(void, WS_WD), (const LAS int*)(F.lds + LDS_TAB_OFF), ntiles, 8, F.G, F.vcu, (size_t)256 * DFF, (size_t)DM * DFF, (size_t)256 * DFF, nullptr};
        pg8::EpiDown E{F.in[23], WSP(int, WS_ROWSLOT), WSP(float, WS_ROWW), WSP(unsigned char, WS_MOEOUT)};
        pg8::gemm_phase<pg8::EpiDown, pg8::MoeOrder<false>, true, true, true>(lds, g, S, E);
    }
    SEAM(12);
    if (IN(13)) { final_phase(F); }
#undef IN
#undef SEAM
}

extern "C" void kernel_launch(void* const* d_in, const int* in_sizes, int n_in, void* d_out, int out_size, void* d_ws, size_t ws_size, hipStream_t stream) {
    static int grid = 0;
    if (grid == 0) {
        if (n_in != 25 || out_size != T * DM || ws_size < WS_END) { fprintf(stderr, "kernel_launch: unexpected shapes (n_in %d out %d ws %zu need %zu)\n", n_in, out_size, ws_size, (size_t)WS_END); grid = -1; return; }
        int dev = 0, cus = 0, per_cu = 0;
        if (hipGetDevice(&dev) != hipSuccess || hipDeviceGetAttribute(&cus, hipDeviceAttributeMultiprocessorCount, dev) != hipSuccess) { grid = -1; return; }
        if (hipFuncSetAttribute((const void*)mk_fwd, hipFuncAttributeMaxDynamicSharedMemorySize, LDS_BYTES) != hipSuccess) { fprintf(stderr, "kernel_launch: hipFuncSetAttribute failed\n"); grid = -1; return; }
        if (hipOccupancyMaxActiveBlocksPerMultiprocessor(&per_cu, (const void*)mk_fwd, NTHR, LDS_BYTES) != hipSuccess || per_cu < 1) { fprintf(stderr, "kernel_launch: occupancy query says %d\n", per_cu); (void)hipGetLastError(); }
        grid = cus;
    }
    if (grid < 0) return;
    (void)hipMemsetAsync((char*)d_ws + WS_CTL, 0, CTL_ZERO_BYTES, stream);
    Args a{};
    for (int i = 0; i < 25; ++i) a.in[i] = (const float*)d_in[i];
    a.out = (float*)d_out; a.ws = (unsigned char*)d_ws;
    a.ph_lo = 0; a.ph_hi = NPHASES;
    hipLaunchKernelGGL(mk_fwd, dim3(grid), dim3(NTHR), LDS_BYTES, stream, a);
}
```

```cpp
#include <hip/hip_runtime.h>
#include <cstdio>
#include <cstdint>

#define LAS __attribute__((address_space(3)))
#define GAS __attribute__((address_space(1)))
typedef unsigned short bf16_t;
typedef short bf16x8 __attribute__((ext_vector_type(8)));
typedef float f32x4 __attribute__((ext_vector_type(4)));
typedef float f32x2 __attribute__((ext_vector_type(2)));
typedef float f32x16 __attribute__((ext_vector_type(16)));
typedef unsigned u32x4 __attribute__((ext_vector_type(4)));
typedef unsigned u32x2 __attribute__((ext_vector_type(2)));

constexpr int BATCH = 2, SEQ = 8192, T = BATCH * SEQ, DM = 2048;
constexpr int NPROJ = 7424;
constexpr int PC_QA = 0, PC_KA = 1024, PC_QD = 1280, PC_KD = 2304, PC_G = 3328;
constexpr int NVT = 1280;
constexpr int NE = 32, TOPK = 4, DFF = 2048;
constexpr int XROWS = 73728;
constexpr int MAXTILES = XROWS / 256;
constexpr float RMS_EPS = 1e-5f;
constexpr float LOG2E = 1.4426950408889634f;
constexpr float C2_64 = 0.125f * LOG2E;
constexpr float C2_128 = 0.08838834764831845f * LOG2E;

constexpr size_t MiB = 1u << 20;
constexpr size_t WS_CTL = 0, CTL_ZERO_BYTES = 1 * MiB;
constexpr size_t CTL_SS_OFF = 512 * 1024;
constexpr size_t WS_WIN = 2 * MiB;
constexpr size_t WS_WB = WS_WIN + 34 * MiB;
constexpr size_t WS_WO = WS_WB + 8 * MiB;
constexpr size_t WS_WCQ = WS_WO + 8 * MiB;
constexpr size_t WS_WCKV = WS_WCQ + 2 * MiB;
constexpr size_t WS_WCO = WS_WCKV + 4 * MiB;
constexpr size_t WS_WGU = WS_WCO + 2 * MiB;
constexpr size_t WS_WD = WS_WGU + 512 * MiB;
constexpr size_t WS_XN = WS_WD + 256 * MiB;
constexpr size_t WS_PROJ = WS_XN + 64 * MiB;
constexpr size_t WS_VT = WS_PROJ + 232 * MiB;
constexpr size_t WS_YA = WS_VT + 40 * MiB;
constexpr size_t WS_YD = WS_YA + 32 * MiB;
constexpr size_t WS_MERGED = WS_YD + 32 * MiB;
constexpr size_t WS_H = WS_MERGED + 64 * MiB;
constexpr size_t WS_MEMN = WS_H + 128 * MiB;
constexpr size_t WS_KM = WS_MEMN + 2 * MiB;
constexpr size_t WS_VMT = WS_KM + 1 * MiB;
constexpr size_t WS_QC = WS_VMT + 1 * MiB;
constexpr size_t WS_OC = WS_QC + 16 * MiB;
constexpr size_t WS_TOPI = WS_OC + 16 * MiB;
constexpr size_t WS_TOPW = WS_TOPI + 1 * MiB;
constexpr size_t WS_ROWSLOT = WS_TOPW + 1 * MiB;
constexpr size_t WS_ROWW = WS_ROWSLOT + 1 * MiB;
constexpr size_t WS_XG = WS_ROWW + 1 * MiB;
constexpr size_t WS_ACT = WS_XG + 288 * MiB;
constexpr size_t WS_MOEOUT = WS_ACT + 288 * MiB;
constexpr size_t WS_ROWSQP = WS_MOEOUT + 256 * MiB;
constexpr size_t WS_WING8 = WS_ROWSQP + 2 * MiB;
constexpr size_t WS_XN8 = WS_WING8 + 8 * MiB;
constexpr size_t WS_G8 = WS_XN8 + 32 * MiB;
constexpr size_t WS_WRT = WS_G8 + 64 * MiB;
constexpr size_t WS_ROWTOK = WS_WRT + 1 * MiB;
constexpr size_t WS_M8 = WS_ROWTOK + 1 * MiB;
constexpr size_t WS_END = WS_M8 + 32 * MiB;
constexpr int CW_CNT = 64;
constexpr int CW_CUR = 128;
constexpr int CW_QHEAD = 1024;
constexpr int CW_KMAX = 192;
constexpr int CW_KDONE = 448;
constexpr int CW_RSC = 16384;
constexpr int CW_CONV = 1920;
constexpr int CW_DONE = 2048;
constexpr int CW_BAR = 4096;

constexpr int RING_BYTES = 131072;
constexpr int LDS_FLAG_OFF = 131072;
constexpr int LDS_TAB_OFF = 134144;
constexpr int LDS_MISC_OFF = 136192;
constexpr int LDS_BYTES = 147456;
constexpr int NWAVES = 8, NTHR = 512;

__device__ __forceinline__ unsigned f2bf(float f) { unsigned u = __builtin_bit_cast(unsigned, f); return (u + 0x7fffu + ((u >> 16) & 1u)) >> 16; }
__device__ __forceinline__ unsigned pk2(float lo, float hi) { typedef __bf16 bf2 __attribute__((ext_vector_type(2))); f32x2 v = {lo, hi}; bf2 b = __builtin_convertvector(v, bf2); return __builtin_bit_cast(unsigned, b); }
__device__ __forceinline__ float bf_lo(unsigned w) { return __builtin_bit_cast(float, w << 16); }
__device__ __forceinline__ float bf_hi(unsigned w) { return __builtin_bit_cast(float, w & 0xffff0000u); }
__device__ __forceinline__ float wave_sum(float v) {
#pragma unroll
    for (int o = 1; o < 64; o <<= 1) v += __shfl_xor(v, o);
    return v;
}
#define LDS_WAIT() asm volatile("s_waitcnt lgkmcnt(0)" ::: "memory")
#define VM_WAIT() asm volatile("s_waitcnt vmcnt(0)" ::: "memory")
namespace pg8 {
#define PG8_LAS __attribute__((address_space(3)))
constexpr int BM = 256, BK = 64, HALF = 128, HTB = HALF * BK * 2  , STAGE_BYTES = 8 * HTB, NXCD = 8, WGM = 4;

__host__ __device__ __forceinline__ int lds_byte(int r, int c) { const int st = (r >> 4) * 2 + (c >> 5), rr = r & 15, cc = c & 31, ob = rr * 64 + cc * 2; return st * 1024 + (ob ^ (((ob >> 9) & 1) << 5)); }
__host__ __device__ __forceinline__ void stage_rc(int b, int& R, int& C) { const int st = b / 1024, sb = b % 1024, swz = sb ^ (((sb >> 9) & 1) << 5); R = (st >> 1) * 16 + swz / 64; C = (st & 1) * 32 + (swz % 64) / 2; }
__host__ __device__ __forceinline__ int perm32(int rho) { const int n = rho >> 4, i = rho & 15; return 8 * (i >> 2) + 4 * n + (i & 3); }

typedef int v8i_t __attribute__((ext_vector_type(8)));
__device__ __forceinline__ v8i_t cat16(bf16x8 a, bf16x8 b) { typedef int v4i_t __attribute__((ext_vector_type(4))); const v4i_t x = __builtin_bit_cast(v4i_t, a), y = __builtin_bit_cast(v4i_t, b); return (v8i_t){x[0], x[1], x[2], x[3], y[0], y[1], y[2], y[3]}; }
__device__ __forceinline__ void glds16_s(const char* sbase, unsigned voff, unsigned ldsdst) {
    unsigned keep;
    asm volatile("s_mov_b32 %0, m0\n\ts_mov_b32 m0, %3\n\ts_nop 2\n\tglobal_load_lds_dwordx4 %1, %2\n\ts_mov_b32 m0, %0" : "=&s"(keep) : "v"(voff), "s"(sbase), "s"(ldsdst) : "memory");
}
struct Unit { int pm, pn, e; };
struct Gemm { int K; size_t bhstep; };

struct StaticOrder {
    static constexpr bool GATHER = false;
    const bf16_t* A; const bf16_t* Bt; int K;
    int nM, nN, nwg, G, c;
    __device__ void init(const bf16_t* A_, const bf16_t* Bt_, int M, int N, int K_, int G_, int c_) { A = A_; Bt = Bt_; K = K_; nM = M / BM; nN = N / BM; nwg = nM * nN; G = G_; c = c_; }
    __device__ bool next(int i, Unit& u) const {
        const long L = (long)i * G + c; if (L >= nwg) return false;
        int wgid = (int)L; { const int q = nwg / NXCD, r = nwg % NXCD, xcd = wgid % NXCD, off = wgid / NXCD; wgid = (xcd < r ? xcd * (q + 1) : r * (q + 1) + (xcd - r) * q) + off; }
        const int nig = WGM * nN, gid = wgid / nig, fm = gid * WGM, gsz = (nM - fm) < WGM ? (nM - fm) : WGM;
        u.pm = fm + ((wgid % nig) % gsz); u.pn = (wgid % nig) / gsz; u.e = 0; return true;
    }
    __device__ __forceinline__ void ptrs(const Unit& u, const char*& a, const char*& b) const {
        a = (const char*)A + (size_t)u.pm * (size_t)(BM * 2) * K; b = (const char*)Bt + (size_t)u.pn * (size_t)(BM * 2) * K; }
    __device__ __forceinline__ void a_ready(const Unit&) const {}
    __device__ __forceinline__ void done(const Unit&) const {}
};
__device__ __forceinline__ void grid_map(int L, int nM, int nN, int& pm, int& pn) {
    const int nwg = nM * nN; int wgid = L; { const int q = nwg / NXCD, r = nwg % NXCD, xcd = wgid % NXCD, off = wgid / NXCD; wgid = (xcd < r ? xcd * (q + 1) : r * (q + 1) + (xcd - r) * q) + off; }
    const int nig = WGM * nN, gid = wgid / nig, fm = gid * WGM, gsz = (nM - fm) < WGM ? (nM - fm) : WGM;
    pm = fm + ((wgid % nig) % gsz); pn = (wgid % nig) / gsz;
}
struct ProjOrder {
    static constexpr bool GATHER = false;
    const bf16_t* XN; const bf16_t* WIN; const bf16_t* MEMN; const bf16_t* WCKV; int G, c;
    static constexpr int N0 = 64 * 13, N1 = 5 * 64, N2 = 4, N3 = 4, NTOT = N0 + N1 + N2 + N3;
    __device__ bool next(int i, Unit& u) const {
        int L = i * G + c; if (L >= NTOT) return false;
        if (L < N0) { u.e = 0; grid_map(L, 64, 13, u.pm, u.pn); return true; } L -= N0;
        if (L < N1) { u.e = 1; grid_map(L, 5, 64, u.pm, u.pn); return true; } L -= N1;
        if (L < N2) { u.e = 2; u.pm = L >> 1; u.pn = L & 1; return true; } L -= N2;
        u.e = 3; u.pm = L >> 1; u.pn = L & 1; return true;
    }
    __device__ __forceinline__ void ptrs(const Unit& u, const char*& a, const char*& b) const {
        const size_t ts = (size_t)(BM * 2) * 2048;
        const bf16_t* A = u.e == 0 ? XN : (u.e == 1 ? WIN + (size_t)NPROJ * 2048 : (u.e == 2 ? MEMN : WCKV + (size_t)512 * 2048));
        const bf16_t* B = u.e == 0 ? WIN : (u.e == 1 ? XN : (u.e == 2 ? WCKV : MEMN));
        a = (const char*)A + (size_t)u.pm * ts; b = (const char*)B + (size_t)u.pn * ts; }
    __device__ __forceinline__ void a_ready(const Unit&) const {}
    __device__ __forceinline__ void done(const Unit&) const {}
};
struct BranchOrder {
    static constexpr bool GATHER = false;
    const bf16_t* YA; const bf16_t* YD; const bf16_t* WB; int G, c;
    __device__ bool next(int i, Unit& u) const {
        const int L = (i >> 1) * G + c; if (L >= 64 * 8) return false;
        u.e = i & 1; grid_map(L, 64, 8, u.pm, u.pn); return true;
    }
    __device__ __forceinline__ void ptrs(const Unit& u, const char*& a, const char*& b) const {
        const size_t ts = (size_t)(BM * 2) * 1024;
        a = (const char*)(u.e ? YD : YA) + (size_t)u.pm * ts; b = (const char*)(WB + (size_t)u.e * 2048 * 1024) + (size_t)u.pn * ts; }
    __device__ __forceinline__ void a_ready(const Unit&) const {}
    __device__ __forceinline__ void done(const Unit&) const {}
};
template <bool GATHER_>
struct MoeOrder {
    static constexpr bool GATHER = GATHER_;
    const void* A; const void* Bt; const PG8_LAS int* tile_e; int ntiles, nN, G, c; size_t a_tstride, b_estride, b_tstride;
    const unsigned short* rowtok;
    __device__ bool next(int i, Unit& u) const {
        if (G == 256) {
            const int x = c >> 5, w = c & 31, mpr = 256 / nN;
            const int m = (nN == 16) ? 4 * (x >> 1) + (w >> 3) : 4 * x + (w >> 3), n = (nN == 16) ? 8 * (x & 1) + (w & 7) : (w & 7);
            u.pm = i * mpr + m; u.pn = n; if (u.pm >= ntiles) return false;
        } else { const long L = (long)i * G + c; if (L >= (long)ntiles * nN) return false; u.pm = (int)(L / nN); u.pn = (int)(L % nN); }
        u.e = __builtin_amdgcn_readfirstlane(tile_e[u.pm]); return true;
    }
    __device__ __forceinline__ void ptrs(const Unit& u, const char*& a, const char*& b) const {
        a = GATHER_ ? (const char*)A : (const char*)A + (size_t)u.pm * a_tstride; b = (const char*)Bt + (size_t)u.e * b_estride + (size_t)u.pn * b_tstride; }
    __device__ __forceinline__ const unsigned short* rows(const Unit& u) const { return rowtok + u.pm * 256; }
    __device__ __forceinline__ void a_ready(const Unit&) const {}
    __device__ __forceinline__ void done(const Unit&) const {}
};

#define EPI_ROWS_BEGIN const int row0 = u.pm * BM + wr * 64 + fr; \
    _Pragma("unroll") for (int ai = 0; ai < 2; ++ai) _Pragma("unroll") for (int m = 0; m < 4; ++m) { const int row = row0 + ai * HALF + m * 16;
#define EPI_ROWS_END }
__device__ __forceinline__ u32x4 pack8(f32x4 v0, f32x4 v1) { u32x4 w; w.x = pk2(v0[0], v0[1]); w.y = pk2(v0[2], v0[3]); w.z = pk2(v1[0], v1[1]); w.w = pk2(v1[2], v1[3]); return w; }
__device__ __forceinline__ void unpack8(u32x4 w, f32x4& v0, f32x4& v1) { v0 = (f32x4){bf_lo(w.x), bf_hi(w.x), bf_lo(w.y), bf_hi(w.y)}; v1 = (f32x4){bf_lo(w.z), bf_hi(w.z), bf_lo(w.w), bf_hi(w.w)}; }
__device__ __forceinline__ float sigm(float x) { return __builtin_amdgcn_rcpf(1.0f + __builtin_amdgcn_exp2f(-LOG2E * x)); }

struct EpiPlain {
    static constexpr bool PERM = true, AFTER_DRAIN = false;
    bf16_t* O; int ldc; float scale;
    __device__ __forceinline__ void operator()(const f32x4 (&acc)[2][2][4][2], const Unit& u, int wr, int wc, int fr, int fq) const {
        const int col0 = u.pn * BM + wc * 32 + 8 * fq;
        EPI_ROWS_BEGIN
            bf16_t* rowp = O + (size_t)row * ldc + col0;
#pragma unroll
            for (int bj = 0; bj < 2; ++bj) *(u32x4*)(rowp + bj * HALF) = pack8(acc[ai][bj][m][0] * scale, acc[ai][bj][m][1] * scale);
        EPI_ROWS_END
    }
};
struct EpiRowScale {
    static constexpr bool PERM = true, AFTER_DRAIN = false;
    bf16_t* O; int ldc; float scale; const unsigned long long* SS;
    __device__ __forceinline__ void operator()(const f32x4 (&acc)[2][2][4][2], const Unit& u, int wr, int wc, int fr, int fq) const {
        const int col0 = u.pn * BM + wc * 32 + 8 * fq;
        EPI_ROWS_BEGIN
            bf16_t* rowp = O + (size_t)row * ldc + col0;
            const float ssq = (float)__hip_atomic_load(SS + row, __ATOMIC_RELAXED, __HIP_MEMORY_SCOPE_AGENT) * (1.0f / 1048576.0f);
            const float s = scale * __builtin_amdgcn_rsqf(ssq * (1.0f / DM) + RMS_EPS);
#pragma unroll
            for (int bj = 0; bj < 2; ++bj) *(u32x4*)(rowp + bj * HALF) = pack8(acc[ai][bj][m][0] * s, acc[ai][bj][m][1] * s);
        EPI_ROWS_END
    }
};
struct EpiProj {
    static constexpr bool PERM = true, AFTER_DRAIN = false;
    bf16_t* O;
    __device__ __forceinline__ void operator()(const f32x4 (&acc)[2][2][4][2], const Unit& u, int wr, int wc, int fr, int fq) const {
        const int col0 = u.pn * BM + wc * 32 + 8 * fq; const int pn = u.pn;
        const int mode = (pn < 4 || (pn >= 5 && pn < 9)) ? 1 : (pn >= 13 ? 2 : 0);
        EPI_ROWS_BEGIN
            bf16_t* rowp = O + (size_t)row * NPROJ + col0;
#pragma unroll
            for (int bj = 0; bj < 2; ++bj) { f32x4 v0 = acc[ai][bj][m][0], v1 = acc[ai][bj][m][1];
                if (mode == 1) { v0 = v0 * C2_64; v1 = v1 * C2_64; }
                else if (mode == 2) {
#pragma unroll
                    for (int i = 0; i < 4; ++i) { v0[i] = sigm(v0[i]); v1[i] = sigm(v1[i]); } }
                *(u32x4*)(rowp + bj * HALF) = pack8(v0, v1); }
        EPI_ROWS_END
    }
};
__device__ __forceinline__ unsigned q4_u8(f32x4 v) { const unsigned a = (unsigned)(v[0] * 255.0f + 0.5f), b = (unsigned)(v[1] * 255.0f + 0.5f), c = (unsigned)(v[2] * 255.0f + 0.5f), d = (unsigned)(v[3] * 255.0f + 0.5f); return a | (b << 8) | (c << 16) | (d << 24); }
__device__ __forceinline__ f32x4 u8_f4(unsigned w) { return (f32x4){(float)(w & 0xffu), (float)((w >> 8) & 0xffu), (float)((w >> 16) & 0xffu), (float)(w >> 24)} * (1.0f / 255.0f); }
__device__ __forceinline__ unsigned pk4_fp8(float a, float b, float c, float d) { int w = 0; w = __builtin_amdgcn_cvt_pk_fp8_f32(a, b, w, false); w = __builtin_amdgcn_cvt_pk_fp8_f32(c, d, w, true); return (unsigned)w; }
struct EpiBranch0 {
    static constexpr bool PERM = true, AFTER_DRAIN = false;
    const unsigned char* G8; bf16_t* O;
    __device__ __forceinline__ void operator()(const f32x4 (&acc)[2][2][4][2], const Unit& u, int wr, int wc, int fr, int fq) const {
        const int col0 = u.pn * BM + wc * 32 + 8 * fq;
        EPI_ROWS_BEGIN
#pragma unroll
            for (int bj = 0; bj < 2; ++bj) { const int col = col0 + bj * HALF;
                const u32x2 gw = *(const u32x2*)(G8 + (size_t)row * 4096 + col); const f32x4 g0 = u8_f4(gw.x), g1 = u8_f4(gw.y);
                *(u32x4*)(O + (size_t)row * DM + col) = pack8(g0 * acc[ai][bj][m][0], g1 * acc[ai][bj][m][1]); }
        EPI_ROWS_END
    }
};
struct EpiBranch1 {
    static constexpr bool PERM = true, AFTER_DRAIN = false;
    const unsigned char* G8; bf16_t* O; unsigned char* O8;
    __device__ __forceinline__ void operator()(const f32x4 (&acc)[2][2][4][2], const Unit& u, int wr, int wc, int fr, int fq) const {
        const int col0 = u.pn * BM + wc * 32 + 8 * fq;
        EPI_ROWS_BEGIN
#pragma unroll
            for (int bj = 0; bj < 2; ++bj) { const int col = col0 + bj * HALF;
                const u32x2 gw = *(const u32x2*)(G8 + (size_t)row * 4096 + DM + col); const f32x4 g0 = u8_f4(gw.x), g1 = u8_f4(gw.y);
                f32x4 t0, t1; unpack8(*(const u32x4*)(O + (size_t)row * DM + col), t0, t1);
                f32x4 y0, y1; y0.lo = (g0.lo * acc[ai][bj][m][0].lo + t0.lo) * 8.0f; y0.hi = (g0.hi * acc[ai][bj][m][0].hi + t0.hi) * 8.0f; y1.lo = (g1.lo * acc[ai][bj][m][1].lo + t1.lo) * 8.0f; y1.hi = (g1.hi * acc[ai][bj][m][1].hi + t1.hi) * 8.0f;
                u32x2 q; q.x = pk4_fp8(y0[0], y0[1], y0[2], y0[3]); q.y = pk4_fp8(y1[0], y1[1], y1[2], y1[3]); *(u32x2*)(O8 + (size_t)row * DM + col) = q; }
        EPI_ROWS_END
    }
};
template <bool BASE_BF16>
struct EpiResid {
    static constexpr bool PERM = true, AFTER_DRAIN = false;
    const void* BASE; bf16_t* OUT; float scale; unsigned long long* SS;
    __device__ __forceinline__ void operator()(const f32x4 (&acc)[2][2][4][2], const Unit& u, int wr, int wc, int fr, int fq) const {
        const int col0 = u.pn * BM + wc * 32 + 8 * fq;
        EPI_ROWS_BEGIN
            f32x2 sq2 = {0.f, 0.f};
#pragma unroll
            for (int bj = 0; bj < 2; ++bj) { const size_t off = (size_t)row * DM + col0 + bj * HALF;
                f32x4 b0, b1;
                if (BASE_BF16) unpack8(*(const u32x4*)((const bf16_t*)BASE + off), b0, b1);
                else { b0 = *(const f32x4*)((const float*)BASE + off); b1 = *(const f32x4*)((const float*)BASE + off + 4); }
                f32x4 y0, y1; y0.lo = acc[ai][bj][m][0].lo * scale + b0.lo; y0.hi = acc[ai][bj][m][0].hi * scale + b0.hi; y1.lo = acc[ai][bj][m][1].lo * scale + b1.lo; y1.hi = acc[ai][bj][m][1].hi * scale + b1.hi;
                if (!BASE_BF16) { sq2 += y0.lo * y0.lo; sq2 += y0.hi * y0.hi; sq2 += y1.lo * y1.lo; sq2 += y1.hi * y1.hi; }
                *(u32x4*)(OUT + off) = pack8(y0, y1); }
            if (!BASE_BF16) { float sq = sq2.x + sq2.y; sq += __shfl_xor(sq, 16); sq += __shfl_xor(sq, 32);
                if (fq == 0) atomicAdd(SS + row, (unsigned long long)(sq * 1048576.0f + 0.5f)); }
        EPI_ROWS_END
    }
};
struct EpiGlu {
    static constexpr bool PERM = true, AFTER_DRAIN = false;
    const float* bgu; unsigned char* ACT;
    __device__ __forceinline__ void operator()(const f32x4 (&acc)[2][2][4][2], const Unit& u, int wr, int wc, int fr, int fq) const {
        const int col = u.pn * HALF + wc * 32 + 8 * fq;
        const float* bg = bgu + (size_t)u.e * (2 * DFF) + col; const float* bl = bg + DFF;
        const f32x4 bg0 = *(const f32x4*)bg, bg1 = *(const f32x4*)(bg + 4), bl0 = *(const f32x4*)bl, bl1 = *(const f32x4*)(bl + 4);
        EPI_ROWS_BEGIN
            f32x4 a[2];
#pragma unroll
            for (int n = 0; n < 2; ++n) {
                const f32x4 G = acc[ai][0][m][n], L = acc[ai][1][m][n], BG = n ? bg1 : bg0, BL = n ? bl1 : bl0;
#pragma unroll
                for (int h = 0; h < 2; ++h) {
                    const f32x2 g = (h ? G.hi : G.lo) * (1.0f / 512.0f) + (h ? BG.hi : BG.lo), l = (h ? L.hi : L.lo) * (1.0f / 512.0f) + (h ? BL.hi : BL.lo);
                    const f32x2 gl = {fminf(g.x, 7.0f), fminf(g.y, 7.0f)}, li = {fminf(fmaxf(l.x, -7.0f), 7.0f), fminf(fmaxf(l.y, -7.0f), 7.0f)};
                    const f32x2 t = gl * (-1.702f * LOG2E);
                    const f32x2 d = (f32x2){__builtin_amdgcn_exp2f(t.x), __builtin_amdgcn_exp2f(t.y)} + 1.0f;
                    const f32x2 r = {__builtin_amdgcn_rcpf(d.x), __builtin_amdgcn_rcpf(d.y)};
                    const f32x2 av = (gl * r) * (li * 4.0f + 4.0f);
                    a[n][2 * h] = av.x; a[n][2 * h + 1] = av.y; } }
            u32x2 w; w.x = pk4_fp8(a[0][0], a[0][1], a[0][2], a[0][3]); w.y = pk4_fp8(a[1][0], a[1][1], a[1][2], a[1][3]);
            *(u32x2*)(ACT + (size_t)row * DFF + col) = w;
        EPI_ROWS_END
    }
};
struct EpiDown {
    static constexpr bool PERM = true, AFTER_DRAIN = false;
    const float* bd; const int* rowslot; const float* roww; unsigned char* OUT;
    __device__ __forceinline__ void operator()(const f32x4 (&acc)[2][2][4][2], const Unit& u, int wr, int wc, int fr, int fq) const {
        const int col0 = u.pn * BM + wc * 32 + 8 * fq;
        const float* bp = bd + (size_t)u.e * DM + col0;
        f32x4 bv[2][2];
#pragma unroll
        for (int bj = 0; bj < 2; ++bj) { bv[bj][0] = *(const f32x4*)(bp + bj * HALF); bv[bj][1] = *(const f32x4*)(bp + bj * HALF + 4); }
        EPI_ROWS_BEGIN
            const int slot = rowslot[row]; const float w = roww[row];
            if (slot >= 0) {
#pragma unroll
                for (int bj = 0; bj < 2; ++bj)
                { const float w32 = 32.0f * w; f32x4 y0, y1;
                    y0.lo = (acc[ai][bj][m][0].lo * (1.0f / 256.0f) + bv[bj][0].lo) * w32; y0.hi = (acc[ai][bj][m][0].hi * (1.0f / 256.0f) + bv[bj][0].hi) * w32;
                    y1.lo = (acc[ai][bj][m][1].lo * (1.0f / 256.0f) + bv[bj][1].lo) * w32; y1.hi = (acc[ai][bj][m][1].hi * (1.0f / 256.0f) + bv[bj][1].hi) * w32;
                    u32x2 q; q.x = pk4_fp8(y0[0], y0[1], y0[2], y0[3]); q.y = pk4_fp8(y1[0], y1[1], y1[2], y1[3]); *(u32x2*)(OUT + (size_t)slot * DM + col0 + bj * HALF) = q; }
            }
        EPI_ROWS_END
    }
};


struct EpiGate {
    static constexpr bool PERM = true, AFTER_DRAIN = false;
    unsigned char* G8;
    __device__ __forceinline__ void operator()(const f32x4 (&acc)[2][2][4][2], const Unit& u, int wr, int wc, int fr, int fq) const {
        const int col0 = u.pn * BM + wc * 32 + 8 * fq;
        EPI_ROWS_BEGIN
            unsigned char* rowp = G8 + (size_t)row * 4096 + col0;
#pragma unroll
            for (int bj = 0; bj < 2; ++bj) { u32x2 w;
#pragma unroll
                for (int n = 0; n < 2; ++n) { const f32x4 A = acc[ai][bj][m][n]; unsigned q[4];
#pragma unroll
                    for (int h = 0; h < 2; ++h) {
                        const f32x2 t = (h ? A.hi : A.lo) * (-LOG2E / 512.0f);
                        const f32x2 d = (f32x2){__builtin_amdgcn_exp2f(t.x), __builtin_amdgcn_exp2f(t.y)} + 1.0f;
                        const f32x2 r = (f32x2){__builtin_amdgcn_rcpf(d.x), __builtin_amdgcn_rcpf(d.y)} * 255.0f + 0.5f;
                        q[2 * h] = (unsigned)r.x; q[2 * h + 1] = (unsigned)r.y; }
                    const unsigned pk = q[0] | (q[1] << 8) | (q[2] << 16) | (q[3] << 24); if (n) w.y = pk; else w.x = pk; }
                *(u32x2*)(rowp + bj * HALF) = w; }
        EPI_ROWS_END
    }
};

struct EpiProjAll {
    static constexpr bool PERM = true, AFTER_DRAIN = false;
    bf16_t* PROJ; bf16_t* VT; bf16_t* KM; bf16_t* VMT;
    __device__ __forceinline__ void operator()(const f32x4 (&acc)[2][2][4][2], const Unit& u, int wr, int wc, int fr, int fq) const {
        if (u.e == 0) { EpiProj E{PROJ}; E(acc, u, wr, wc, fr, fq); }
        else { EpiPlain E{u.e == 1 ? VT : (u.e == 2 ? KM : VMT), u.e == 1 ? T : 512, 1.0f}; E(acc, u, wr, wc, fr, fq); }
    }
};
struct EpiBranchAll {
    static constexpr bool PERM = true, AFTER_DRAIN = false;
    const unsigned char* PROJ; bf16_t* O; unsigned char* O8;
    __device__ __forceinline__ void operator()(const f32x4 (&acc)[2][2][4][2], const Unit& u, int wr, int wc, int fr, int fq) const {
        if (u.e == 0) { EpiBranch0 E{PROJ, O}; E(acc, u, wr, wc, fr, fq); }
        else { asm volatile("s_waitcnt vmcnt(0)" ::: "memory");
               EpiBranch1 E{PROJ, O, O8}; E(acc, u, wr, wc, fr, fq); }
    }
};
template <class Epi, class Sched, bool ALIGN_EPI = false, bool SP2 = false, bool FP8 = false>
__device__ __forceinline__ void gemm_phase(PG8_LAS unsigned char* lds, const Gemm g, const Sched& S, const Epi& E) {
    int tid = threadIdx.x; asm volatile("" : "+v"(tid)); const int wid = __builtin_amdgcn_readfirstlane(tid >> 6), lane = tid & 63, wr = wid >> 2, wc = wid & 3, fr = lane & 15, fq = lane >> 4;
    const int K = g.K, nt = K / BK;
    unsigned voffA[2], voffB[2];
#pragma unroll
    for (int i = 0; i < 2; ++i) { int R, C; stage_rc(tid * 16 + i * 8192, R, C); const int Rb = Epi::PERM ? ((R & ~31) + perm32(R & 31)) : R;
        voffA[i] = (unsigned)(R * K + C) * 2u; voffB[i] = (unsigned)(Rb * K + C) * 2u; }
    u32x2 vgc = {0u, 0u}, vgn = {0u, 0u};
    auto gather_issue = [&](const unsigned short* rp, u32x2& dst) { int t4 = threadIdx.x; asm volatile("" : "+v"(t4)); int R, C; stage_rc(t4 * 16, R, C); const unsigned o = (unsigned)R * 8u;
        asm volatile("s_nop 4\n\tglobal_load_dwordx2 %0, %1, %2" : "=&v"(dst) : "v"(o), "s"(rp) : "memory"); };
#define PG8_GOFF(v, h, i) ((((i) ? ((h) ? (v).y >> 16 : (v).x >> 16) : ((h) ? (v).y & 0xffffu : (v).x & 0xffffu)) * (unsigned)(K * 2)) + (voffB[0] & (unsigned)(K * 2 - 1)))
    const size_t kstep = (size_t)(BK * 2);
    const size_t hstep = Sched::GATHER ? (size_t)0 : (size_t)HALF * K * 2;
    const size_t bhs = g.bhstep;
    const unsigned lds0 = (unsigned)(unsigned long)lds;
    const unsigned ldsw = (unsigned)wid * 1024u;
    const int aoff = lds_byte(wr * 64 + fr, fq * 8), boff = lds_byte(wc * 32 + fr, fq * 8);
#define PG8_SA(b, h) (((b) * 2 + (h)) * HTB)
#define PG8_SB(b, h) ((4 + (b) * 2 + (h)) * HTB)
#define PG8_STAGE(bufoff, gbase, voff) do { _Pragma("unroll") for (int _i = 0; _i < 2; ++_i) \
        glds16_s((const char*)(gbase), (voff)[_i], lds0 + (unsigned)(bufoff) + ldsw + (unsigned)(_i * 8192)); } while (0)
#define PG8_STAGE_A(bufoff, gbase, h, nx) do { if constexpr (Sched::GATHER) { u32x2 vv_ = (nx) ? vgn : vgc; asm volatile("" : "+v"(vv_));        const unsigned vs_[2] = {PG8_GOFF(vv_, h, 0), PG8_GOFF(vv_, h, 1)}; PG8_STAGE(bufoff, gbase, vs_); } else PG8_STAGE(bufoff, gbase, voffA); } while (0)
#define PG8_LDA(dst, b, h) do { _Pragma("unroll") for (int m = 0; m < 4; ++m) _Pragma("unroll") for (int k = 0; k < 2; ++k) dst[m][k] = *(const PG8_LAS bf16x8*)(lds + PG8_SA(b, h) + aoff + m * 2048 + k * 1024); } while (0)
#define PG8_LDB(dst, b, h) do { _Pragma("unroll") for (int n = 0; n < 2; ++n) _Pragma("unroll") for (int k = 0; k < 2; ++k) dst[n][k] = *(const PG8_LAS bf16x8*)(lds + PG8_SB(b, h) + boff + n * 2048 + k * 1024); } while (0)
#define PG8_MMA(ai, bj, At, Bt) do { __builtin_amdgcn_s_setprio(1); _Pragma("unroll") for (int m = 0; m < 4; ++m) _Pragma("unroll") for (int n = 0; n < 2; ++n) { \
        if constexpr (FP8) acc[ai][bj][m][n] = __builtin_amdgcn_mfma_scale_f32_16x16x128_f8f6f4(cat16(Bt[n][0], Bt[n][1]), cat16(At[m][0], At[m][1]), acc[ai][bj][m][n], 0, 0, 0, 0, 0, 0); \
        else { _Pragma("unroll") for (int k = 0; k < 2; ++k) acc[ai][bj][m][n] = __builtin_amdgcn_mfma_f32_16x16x32_bf16(Bt[n][k], At[m][k], acc[ai][bj][m][n], 0, 0, 0); } } __builtin_amdgcn_s_setprio(0); } while (0)
#define PG8_WAIT_V(n) asm volatile("s_waitcnt vmcnt(" #n ")" ::: "memory")
#define PG8_WAIT_L(n) asm volatile("s_waitcnt lgkmcnt(" #n ")" ::: "memory")
#define PG8_BAR __builtin_amdgcn_s_barrier()
#define PG8_SCHED __builtin_amdgcn_sched_barrier(0)
    Unit cur, nxt; int ui = 0;
    if (!S.next(0, cur)) return;
    f32x4 acc[2][2][4][2];
#pragma unroll
    for (int a = 0; a < 2; ++a)
#pragma unroll
        for (int b = 0; b < 2; ++b)
#pragma unroll
            for (int m = 0; m < 4; ++m)
#pragma unroll
                for (int n = 0; n < 2; ++n) acc[a][b][m][n] = (f32x4){0.f, 0.f, 0.f, 0.f};
    bf16x8 At[4][2], B0[2][2], B1[2][2];
    const char* cA; const char* cB; S.ptrs(cur, cA, cB);
    S.a_ready(cur);
    if constexpr (Sched::GATHER) { static_assert(SP2, "gather is written for the SP2 loop"); gather_issue(S.rows(cur), vgc); asm volatile("s_waitcnt vmcnt(0)" : "+v"(vgc) :: "memory"); vgn = vgc; }
    if constexpr (SP2) {
        PG8_STAGE(PG8_SB(0, 0), cB, voffB); PG8_STAGE(PG8_SB(0, 1), cB + bhs, voffB); PG8_STAGE_A(PG8_SA(0, 0), cA, 0, false); PG8_STAGE_A(PG8_SA(0, 1), cA + hstep, 1, false);
        if (wr == 1) PG8_BAR;
        PG8_WAIT_V(2); PG8_BAR;
        PG8_STAGE(PG8_SB(1, 0), cB + kstep, voffB); PG8_STAGE_A(PG8_SA(1, 0), cA + kstep, 0, false); PG8_STAGE(PG8_SB(1, 1), cB + bhs + kstep, voffB);
        PG8_WAIT_V(6); PG8_BAR;
    } else {
        PG8_STAGE(PG8_SB(0, 0), cB, voffB); PG8_STAGE(PG8_SA(0, 0), cA, voffA); PG8_STAGE(PG8_SB(0, 1), cB + bhs, voffB); PG8_STAGE(PG8_SA(0, 1), cA + hstep, voffA);
        if (wr == 1) PG8_BAR;
        PG8_WAIT_V(4); PG8_BAR;
        PG8_STAGE(PG8_SB(1, 0), cB + kstep, voffB); PG8_STAGE(PG8_SA(1, 0), cA + kstep, voffA); PG8_STAGE(PG8_SB(1, 1), cB + bhs + kstep, voffB);
        PG8_WAIT_V(6); PG8_BAR;
    }
    for (;;) {
        const bool has_next = S.next(ui + 1, nxt);
        const char* nA = cA; const char* nB = cB; if (has_next) S.ptrs(nxt, nA, nB);
        if constexpr (Sched::GATHER) { if (has_next) gather_issue(S.rows(nxt), vgn); }
        for (int t = 0; t < nt; t += 2) {
            const bool last = (t == nt - 2);
            const char* a1 = cA + (size_t)(t + 1) * kstep;
            const char* a2 = last ? nA : cA + (size_t)(t + 2) * kstep; const char* b2 = last ? nB : cB + (size_t)(t + 2) * kstep;
            const char* a3 = a2 + kstep; const char* b3 = b2 + kstep;
            if (last && has_next) S.a_ready(nxt);
            if constexpr (SP2) {
            PG8_LDB(B0, 0, 0); PG8_LDB(B1, 0, 1); PG8_SCHED; PG8_LDA(At, 0, 0); PG8_STAGE_A(PG8_SA(1, 1), a1 + hstep, 1, false);
            PG8_WAIT_V(8); PG8_WAIT_L(0); PG8_BAR; PG8_MMA(0, 0, At, B0); PG8_MMA(0, 1, At, B1); PG8_BAR; PG8_SCHED;
            PG8_LDA(At, 0, 1); PG8_STAGE(PG8_SB(0, 0), b2, voffB); PG8_STAGE(PG8_SB(0, 1), b2 + bhs, voffB); PG8_STAGE_A(PG8_SA(0, 0), a2, 0, last);
            PG8_WAIT_V(8); PG8_WAIT_L(0); PG8_BAR;
            PG8_MMA(1, 0, At, B0); PG8_MMA(1, 1, At, B1); PG8_BAR; PG8_SCHED;
            PG8_LDB(B0, 1, 0); PG8_LDB(B1, 1, 1); PG8_SCHED; PG8_LDA(At, 1, 0); PG8_STAGE_A(PG8_SA(0, 1), a2 + hstep, 1, last);
            PG8_WAIT_V(8); PG8_WAIT_L(0); PG8_BAR; PG8_MMA(0, 0, At, B0); PG8_MMA(0, 1, At, B1); PG8_BAR; PG8_SCHED;
            PG8_LDA(At, 1, 1); PG8_STAGE(PG8_SB(1, 0), b3, voffB); PG8_STAGE(PG8_SB(1, 1), b3 + bhs, voffB); PG8_STAGE_A(PG8_SA(1, 0), a3, 0, last);
            PG8_WAIT_V(8); PG8_WAIT_L(0); PG8_BAR; PG8_MMA(1, 0, At, B0); PG8_MMA(1, 1, At, B1); PG8_BAR; PG8_SCHED;
            } else {
            PG8_LDB(B0, 0, 0); PG8_SCHED; PG8_LDA(At, 0, 0); PG8_STAGE(PG8_SA(1, 1), a1 + hstep, voffA);
            PG8_WAIT_L(8); PG8_BAR; PG8_WAIT_L(0); PG8_MMA(0, 0, At, B0); PG8_BAR; PG8_SCHED;
            PG8_LDB(B1, 0, 1); PG8_STAGE(PG8_SB(0, 0), b2, voffB);
            PG8_BAR; PG8_WAIT_L(0); PG8_MMA(0, 1, At, B1); PG8_BAR;
            PG8_LDA(At, 0, 1); PG8_STAGE(PG8_SA(0, 0), a2, voffA);
            PG8_BAR; PG8_WAIT_L(0); PG8_MMA(1, 0, At, B0); PG8_BAR; PG8_SCHED;
            PG8_STAGE(PG8_SB(0, 1), b2 + bhs, voffB);
            PG8_WAIT_V(6); PG8_BAR; PG8_MMA(1, 1, At, B1); PG8_BAR;
            PG8_LDB(B0, 1, 0); PG8_SCHED; PG8_LDA(At, 1, 0); PG8_STAGE(PG8_SA(0, 1), a2 + hstep, voffA);
            PG8_WAIT_L(8); PG8_BAR; PG8_WAIT_L(0); PG8_MMA(0, 0, At, B0); PG8_BAR; PG8_SCHED;
            PG8_LDB(B1, 1, 1); PG8_STAGE(PG8_SB(1, 0), b3, voffB);
            PG8_BAR; PG8_WAIT_L(0); PG8_MMA(0, 1, At, B1); PG8_BAR;
            PG8_LDA(At, 1, 1); PG8_STAGE(PG8_SA(1, 0), a3, voffA);
            PG8_BAR; PG8_WAIT_L(0); PG8_MMA(1, 0, At, B0); PG8_BAR; PG8_SCHED;
            PG8_STAGE(PG8_SB(1, 1), b3 + bhs, voffB);
            PG8_WAIT_V(6); PG8_BAR; PG8_MMA(1, 1, At, B1); PG8_BAR;
            }
        }
        if constexpr (ALIGN_EPI) { if (wr == 0) PG8_BAR; }
        if constexpr (!Epi::AFTER_DRAIN) { int t2 = threadIdx.x; asm volatile("" : "+v"(t2)); const int l2 = t2 & 63, w2 = __builtin_amdgcn_readfirstlane(t2 >> 6); E(acc, cur, w2 >> 2, w2 & 3, l2 & 15, l2 >> 4); S.done(cur); }
        if (!has_next) break;
#pragma unroll
        for (int a = 0; a < 2; ++a)
#pragma unroll
            for (int b = 0; b < 2; ++b)
#pragma unroll
                for (int m = 0; m < 4; ++m)
#pragma unroll
                    for (int n = 0; n < 2; ++n) acc[a][b][m][n] = (f32x4){0.f, 0.f, 0.f, 0.f};
        cur = nxt; cA = nA; cB = nB; ++ui;
        if constexpr (Sched::GATHER) vgc = vgn;
        if constexpr (ALIGN_EPI) { if (wr == 1) PG8_BAR; }
    }
    PG8_WAIT_V(0);
    if constexpr (!ALIGN_EPI) { if (wr == 0) PG8_BAR; }
    PG8_BAR;
    if constexpr (Epi::AFTER_DRAIN) { E.fused(acc, cur, wr, wc, fr, fq, lds, wid, lane); S.done(cur); }
#undef PG8_SA
#undef PG8_SB
#undef PG8_STAGE
#undef PG8_STAGE_A
#undef PG8_GOFF
#undef PG8_LDA
#undef PG8_LDB
#undef PG8_MMA
#undef PG8_WAIT_V
#undef PG8_WAIT_L
#undef PG8_BAR
#undef PG8_SCHED
}
}

#define XB_TMO      128
#define XB_XCNT(j)  (256  + 64 * (j))
#define XB_XSUB(j)  (1280 + 64 * (j))
#define XB_XGEN(j)  (2304 + 64 * (j))
#define XB_TOP      3328
#define XB_TOPGEN   3392
#define XCD_BAR_WORDS 3456
#define XB_SPIN_CAP (1u << 18)
#define LAS __attribute__((address_space(3)))

__device__ __forceinline__ unsigned xb_ld(unsigned* p)              { return __hip_atomic_load(p, __ATOMIC_RELAXED, __HIP_MEMORY_SCOPE_AGENT); }
__device__ __forceinline__ unsigned xb_add(unsigned* p, unsigned v) { return __hip_atomic_fetch_add(p, v, __ATOMIC_RELAXED, __HIP_MEMORY_SCOPE_AGENT); }
__device__ __forceinline__ unsigned xb_xcc_id() { return (unsigned)__builtin_amdgcn_s_getreg((3 << 11) | 20) & 0xFu; }
#define XB_SPIN(cond, bar) do { unsigned _sp = 0; while (cond) { __builtin_amdgcn_s_sleep(1); \
    if ((++_sp & 255u) == 0u) { if (xb_ld(&(bar)[XB_TMO])) break; if (_sp > XB_SPIN_CAP) { atomicAdd(&(bar)[XB_TMO], 1u); break; } } } } while (0)

struct XcdBarrier {
    unsigned* bar; unsigned x;
    volatile LAS unsigned* st;
};

__device__ __forceinline__ XcdBarrier xcd_barrier_post(unsigned* bar, volatile LAS unsigned* st) {
    XcdBarrier b; b.bar = bar; b.x = xb_xcc_id(); b.st = st;
    if (threadIdx.x == 0) (void)xb_add(&bar[XB_XCNT(b.x)], 1u);
    return b;
}
__device__ __forceinline__ void xcd_barrier_complete(unsigned* bar, unsigned x, unsigned& nloc, unsigned& nx) {
    const unsigned G = gridDim.x * gridDim.y * gridDim.z;
    unsigned sum, cnt, mine, sp = 0u;
    for (;;) {
        sum = 0u; cnt = 0u; mine = 0u;
#pragma unroll
        for (unsigned j = 0; j < 16; ++j) { const unsigned c = xb_ld(&bar[XB_XCNT(j)]); sum += c; cnt += (c > 0u) ? 1u : 0u; mine = (j == x) ? c : mine; }
        if (sum == G) break;
        __builtin_amdgcn_s_sleep(1);
        if ((++sp & 255u) == 0u) { if (xb_ld(&bar[XB_TMO])) break; if (sp > XB_SPIN_CAP) { atomicAdd(&bar[XB_TMO], 1u); break; } }
    }
    nloc = mine > 0u ? mine : 1u; nx = cnt > 0u ? cnt : 1u;
}

__device__ __forceinline__ void xcd_barrier(const XcdBarrier& b) {
    asm volatile("s_waitcnt vmcnt(0)" ::: "memory");
    __syncthreads();
    if (threadIdx.x == 0) {
        unsigned* bar = b.bar;
        __builtin_amdgcn_s_waitcnt(0);
        unsigned nloc = b.st[0], nx = b.st[1];
        if (nloc == 0u) { xcd_barrier_complete(bar, b.x, nloc, nx); b.st[0] = nloc; b.st[1] = nx; }
        const unsigned old = xb_add(&bar[XB_XSUB(b.x)], 1u);
        const unsigned gen = old / nloc;
        if (old + 1u == (gen + 1u) * nloc) {
            __builtin_amdgcn_fence(__ATOMIC_RELEASE, "agent");
            asm volatile("s_waitcnt vmcnt(0)" ::: "memory");
            const unsigned og = xb_add(&bar[XB_TOP], 1u);
            const unsigned tg = og / nx;
            if (og + 1u == (tg + 1u) * nx) xb_add(&bar[XB_TOPGEN], 1u);
            else XB_SPIN(xb_ld(&bar[XB_TOPGEN]) == tg, bar);
            __builtin_amdgcn_fence(__ATOMIC_ACQUIRE, "agent");
            xb_add(&bar[XB_XGEN(b.x)], 1u);
            asm volatile("s_waitcnt vmcnt(0)" ::: "memory");
        } else {
            XB_SPIN(xb_ld(&bar[XB_XGEN(b.x)]) == gen, bar);
            __builtin_amdgcn_fence(__ATOMIC_ACQUIRE, "agent");
            asm volatile("s_waitcnt vmcnt(0)" ::: "memory");
        }
    }
    __syncthreads();
}


struct Frame {
    LAS unsigned char* lds;
    unsigned* ctl;
    int wave, vcu, G;
    const float* in[25];
    float* out;
    unsigned char* ws;
};
#define WSP(type, off) ((type*)(F.ws + (off)))

__device__ __forceinline__ int win_dst_row(int n0) {
    if (n0 < 1280) return n0;
    if (n0 < 1536) return NPROJ + (n0 - 1280);
    if (n0 < 2560) return PC_QD + (n0 - 1536);
    if (n0 < 3584) return PC_KD + (n0 - 2560);
    if (n0 < 4608) return NPROJ + 256 + (n0 - 3584);
    return PC_G + (n0 - 4608);
}
__device__ __forceinline__ void rms_row_bf16(const float* xrow, const float* gain, bf16_t* orow, int lane, unsigned char* o8 = nullptr) {
    f32x4 v[8]; float s = 0.f;
#pragma unroll
    for (int j = 0; j < 8; ++j) { v[j] = ((const f32x4*)xrow)[lane + 64 * j]; s += (v[j][0] * v[j][0] + v[j][1] * v[j][1]) + (v[j][2] * v[j][2] + v[j][3] * v[j][3]); }
    const float rstd = 1.0f / sqrtf(wave_sum(s) * (1.0f / DM) + RMS_EPS);
#pragma unroll
    for (int j = 0; j < 8; ++j) { const f32x4 g = ((const f32x4*)gain)[lane + 64 * j]; const f32x4 o = v[j] * rstd * g;
        u32x2 w; w.x = pk2(o[0], o[1]); w.y = pk2(o[2], o[3]); ((u32x2*)orow)[lane + 64 * j] = w;
        if (o8) ((unsigned*)o8)[lane + 64 * j] = pg8::pk4_fp8(o[0] * 8.0f, o[1] * 8.0f, o[2] * 8.0f, o[3] * 8.0f); }
}
__device__ __forceinline__ void rows_rms_phase(Frame& F, const float* X, const float* gain, bf16_t* O, int nrows, unsigned char* O8 = nullptr) {
    int lane = threadIdx.x; asm volatile("" : "+v"(lane)); lane &= 63;
    const int gw = F.vcu * NWAVES + F.wave, NGW = F.G * NWAVES;
    for (int r = gw; r < nrows; r += NGW) rms_row_bf16(X + (size_t)r * DM, gain, O + (size_t)r * DM, lane, O8 ? O8 + (size_t)r * DM : nullptr);
}

__device__ __forceinline__ void rows_rstd_phase(Frame& F, const bf16_t* X, float* RS, unsigned* rsc, int nrows) {
    int lane = threadIdx.x; asm volatile("" : "+v"(lane)); lane &= 63;
    const int gw = F.vcu * NWAVES + F.wave, NGW = F.G * NWAVES;
    for (int r = gw; r < nrows; r += 2 * NGW) {
        const int r1 = r + NGW; const bool two = r1 < nrows;
        u32x4 w[2][4];
#pragma unroll
        for (int j = 0; j < 4; ++j) { w[0][j] = ((const u32x4*)(X + (size_t)r * DM))[lane + 64 * j]; w[1][j] = ((const u32x4*)(X + (size_t)(two ? r1 : r) * DM))[lane + 64 * j]; }
#pragma unroll
        for (int q = 0; q < 2; ++q) { float s = 0.f;
#pragma unroll
            for (int j = 0; j < 4; ++j) { f32x4 v0, v1; pg8::unpack8(w[q][j], v0, v1);
                s += ((v0[0] * v0[0] + v0[1] * v0[1]) + (v0[2] * v0[2] + v0[3] * v0[3])) + ((v1[0] * v1[0] + v1[1] * v1[1]) + (v1[2] * v1[2] + v1[3] * v1[3])); }
            s = wave_sum(s);
            if (lane == 0 && (q == 0 || two)) __hip_atomic_store((unsigned*)RS + (q ? r1 : r), __builtin_bit_cast(unsigned, 1.0f / sqrtf(s * (1.0f / DM) + RMS_EPS)), __ATOMIC_RELAXED, __HIP_MEMORY_SCOPE_AGENT); }
    }
    asm volatile("s_waitcnt vmcnt(0)" ::: "memory");
    if (lane == 0) for (int r = gw; r < nrows; r += NGW) __hip_atomic_fetch_add(rsc + 32 * (r >> 8), 1u, __ATOMIC_RELAXED, __HIP_MEMORY_SCOPE_AGENT);
}

struct TrItem { const float* src; int N; unsigned char* dst; int dpitch; int fp8; const float* gain; };
__device__ __forceinline__ bool tr_decode(Frame& F, int it, TrItem& d) {
    constexpr int I_IN = 32 * 136, I_B = 16 * 32, I_O = 32 * 32, I_CQ = 32 * 8, I_CKV = 32 * 16, I_CO = 8 * 32, I_GU1 = 32 * 64, I_D1 = 32 * 32;
    constexpr int NITEMS = I_IN + 2 * I_B + I_O + I_CQ + I_CKV + I_CO + NE * I_GU1 + NE * I_D1;
    if (it >= NITEMS) return false;
    int r = it; const float* W; int K, N, kb, nb, drow; unsigned char* D; int esz = 2; d.fp8 = 0; d.gain = nullptr;
    if (r < NE * I_GU1) { const int e = r / I_GU1, q = r % I_GU1; kb = q / 128; nb = q % 128; W = F.in[20] + (size_t)e * DM * 2 * DFF; K = DM; N = 2 * DFF; D = WSP(unsigned char, WS_WGU) + (size_t)e * 2 * DFF * DM; drow = 32 * nb; esz = 1; d.fp8 = 1; }
    else if ((r -= NE * I_GU1) < NE * I_D1) { const int e = r / I_D1, q = r % I_D1; kb = q / 64; nb = q % 64; W = F.in[22] + (size_t)e * DFF * DM; K = DFF; N = DM; D = WSP(unsigned char, WS_WD) + (size_t)e * DM * DFF; drow = 32 * nb; esz = 1; d.fp8 = 1; }
    else if ((r -= NE * I_D1) < 32 * 72) { kb = r / 72; nb = r % 72; W = F.in[3]; K = DM; N = 8704; D = WSP(unsigned char, WS_WIN); drow = win_dst_row(64 * nb); }
    else if ((r -= 32 * 72) < 16 * 128) { kb = r / 128; nb = r % 128; d.fp8 = 1; d.src = F.in[3] + (size_t)(128 * kb) * 8704 + 4608 + 32 * nb; d.N = 8704; d.dpitch = DM; d.dst = WSP(unsigned char, WS_WING8) + (size_t)(32 * nb) * DM + 128 * kb; return true; }
    else if ((r -= 16 * 128) < 2 * I_B) { const int n = r / I_B, q = r % I_B; kb = q / 32; nb = q % 32; W = F.in[10] + (size_t)n * 1024 * DM; K = 1024; N = DM; D = WSP(unsigned char, WS_WB) + (size_t)n * DM * 1024 * 2; drow = 64 * nb; }
    else if ((r -= 2 * I_B) < I_O) { kb = r / 64; nb = r % 64; W = F.in[11]; K = DM; N = DM; D = WSP(unsigned char, WS_WO); drow = 32 * nb; esz = 1; d.fp8 = 1; }
    else if ((r -= I_O) < I_CQ) { kb = r / 8; nb = r % 8; W = F.in[14]; K = DM; N = 512; D = WSP(unsigned char, WS_WCQ); drow = 64 * nb; d.gain = F.in[12] + 64 * kb; }
    else if ((r -= I_CQ) < I_CKV) { kb = r / 16; nb = r % 16; W = F.in[15]; K = DM; N = 1024; D = WSP(unsigned char, WS_WCKV); drow = 64 * nb; }
    else { r -= I_CKV; kb = r / 32; nb = r % 32; W = F.in[16]; K = 512; N = DM; D = WSP(unsigned char, WS_WCO); drow = 64 * nb; }
    if (d.fp8) { d.src = W + (size_t)(128 * kb) * N + 32 * nb; d.N = N; d.dpitch = K; d.dst = D + (size_t)drow * K + (size_t)(128 * kb); return true; }
    d.src = W + (size_t)(64 * kb) * N + 64 * nb; d.N = N; d.dpitch = K * esz; d.dst = D + (size_t)drow * d.dpitch + (size_t)(64 * kb) * esz;
    return true;
}
constexpr int NMOE_ITEMS = NE * (32 * 64 + 32 * 32);
constexpr int NALL_ITEMS = NMOE_ITEMS + 32 * 136 + 2 * 16 * 32 + 32 * 32 + 32 * 8 + 32 * 16 + 8 * 32;
__device__ __forceinline__ void conv_items(Frame& F, int lane, int it0, int step, int end) {
    LAS float* scr = (LAS float*)(F.lds + F.wave * 16896);
    TrItem cur, nxt; int it = it0;
    bool have = it < end && tr_decode(F, it, cur);
    f32x4 v[16];
#define TR_LOAD(D_) do { if ((D_).fp8) { _Pragma("unroll") for (int i = 0; i < 16; ++i) v[i] = *(const f32x4*)((D_).src + (size_t)((lane >> 3) + 8 * i) * (D_).N + 4 * (lane & 7)); } \
        else { _Pragma("unroll") for (int i = 0; i < 16; ++i) v[i] = *(const f32x4*)((D_).src + (size_t)((lane >> 4) + 4 * i) * (D_).N + 4 * (lane & 15)); } } while (0)
    if (have) TR_LOAD(cur);
    while (have) {
        if (cur.fp8) {
#pragma unroll
            for (int i = 0; i < 16; ++i) { LAS float* s = scr + ((lane >> 3) + 8 * i) * 33 + 4 * (lane & 7); s[0] = v[i][0] * 64.0f; s[1] = v[i][1] * 64.0f; s[2] = v[i][2] * 64.0f; s[3] = v[i][3] * 64.0f; }
        } else {
#pragma unroll
            for (int i = 0; i < 16; ++i) { const float sc = cur.gain ? cur.gain[(lane >> 4) + 4 * i] : 1.0f; LAS float* s = scr + ((lane >> 4) + 4 * i) * 65 + 4 * (lane & 15); s[0] = v[i][0] * sc; s[1] = v[i][1] * sc; s[2] = v[i][2] * sc; s[3] = v[i][3] * sc; }
        }
        it += step;
        const bool hn = it < end && tr_decode(F, it, nxt);
        if (hn) TR_LOAD(nxt);
        LDS_WAIT(); asm volatile("" ::: "memory");
        const int kc = lane >> 3;
        if (cur.fp8) {
#pragma unroll
            for (int j = 0; j < 4; ++j) { const int n = lane & 31, k16 = 2 * j + (lane >> 5); const LAS float* s = scr + (16 * k16) * 33 + n;
                u32x4 o; o.x = pg8::pk4_fp8(s[0], s[33], s[66], s[99]); o.y = pg8::pk4_fp8(s[132], s[165], s[198], s[231]);
                o.z = pg8::pk4_fp8(s[264], s[297], s[330], s[363]); o.w = pg8::pk4_fp8(s[396], s[429], s[462], s[495]);
                *(u32x4*)(cur.dst + (size_t)n * cur.dpitch + 16 * k16) = o; }
        } else {
#pragma unroll
            for (int j = 0; j < 8; ++j) { const int n = (lane & 7) + 8 * j; const LAS float* s = scr + (8 * kc) * 65 + n;
                u32x4 o; o.x = pk2(s[0], s[65]); o.y = pk2(s[130], s[195]); o.z = pk2(s[260], s[325]); o.w = pk2(s[390], s[455]);
                *(u32x4*)(cur.dst + (size_t)n * cur.dpitch + 16 * kc) = o; }
        }
        LDS_WAIT(); asm volatile("" ::: "memory");
        cur = nxt; have = hn;
    }
#undef TR_LOAD
}
template <int BLK>
__device__ __forceinline__ void conv_filler(Frame& F, int phase) {
    int tid = threadIdx.x; asm volatile("" : "+v"(tid)); const int lane = tid & 63;
    volatile LAS unsigned* fl = (volatile LAS unsigned*)(F.lds + LDS_MISC_OFF) + 16;
    asm volatile("s_waitcnt vmcnt(0)" ::: "memory");
    __syncthreads();
    unsigned nbase = (unsigned)NMOE_ITEMS, arrived = 0u;
    if (tid == 0) { if (phase >= 0) arrived = __hip_atomic_fetch_add(F.ctl + CW_DONE + 64 * phase, 1u, __ATOMIC_RELAXED, __HIP_MEMORY_SCOPE_AGENT) + 1u;
                    if (phase < 0 || arrived < (unsigned)F.G) nbase = __hip_atomic_fetch_add(F.ctl + CW_CONV, (unsigned)(NWAVES * BLK), __ATOMIC_RELAXED, __HIP_MEMORY_SCOPE_AGENT); }
    for (;;) {
        if (tid == 0) fl[0] = nbase;
        __syncthreads();
        const unsigned base = fl[0];
        __syncthreads();
        if (base >= (unsigned)NMOE_ITEMS) break;
        if (tid == 0) {
            if (phase >= 0 && arrived >= (unsigned)F.G) nbase = (unsigned)NMOE_ITEMS;
            else { nbase = __hip_atomic_fetch_add(F.ctl + CW_CONV, (unsigned)(NWAVES * BLK), __ATOMIC_RELAXED, __HIP_MEMORY_SCOPE_AGENT);
                   if (phase >= 0) arrived = __hip_atomic_load(F.ctl + CW_DONE + 64 * phase, __ATOMIC_RELAXED, __HIP_MEMORY_SCOPE_AGENT); } }
        const int b0 = (int)base + F.wave * BLK, b1 = b0 + BLK;
        conv_items(F, lane, b0, 1, b1 < NMOE_ITEMS ? b1 : NMOE_ITEMS);
    }
}
__device__ __forceinline__ void p0_prologue(Frame& F) {
    int tid = threadIdx.x; asm volatile("" : "+v"(tid)); const int lane = tid & 63;
    const int gw = F.vcu * NWAVES + F.wave, NGW = F.G * NWAVES;
    conv_items(F, lane, NMOE_ITEMS + gw, NGW, NALL_ITEMS);
    rows_rms_phase(F, F.in[0], F.in[2], WSP(bf16_t, WS_XN), T, WSP(unsigned char, WS_XN8));
    rows_rms_phase(F, F.in[1], F.in[13], WSP(bf16_t, WS_MEMN), BATCH * 256);
    int* rs = WSP(int, WS_ROWSLOT);
    for (int i = blockIdx.x * NTHR + tid; i < XROWS; i += F.G * NTHR) rs[i] = -1;
    { unsigned* rt = WSP(unsigned, WS_ROWTOK); for (int i = blockIdx.x * NTHR + tid; i < XROWS / 2; i += F.G * NTHR) rt[i] = 0u; }
    { bf16_t* WRT = WSP(bf16_t, WS_WRT); const float* Wr = F.in[18]; const float* gffn = F.in[17];
      for (int i = blockIdx.x * NTHR + tid; i < NE * DM; i += F.G * NTHR) { const int e = i >> 11, k = i & (DM - 1);
          const float w = Wr[(size_t)k * NE + e] * gffn[k]; const unsigned h0 = f2bf(w); const float r1 = w - __builtin_bit_cast(float, h0 << 16);
          const unsigned h1 = f2bf(r1); const float r2 = r1 - __builtin_bit_cast(float, h1 << 16); const unsigned h2 = f2bf(r2);
          const int c = k >> 9, wv = (k >> 6) & 7, kk = (k >> 4) & 3, hi_ = (k >> 3) & 1, j = k & 7;
          const size_t d = ((size_t)((wv * 16 + 4 * c + kk) * 3) * 64 + 32 * hi_ + e) * 8 + j;
          WRT[d] = (bf16_t)h0; WRT[d + 512] = (bf16_t)h1; WRT[d + 1024] = (bf16_t)h2; } }
}

__device__ __forceinline__ void route_r1(Frame& F) {
    const bf16_t* H2 = WSP(bf16_t, WS_H); const float* gffn = F.in[17]; const float* br = F.in[19]; const u32x4* WRTF = WSP(u32x4, WS_WRT);
    unsigned char* XN3 = WSP(unsigned char, WS_XN); int* TOPI = WSP(int, WS_TOPI); float* TOPW = WSP(float, WS_TOPW);
    LAS unsigned char* Xb = F.lds;
    LAS float* Lp = (LAS float*)(F.lds + 67584);
    LAS float* rsq = (LAS float*)(F.lds + 100352);
    LAS float* rstd_s = (LAS float*)(F.lds + 100864);
    LAS float* Lg = (LAS float*)(F.lds + 100992);
    LAS int* hist = (LAS int*)(F.lds + 105216);
    int tid = threadIdx.x; asm volatile("" : "+v"(tid)); const int lane = tid & 63;
    const int wave = F.wave, ql = lane & 31, hi = lane >> 5;
    u32x4 pf0[4], pf1[4];
#define R1_LOAD(P_, TASK_, CH_) do { _Pragma("unroll") for (int i = 0; i < 4; ++i) { const int f = tid + 512 * i, row = f >> 6, c8 = f & 63; \
        P_[i] = *(const u32x4*)(H2 + (size_t)((TASK_) * 32 + row) * DM + (CH_) * 512 + 8 * c8); } } while (0)
#define R1_CHUNK(P_, CH_) do { \
            LAS unsigned char* xb = Xb + ((CH_) & 1) * 33280; \
            bf16x8 bfr[4][3];                                     \
            _Pragma("unroll") for (int kk = 0; kk < 4; ++kk) _Pragma("unroll") for (int tm = 0; tm < 3; ++tm) bfr[kk][tm] = __builtin_bit_cast(bf16x8, WRTF[(size_t)((wave * 16 + 4 * (CH_) + kk) * 3 + tm) * 64 + lane]); \
            _Pragma("unroll") for (int i = 0; i < 4; ++i) { const int f = tid + 512 * i, row = f >> 6, c8 = f & 63; \
                f32x4 v0, v1; pg8::unpack8(P_[i], v0, v1); \
                sq[i] += ((v0[0] * v0[0] + v0[1] * v0[1]) + (v0[2] * v0[2] + v0[3] * v0[3])) + ((v1[0] * v1[0] + v1[1] * v1[1]) + (v1[2] * v1[2] + v1[3] * v1[3])); \
                *(LAS u32x4*)(xb + row * 1040 + 16 * c8) = P_[i]; } \
            if ((CH_) < 2) R1_LOAD(P_, task, (CH_) + 2); else if (task + F.G < T / 32) R1_LOAD(P_, task + F.G, (CH_) - 2); \
            __syncthreads();                                      \
            _Pragma("unroll") for (int kk = 0; kk < 4; ++kk) { const bf16x8 a = *(const LAS bf16x8*)(xb + ql * 1040 + (64 * wave + 16 * kk + 8 * hi) * 2); \
                _Pragma("unroll") for (int tm = 0; tm < 3; ++tm) acc = __builtin_amdgcn_mfma_f32_32x32x16_bf16(a, bfr[kk][tm], acc, 0, 0, 0); } } while (0)
    if (F.vcu < T / 32) { R1_LOAD(pf0, F.vcu, 0); R1_LOAD(pf1, F.vcu, 1); }
    for (int task = F.vcu; task < T / 32; task += F.G) {
        const int r0 = task * 32;
        f32x16 acc = {};
        float sq[4];
#pragma unroll
        for (int i = 0; i < 4; ++i) sq[i] = 0.f;
        if (tid < 32) hist[tid] = 0;
#pragma unroll 1
        for (int cp = 0; cp < 4; cp += 2) { R1_CHUNK(pf0, cp); R1_CHUNK(pf1, cp + 1); }
#pragma unroll
        for (int i = 0; i < 4; ++i) { const float s = wave_sum(sq[i]); if (lane == 0) rsq[(wave + 8 * i) * 4] = s; }
#pragma unroll
        for (int r = 0; r < 16; ++r) Lp[wave * 1024 + ((r & 3) + 8 * (r >> 2) + 4 * hi) * 32 + ql] = acc[r];
        __syncthreads();
#pragma unroll
        for (int i = 0; i < 2; ++i) { const int o = tid + 512 * i, tok = o >> 5, e = o & 31; float s = 0.f;
#pragma unroll
            for (int w = 0; w < 8; ++w) s += Lp[w * 1024 + o];
            const float rstd = 1.0f / sqrtf(rsq[tok * 4] * (1.0f / DM) + RMS_EPS);
            if (e == 0) rstd_s[tok] = rstd;
            Lg[tok * 33 + e] = s * rstd + br[e]; }
        __syncthreads();
        { const int tl = lane >> 4, j = lane & 15, tok = 4 * wave + tl; float v0 = Lg[tok * 33 + j], v1 = Lg[tok * 33 + j + 16]; int idx[4]; float val[4];
#pragma unroll
          for (int k = 0; k < 4; ++k) { float bv = v0 >= v1 ? v0 : v1; int bi = v0 >= v1 ? j : j + 16;
#pragma unroll
              for (int m = 1; m < 16; m <<= 1) { const float ov = __shfl_xor(bv, m); const int oi = __shfl_xor(bi, m); const bool take = ov > bv || (ov == bv && oi < bi); bv = take ? ov : bv; bi = take ? oi : bi; }
              idx[k] = bi; val[k] = bv; if (bi == j) v0 = -INFINITY; if (bi == j + 16) v1 = -INFINITY; }
          if (j == 0) { float ex[4], sum = 0.f;
#pragma unroll
              for (int k = 0; k < 4; ++k) { ex[k] = __expf(val[k] - val[0]); sum += ex[k]; }
              const float inv = 1.0f / sum; const int t = r0 + tok;
              *(int __attribute__((ext_vector_type(4)))*)(TOPI + t * 4) = (int __attribute__((ext_vector_type(4)))){idx[0], idx[1], idx[2], idx[3]};
              *(f32x4*)(TOPW + t * 4) = (f32x4){ex[0] * inv, ex[1] * inv, ex[2] * inv, ex[3] * inv};
#pragma unroll
              for (int k = 0; k < 4; ++k) atomicAdd((int*)&hist[idx[k]], 1); } }
#pragma unroll
        for (int rr = 0; rr < 4; ++rr) { const int row = 4 * wave + rr; const float rstd = rstd_s[row];
            const bf16_t* xr = H2 + (size_t)(r0 + row) * DM; unsigned char* orow = XN3 + (size_t)(r0 + row) * DM; const float r8 = rstd * 8.0f;
#pragma unroll
            for (int j = 0; j < 4; ++j) { f32x4 v0, v1; pg8::unpack8(((const u32x4*)xr)[lane + 64 * j], v0, v1);
                const f32x4 o0 = v0 * r8 * ((const f32x4*)gffn)[2 * (lane + 64 * j)], o1 = v1 * r8 * ((const f32x4*)gffn)[2 * (lane + 64 * j) + 1];
                u32x2 w; w.x = pg8::pk4_fp8(o0[0], o0[1], o0[2], o0[3]); w.y = pg8::pk4_fp8(o1[0], o1[1], o1[2], o1[3]); ((u32x2*)orow)[lane + 64 * j] = w; } }
        __syncthreads();
        if (tid < 32) { const int h = hist[tid]; if (h) atomicAdd(F.ctl + CW_CNT + tid, (unsigned)h); }
    }
}
__device__ __forceinline__ void route_r2(Frame& F) {
    const int* TOPI = WSP(int, WS_TOPI); const float* TOPW = WSP(float, WS_TOPW);
    int* ROWSLOT = WSP(int, WS_ROWSLOT); float* ROWW = WSP(float, WS_ROWW); unsigned short* ROWTOK = WSP(unsigned short, WS_ROWTOK);
    LAS int* pst = (LAS int*)F.lds; LAS int* lcnt = pst + 32; LAS int* lbase = pst + 64; LAS int* tmpc = pst + 96;
    int tid = threadIdx.x; asm volatile("" : "+v"(tid));
    if (tid < 32) { const unsigned c = __hip_atomic_load(F.ctl + CW_CNT + tid, __ATOMIC_RELAXED, __HIP_MEMORY_SCOPE_AGENT); tmpc[tid] = (int)((c + 255u) & ~255u); }
    __syncthreads();
    if (tid == 0) { int a = 0; for (int e = 0; e < 32; ++e) { pst[e] = a; a += tmpc[e]; } }
    __syncthreads();
    for (int task = F.vcu; task < T / 64; task += F.G) {
        if (tid < 32) lcnt[tid] = 0;
        __syncthreads();
        int e = 0, rank = 0, t = 0, k = 0; float w = 0.f;
        if (tid < 256) { t = 64 * task + (tid >> 2); k = tid & 3; e = TOPI[t * 4 + k]; w = TOPW[t * 4 + k]; rank = atomicAdd((int*)&lcnt[e], 1); }
        __syncthreads();
        if (tid < 32) { const int n = lcnt[tid]; lbase[tid] = n ? (int)atomicAdd(F.ctl + CW_CUR + tid, (unsigned)n) : 0; }
        __syncthreads();
        if (tid < 256) { const int p = pst[e] + lbase[e] + rank; ROWSLOT[p] = t * 4 + k; ROWW[p] = w; ROWTOK[((p >> 8) * 64 + (p & 63)) * 4 + ((p >> 6) & 3)] = (unsigned short)t; }
        __syncthreads();
    }
}
__device__ __forceinline__ int moe_tile_table(Frame& F) {
    LAS int* tab = (LAS int*)(F.lds + LDS_TAB_OFF); LAS int* pt = tab + 304;
    int tid = threadIdx.x; asm volatile("" : "+v"(tid));
    __syncthreads();
    if (tid < 32) { const unsigned c = __hip_atomic_load(F.ctl + CW_CNT + tid, __ATOMIC_RELAXED, __HIP_MEMORY_SCOPE_AGENT); pt[40 + tid] = (int)((c + 255u) >> 8); }
    __syncthreads();
    if (tid == 0) { int a = 0; for (int e = 0; e < 32; ++e) { pt[e] = a; a += pt[40 + e]; } pt[32] = a; tab[300] = a; }
    __syncthreads();
    const int total = tab[300];
    for (int j = tid; j < total; j += NTHR) { int e = 0; for (int x = 0; x < 32; ++x) if (pt[x + 1] <= j) e = x + 1; tab[j] = e; }
    __syncthreads();
    return total;
}
__device__ __forceinline__ void final_phase(Frame& F) {
    const bf16_t* H2 = WSP(bf16_t, WS_H); const unsigned char* MO = WSP(unsigned char, WS_MOEOUT); const float* gain = F.in[24];
    int lane = threadIdx.x; asm volatile("" : "+v"(lane)); lane &= 63;
    const int gw = F.vcu * NWAVES + F.wave, NGW = F.G * NWAVES;
    for (int r = gw; r < T; r += NGW) {
        f32x4 v[8];
#pragma unroll
        for (int j = 0; j < 8; ++j) { const u32x2 w = ((const u32x2*)(H2 + (size_t)r * DM))[lane + 64 * j]; v[j] = (f32x4){bf_lo(w.x), bf_hi(w.x), bf_lo(w.y), bf_hi(w.y)}; }
#pragma unroll
        for (int k = 0; k < 4; ++k) { const unsigned* mr = (const unsigned*)(MO + (size_t)(4 * r + k) * DM);
#pragma unroll
            for (int j = 0; j < 8; ++j) { const unsigned w = mr[lane + 64 * j]; const f32x2 lo = __builtin_amdgcn_cvt_pk_f32_fp8((int)w, false), hi = __builtin_amdgcn_cvt_pk_f32_fp8((int)w, true);
                v[j][0] += lo[0] * (1.0f / 32.0f); v[j][1] += lo[1] * (1.0f / 32.0f); v[j][2] += hi[0] * (1.0f / 32.0f); v[j][3] += hi[1] * (1.0f / 32.0f); } }
        float s = 0.f;
#pragma unroll
        for (int j = 0; j < 8; ++j) s += (v[j][0] * v[j][0] + v[j][1] * v[j][1]) + (v[j][2] * v[j][2] + v[j][3] * v[j][3]);
        const float rstd = 1.0f / sqrtf(wave_sum(s) * (1.0f / DM) + RMS_EPS);
#pragma unroll
        for (int j = 0; j < 8; ++j) { const f32x4 g = ((const f32x4*)gain)[lane + 64 * j]; ((f32x4*)(F.out + (size_t)r * DM))[lane + 64 * j] = v[j] * rstd * g; }
    }
}

namespace att {
constexpr int VP = 72;
__device__ __forceinline__ int pi32(int m) { return (m & ~12) | ((m & 4) << 1) | ((m & 8) >> 1); }
__device__ __forceinline__ float pmax(float v) { auto rr = __builtin_amdgcn_permlane32_swap(__float_as_uint(v), __float_as_uint(v), false, false); return fmaxf(__uint_as_float(rr[0]), __uint_as_float(rr[1])); }
__device__ __forceinline__ float max3f(float a, float b, float c) { float r; asm("v_max3_f32 %0, %1, %2, %3" : "=v"(r) : "v"(a), "v"(b), "v"(c)); return r; }
__device__ __forceinline__ float psum(float v) { auto rr = __builtin_amdgcn_permlane32_swap(__float_as_uint(v), __float_as_uint(v), false, false); return __uint_as_float(rr[0]) + __uint_as_float(rr[1]); }

template <int DQK, int DV, int MASK>
__device__ __forceinline__ void tile_compute(const LAS bf16_t* Ks, const LAS bf16_t* Vs, const bf16x8 (&qf)[DQK / 16], f32x16 (&cin)[2], f32x16 (&o)[DV / 32], float& l, float& mtot,
                                             bool first, bool domask, int qpos, int kbase, int lane) {
    constexpr int KP = DQK + 8, NDS = DQK / 16, NDB = DV / 32;
    const int ql = lane & 31, hi = lane >> 5;
    f32x16 p[2];
#pragma unroll
    for (int j = 0; j < 2; ++j) { const LAS bf16_t* kr = Ks + (32 * j + pi32(ql)) * KP + 8 * hi;
#pragma unroll
        for (int ds = 0; ds < NDS; ++ds) { const bf16x8 kf = *(const LAS bf16x8*)(kr + 16 * ds);
            p[j] = __builtin_amdgcn_mfma_f32_32x32x16_bf16(kf, qf[ds], ds == 0 ? cin[j] : p[j], 0, 0, 0); } }
    if (MASK != 0 && domask) {
#pragma unroll
        for (int j = 0; j < 2; ++j)
#pragma unroll
            for (int r = 0; r < 16; ++r) { const int key = kbase + 32 * j + 16 * (r >> 3) + 8 * hi + (r & 7);
                bool ok = key <= qpos; if (MASK == 2) ok = ok && (key > qpos - 128);
                p[j][r] = ok ? p[j][r] : -INFINITY; }
    }
    float mx = fmaxf(p[0][0], p[1][0]);
#pragma unroll
    for (int r = 1; r < 16; ++r) mx = fmaxf(mx, fmaxf(p[0][r], p[1][r]));
    mx = pmax(mx);
    if (first || __any(mx > 10.0f)) {
        const float delta = first ? mx : fmaxf(mx, 0.f);
#pragma unroll
        for (int j = 0; j < 2; ++j)
#pragma unroll
            for (int r = 0; r < 16; ++r) { p[j][r] -= delta; cin[j][r] -= delta; }
        mtot += delta;
        if (!first) { const float alpha = __builtin_amdgcn_exp2f(-delta); l *= alpha;
#pragma unroll
            for (int db = 0; db < NDB; ++db)
#pragma unroll
                for (int r = 0; r < 16; ++r) o[db][r] *= alpha; }
    }
    float s = 0.f;
#pragma unroll
    for (int j = 0; j < 2; ++j)
#pragma unroll
        for (int r = 0; r < 16; ++r) { p[j][r] = __builtin_amdgcn_exp2f(p[j][r]); s += p[j][r]; }
    l += s;
#pragma unroll
    for (int st = 0; st < 4; ++st) { const int j = st >> 1, a = st & 1;
        u32x4 pw; pw.x = pk2(p[j][8 * a + 0], p[j][8 * a + 1]); pw.y = pk2(p[j][8 * a + 2], p[j][8 * a + 3]); pw.z = pk2(p[j][8 * a + 4], p[j][8 * a + 5]); pw.w = pk2(p[j][8 * a + 6], p[j][8 * a + 7]);
        const bf16x8 pf = __builtin_bit_cast(bf16x8, pw);
#pragma unroll
        for (int db = 0; db < NDB; ++db) { const bf16x8 vf = *(const LAS bf16x8*)(Vs + (32 * db + ql) * VP + 16 * st + 8 * hi);
            o[db] = __builtin_amdgcn_mfma_f32_32x32x16_bf16(vf, pf, o[db], 0, 0, 0); } }
}
template <bool ALIBI>
__device__ __forceinline__ void cin_init(f32x16 (&cin)[2], float slope2, int kbase, int qpos, int hi) {
#pragma unroll
    for (int j = 0; j < 2; ++j)
#pragma unroll
        for (int r = 0; r < 16; ++r) cin[j][r] = ALIBI ? slope2 * (float)(kbase + 32 * j + 16 * (r >> 3) + 8 * hi + (r & 7) - qpos) : 0.f;
}

__device__ __forceinline__ int swz7(int row) { return (row ^ (row >> 3)) & 7; }
template <int MASK>
__device__ __forceinline__ void tile_compute_sw(unsigned slot, int kmat, const unsigned (&krow)[2], const unsigned (&kswz)[2], const unsigned (&vrow)[4], const unsigned (&vswz)[4],
                                                const bf16x8 (&qf)[4], float slope2, f32x16 (&o)[4], float& l, float& mtot, bool first, bool domask, int qpos, int kbase, int lane) {
    const int hi = lane >> 5;
    const float base = slope2 * (float)(kbase - qpos + 8 * hi) - mtot;
    f32x16 p[2];
    bf16x8 kf[2][4];
#pragma unroll
    for (int j = 0; j < 2; ++j)
#pragma unroll
        for (int ds = 0; ds < 4; ++ds) kf[j][ds] = *(const LAS bf16x8*)(unsigned long)(slot + kmat * 8192 + krow[j] + ((unsigned)(32 * ds + 16 * hi) ^ kswz[j]));
    __builtin_amdgcn_sched_barrier(0);
#pragma unroll
    for (int j = 0; j < 2; ++j)
#pragma unroll
        for (int r = 0; r < 16; ++r) p[j][r] = __builtin_fmaf(slope2, (float)(32 * j + 16 * (r >> 3) + (r & 7)), base);
#pragma unroll
    for (int j = 0; j < 2; ++j)
#pragma unroll
        for (int ds = 0; ds < 4; ++ds) p[j] = __builtin_amdgcn_mfma_f32_32x32x16_bf16(kf[j][ds], qf[ds], p[j], 0, 0, 0);
    asm volatile("s_nop 15\n\ts_nop 7" : "+v"(p[0]), "+v"(p[1]));
    bf16x8 vf[4];
#pragma unroll
    for (int db = 0; db < 4; ++db) vf[db] = *(const LAS bf16x8*)(unsigned long)(slot + 16384 + vrow[db] + ((unsigned)(16 * hi) ^ vswz[db]));
    if (MASK != 0 && domask) {
#pragma unroll
        for (int j = 0; j < 2; ++j)
#pragma unroll
            for (int r = 0; r < 16; ++r) { const int key = kbase + 32 * j + 16 * (r >> 3) + 8 * hi + (r & 7); p[j][r] = key <= qpos ? p[j][r] : -INFINITY; }
    }
    float mx = max3f(p[0][0], p[1][0], p[0][1]);
#pragma unroll
    for (int r = 1; r < 15; ++r) mx = max3f(mx, p[1][r], p[0][r + 1]);
    mx = max3f(mx, p[1][15], mx);
    mx = pmax(mx);
    if (first || __any(mx > 10.0f)) {
        const float delta = first ? mx : fmaxf(mx, 0.f);
#pragma unroll
        for (int j = 0; j < 2; ++j)
#pragma unroll
            for (int r = 0; r < 16; ++r) p[j][r] -= delta;
        mtot += delta;
        if (!first) { const float alpha = __builtin_amdgcn_exp2f(-delta); l *= alpha;
#pragma unroll
            for (int db = 0; db < 4; ++db)
#pragma unroll
                for (int r = 0; r < 16; ++r) o[db][r] *= alpha; }
    }
    float s = 0.f;
    u32x4 pw;
#define EXPPACK(st_) do { const int j_ = (st_) >> 1, a_ = (st_) & 1; \
        _Pragma("unroll") for (int r = 0; r < 8; ++r) { p[j_][8 * a_ + r] = __builtin_amdgcn_exp2f(p[j_][8 * a_ + r]); s += p[j_][8 * a_ + r]; } \
        pw.x = pk2(p[j_][8 * a_ + 0], p[j_][8 * a_ + 1]); pw.y = pk2(p[j_][8 * a_ + 2], p[j_][8 * a_ + 3]); pw.z = pk2(p[j_][8 * a_ + 4], p[j_][8 * a_ + 5]); pw.w = pk2(p[j_][8 * a_ + 6], p[j_][8 * a_ + 7]); } while (0)
    EXPPACK(0);
#pragma unroll
    for (int st = 0; st < 4; ++st) {
        const bf16x8 pf = __builtin_bit_cast(bf16x8, pw);
        bf16x8 vn[4];
        if (st < 3) {
#pragma unroll
            for (int db = 0; db < 4; ++db) vn[db] = *(const LAS bf16x8*)(unsigned long)(slot + 16384 + vrow[db] + ((unsigned)(32 * (st + 1) + 16 * hi) ^ vswz[db])); }
        __builtin_amdgcn_sched_barrier(0);
#pragma unroll
        for (int db = 0; db < 4; ++db) o[db] = __builtin_amdgcn_mfma_f32_32x32x16_bf16(vf[db], pf, o[db], 0, 0, 0);
        if (st < 3) { EXPPACK(st + 1);
#pragma unroll
            for (int db = 0; db < 4; ++db) vf[db] = vn[db]; } }
#undef EXPPACK
    l += s;
}
__device__ __forceinline__ void diff_unit(LAS unsigned char* lds, const bf16_t* PROJ, const bf16_t* VT, bf16_t* YD, const float* subg, float lam, const unsigned* kmax2, int b, int h, int i) {
    int tid = threadIdx.x; asm volatile("" : "+v"(tid)); const int lane = tid & 63, wid = __builtin_amdgcn_readfirstlane(tid >> 6), ql = lane & 31, hi = lane >> 5, c = wid >> 2, w4 = wid & 3;
    const int qw0 = 128 * i + 32 * w4, qpos = qw0 + ql;
    const size_t rowbase = (size_t)b * SEQ;
    constexpr unsigned SLOT = 32768;
    const unsigned lds0 = (unsigned)(unsigned long)lds;
    LAS unsigned* flags = (LAS unsigned*)(lds + LDS_FLAG_OFF);
    if (lane == 0) { flags[wid] = 0u; flags[8 + wid] = 0u; }
    bool wdone = false;
    const int R = 8 * wid + (lane >> 3), cp = lane & 7;
    const unsigned voffK = (unsigned)(R * NPROJ + 8 * (cp ^ swz7(R))) * 2u;
    const unsigned voffV0 = (unsigned)(R * T + 8 * (cp ^ swz7(R))) * 2u, voffV1 = (unsigned)((R + 64) * T + 8 * (cp ^ swz7(R + 64))) * 2u;
    const char* Kbase = (const char*)(PROJ + rowbase * NPROJ + PC_KD + h * 128);
    const char* Vbase = (const char*)(VT + (size_t)(256 + h * 128) * T + rowbase);
    const unsigned pdst = lds0 + (unsigned)wid * 1024u;
#define DIFF_DMA(t, so) do { const char* kb_ = Kbase + (size_t)(t) * (64 * NPROJ * 2); const char* vb_ = Vbase + (size_t)(t) * 128; \
        pg8::glds16_s(kb_, voffK, pdst + (so)); pg8::glds16_s(kb_ + 128, voffK, pdst + (so) + 8192u); \
        pg8::glds16_s(vb_, voffV0, pdst + (so) + 16384u); pg8::glds16_s(vb_, voffV1, pdst + (so) + 24576u); } while (0)
    unsigned krow[2], kswz[2], vrow[4], vswz[4];
#pragma unroll
    for (int j = 0; j < 2; ++j) { const int row = 32 * j + pi32(ql); krow[j] = (unsigned)row * 128u; kswz[j] = (unsigned)swz7(row) * 16u; }
#pragma unroll
    for (int db = 0; db < 4; ++db) { const int row = 32 * db + ql; vrow[db] = (unsigned)row * 128u; vswz[db] = (unsigned)swz7(row) * 16u; }
    const float slope2 = __builtin_amdgcn_exp2f(-(float)(h + 1)) * LOG2E;
    f32x16 o[4]; float l = 0.f, mtot = 0.f;
#pragma unroll
    for (int db = 0; db < 4; ++db) o[db] = f32x16{};
    const int thi = 2 * i + 1;
    DIFF_DMA(thi, 0u);
    DIFF_DMA(thi - 1, SLOT);
    bf16x8 qf[4];
    { const bf16_t* Qp = PROJ + (rowbase + qpos) * NPROJ + PC_QD + h * 128 + c * 64 + 8 * hi;
#pragma unroll
      for (int ds = 0; ds < 4; ++ds) qf[ds] = *(const bf16x8*)(Qp + 16 * ds); }
    unsigned kmx_bits = __hip_atomic_load(kmax2 + (b * 8 + h) * 2 + c, __ATOMIC_RELAXED, __HIP_MEMORY_SCOPE_AGENT);
    asm volatile("s_waitcnt vmcnt(0)" ::: "memory");
    asm volatile("" : "+v"(qf[0]), "+v"(qf[1]), "+v"(qf[2]), "+v"(qf[3]), "+v"(kmx_bits));
    const float kmx = sqrtf(__uint_as_float(kmx_bits)) * 1.001f;
    float qk_bound;
    { float s2 = 0.f;
#pragma unroll
      for (int ds = 0; ds < 4; ++ds) { const u32x4 w = __builtin_bit_cast(u32x4, qf[ds]);
#pragma unroll
          for (int e = 0; e < 4; ++e) { const float a = bf_lo(w[e]), b2 = bf_hi(w[e]); s2 += a * a + b2 * b2; } }
      qk_bound = sqrtf(psum(s2)) * 1.001f * kmx; }
    unsigned so = 0u; bool first = true;
    if (wid >= 4) __builtin_amdgcn_s_setprio(1);
    for (int t = thi; t >= 0; --t) {
        if (t >= 1) asm volatile("s_waitcnt vmcnt(4) lgkmcnt(0)\n\ts_barrier" ::: "memory"); else asm volatile("s_waitcnt vmcnt(0) lgkmcnt(0)\n\ts_barrier" ::: "memory");
        { const LAS unsigned* fs = flags + ((t + 1) & 1) * 8; const u32x4 f0 = *(const LAS u32x4*)fs, f1 = *(const LAS u32x4*)(fs + 4);
          if ((f0.x & f0.y & f0.z & f0.w & f1.x & f1.y & f1.z & f1.w) != 0u) break; }
        if (t >= 2) { const unsigned sn = so >= SLOT ? so - SLOT : so + 2 * SLOT; DIFF_DMA(t - 2, sn); }
        const int kbase = 64 * t;
        if (kbase <= qw0 + 31 && !wdone) {
            tile_compute_sw<1>(lds0 + so, c, krow, kswz, vrow, vswz, qf, slope2, o, l, mtot, first, kbase + 63 > qw0, qpos, kbase, lane);
            first = false;
            const float emax = qk_bound - slope2 * (float)(qpos - kbase + 1) - mtot;
            if (__all(emax < -127.0f)) wdone = true;
        }
        if (lane == 0) flags[(t & 1) * 8 + wid] = wdone ? 1u : 0u;
        so = so >= 2 * SLOT ? 0u : so + SLOT;
    }
    asm volatile("s_waitcnt vmcnt(0)" ::: "memory");
#undef DIFF_DMA
    __builtin_amdgcn_s_setprio(0);
    const float inv = 1.0f / psum(l);
    __syncthreads();
    LAS float* X = (LAS float*)lds + w4 * 4096;
    if (c == 1) {
#pragma unroll
        for (int db = 0; db < 4; ++db)
#pragma unroll
            for (int r = 0; r < 16; ++r) X[(db * 16 + r) * 64 + lane] = o[db][r] * inv;
    }
    __syncthreads();
    if (c == 0) {
        float ss = 0.f;
#pragma unroll
        for (int db = 0; db < 4; ++db)
#pragma unroll
            for (int r = 0; r < 16; ++r) { const float d = o[db][r] * inv - lam * X[(db * 16 + r) * 64 + lane]; o[db][r] = d; ss += d * d; }
        ss = psum(ss);
        const float rstd = 0.8f / sqrtf(ss * (1.0f / 128.0f) + RMS_EPS);
        bf16_t* yp = YD + (rowbase + qpos) * 1024 + h * 128 + 4 * hi;
#pragma unroll
        for (int db = 0; db < 4; ++db)
#pragma unroll
            for (int g4 = 0; g4 < 4; ++g4) { const f32x4 g = *(const f32x4*)(subg + 32 * db + 8 * g4 + 4 * hi);
                u32x2 w; w.x = pk2(o[db][4 * g4] * rstd * g[0], o[db][4 * g4 + 1] * rstd * g[1]); w.y = pk2(o[db][4 * g4 + 2] * rstd * g[2], o[db][4 * g4 + 3] * rstd * g[3]);
                *(u32x2*)(yp + 32 * db + 8 * g4) = w; }
    }
    __syncthreads();
}

__device__ __forceinline__ void swa_unit(LAS unsigned char* lds, const bf16_t* PROJ, const bf16_t* VT, bf16_t* YA, const float* sinks, int b, int hk, int i) {
    int tid = threadIdx.x; asm volatile("" : "+v"(tid)); const int lane = tid & 63, wid = __builtin_amdgcn_readfirstlane(tid >> 6), ql = lane & 31, hi = lane >> 5;
    const int hq = hk * 4 + (wid >> 1), qw0 = 64 * i + 32 * (wid & 1), qpos = qw0 + ql;
    const size_t rowbase = (size_t)b * SEQ;
    constexpr int BUF = 18432, VOFF = 9216;
    bf16x8 qf[4];
    { const bf16_t* Qp = PROJ + (rowbase + qpos) * NPROJ + PC_QA + hq * 64 + 8 * hi;
#pragma unroll
      for (int ds = 0; ds < 4; ++ds) qf[ds] = *(const bf16x8*)(Qp + 16 * ds); }
    const int krow = tid >> 3, kch = tid & 7;
    const bf16_t* Kg = PROJ + (rowbase + krow) * NPROJ + PC_KA + hk * 64 + kch * 8;
    const bf16_t* Vg = VT + (size_t)(hk * 64 + krow) * T + rowbase + kch * 8;
    const int sdst = (krow * 72 + kch * 8) * 2;
    const float slope2 = __builtin_amdgcn_exp2f(-0.5f * (float)(hq + 1)) * LOG2E;
    f32x16 cin[2], o[2]; float l = 0.f, mtot = 0.f;
    o[0] = f32x16{}; o[1] = f32x16{};
    u32x4 sk, sv;
    const int thi = i, tlo = i >= 2 ? i - 2 : 0;
    sk = *(const u32x4*)(Kg + (size_t)thi * 64 * NPROJ); sv = *(const u32x4*)(Vg + thi * 64);
    int bo = 0; bool first = true;
    for (int t = thi; t >= tlo; --t) {
        *(LAS u32x4*)(lds + bo + sdst) = sk; *(LAS u32x4*)(lds + bo + VOFF + sdst) = sv;
        __syncthreads();
        if (t > tlo) { sk = *(const u32x4*)(Kg + (size_t)(t - 1) * 64 * NPROJ); sv = *(const u32x4*)(Vg + (t - 1) * 64); }
        const int kbase = 64 * t;
        if (first) cin_init<true>(cin, slope2, kbase, qpos, hi);
        tile_compute<64, 64, 2>((const LAS bf16_t*)(lds + bo), (const LAS bf16_t*)(lds + bo + VOFF), qf, cin, o, l, mtot, first, true, qpos, kbase, lane);
        first = false;
        const float step = 64.f * slope2;
#pragma unroll
        for (int j = 0; j < 2; ++j)
#pragma unroll
            for (int r = 0; r < 16; ++r) cin[j][r] -= step;
        bo ^= BUF;
    }
    const float lt = psum(l), sink2 = sinks[hq] * LOG2E, M = fmaxf(mtot, sink2), f = __builtin_amdgcn_exp2f(mtot - M);
    const float sc = f / (lt * f + __builtin_amdgcn_exp2f(sink2 - M));
    bf16_t* yp = YA + (rowbase + qpos) * 1024 + hq * 64 + 4 * hi;
#pragma unroll
    for (int db = 0; db < 2; ++db)
#pragma unroll
        for (int g4 = 0; g4 < 4; ++g4) { u32x2 w; w.x = pk2(o[db][4 * g4] * sc, o[db][4 * g4 + 1] * sc); w.y = pk2(o[db][4 * g4 + 2] * sc, o[db][4 * g4 + 3] * sc);
            *(u32x2*)(yp + 32 * db + 8 * g4) = w; }
    __syncthreads();
}

__device__ __forceinline__ void cross_unit(LAS unsigned char* lds, const bf16_t* QC, const bf16_t* KM, const bf16_t* VMT, bf16_t* OC, int b, int h, int i) {
    int tid = threadIdx.x; asm volatile("" : "+v"(tid)); const int lane = tid & 63, wid = __builtin_amdgcn_readfirstlane(tid >> 6), ql = lane & 31, hi = lane >> 5;
    const int qpos = 256 * i + 32 * wid + ql;
    const size_t rowbase = (size_t)b * SEQ;
    constexpr int BUF = 35840, VOFF = 17408;
    bf16x8 qf[8];
    { const bf16_t* Qp = QC + (rowbase + qpos) * 512 + h * 128 + 8 * hi;
#pragma unroll
      for (int ds = 0; ds < 8; ++ds) qf[ds] = *(const bf16x8*)(Qp + 16 * ds); }
    const int kr0 = tid >> 4, kc0 = tid & 15, vr0 = tid >> 3, vc0 = tid & 7;
    const bf16_t* Kg = KM + (size_t)(b * 256 + kr0) * 512 + h * 128 + kc0 * 8;
    const bf16_t* Vg = VMT + (size_t)(h * 128 + vr0) * 512 + b * 256 + vc0 * 8;
    const int kdst = (kr0 * 136 + kc0 * 8) * 2, vdst = (vr0 * 72 + vc0 * 8) * 2;
    f32x16 cin[2], o[4]; float l = 0.f, mtot = 0.f;
#pragma unroll
    for (int db = 0; db < 4; ++db) o[db] = f32x16{};
    cin_init<false>(cin, 0.f, 0, 0, 0);
    u32x4 sk0, sk1, sv0, sv1;
#define CR_LOAD(t) do { sk0 = *(const u32x4*)(Kg + (size_t)(t) * 64 * 512); sk1 = *(const u32x4*)(Kg + (size_t)((t) * 64 + 32) * 512); \
        sv0 = *(const u32x4*)(Vg + (t) * 64); sv1 = *(const u32x4*)(Vg + (size_t)64 * 512 + (t) * 64); } while (0)
    CR_LOAD(3);
    int bo = 0; bool first = true;
    for (int t = 3; t >= 0; --t) {
        *(LAS u32x4*)(lds + bo + kdst) = sk0; *(LAS u32x4*)(lds + bo + kdst + 32 * 136 * 2) = sk1;
        *(LAS u32x4*)(lds + bo + VOFF + vdst) = sv0; *(LAS u32x4*)(lds + bo + VOFF + vdst + 64 * 72 * 2) = sv1;
        __syncthreads();
        if (t > 0) CR_LOAD(t - 1);
        tile_compute<128, 128, 0>((const LAS bf16_t*)(lds + bo), (const LAS bf16_t*)(lds + bo + VOFF), qf, cin, o, l, mtot, first, false, qpos, 64 * t, lane);
        first = false;
        bo ^= BUF;
    }
#undef CR_LOAD
    const float inv = 1.0f / psum(l);
    bf16_t* yp = OC + (rowbase + qpos) * 512 + h * 128 + 4 * hi;
#pragma unroll
    for (int db = 0; db < 4; ++db)
#pragma unroll
        for (int g4 = 0; g4 < 4; ++g4) { u32x2 w; w.x = pk2(o[db][4 * g4] * inv, o[db][4 * g4 + 1] * inv); w.y = pk2(o[db][4 * g4 + 2] * inv, o[db][4 * g4 + 3] * inv);
            *(u32x2*)(yp + 32 * db + 8 * g4) = w; }
    __syncthreads();
}
}

constexpr int NPHASES = 14;
struct Args { const float* in[25]; float* out; unsigned char* ws; int ph_lo, ph_hi; };

__global__ void __launch_bounds__(NTHR, 2) mk_fwd(Args args) {
    extern __shared__ __attribute__((aligned(16))) unsigned char lds_raw[];
    Frame F;
    F.lds = (LAS unsigned char*)lds_raw;
    F.wave = __builtin_amdgcn_readfirstlane(threadIdx.x >> 6);
    F.G = gridDim.x; { const int bx = blockIdx.x; F.vcu = (F.G % 8 == 0) ? (bx % 8) * (F.G / 8) + bx / 8 : bx; }
    F.ws = args.ws; F.ctl = (unsigned*)(args.ws + WS_CTL); F.out = args.out;
#pragma unroll
    for (int i = 0; i < 25; ++i) F.in[i] = args.in[i];
    volatile LAS unsigned* MISC = (volatile LAS unsigned*)(F.lds + LDS_MISC_OFF);
    if (threadIdx.x < 64) MISC[threadIdx.x] = 0u;
    __syncthreads();
    XcdBarrier bar; bar.bar = F.ctl + CW_BAR; bar.x = 0; bar.st = nullptr;
    const int lo = args.ph_lo, hi = args.ph_hi;
    if (hi - lo > 1) bar = xcd_barrier_post(F.ctl + CW_BAR, MISC + 8);
#define IN(k) (lo <= (k) && (k) < hi)
#define SEAM(k) do { if (IN(k) && IN((k) + 1)) xcd_barrier(bar); } while (0)
    LAS unsigned char* lds = F.lds;
    const int bid = blockIdx.x;
    bf16_t* XN = WSP(bf16_t, WS_XN); bf16_t* PROJ = WSP(bf16_t, WS_PROJ); bf16_t* VT = WSP(bf16_t, WS_VT); bf16_t* YA = WSP(bf16_t, WS_YA); bf16_t* YD = WSP(bf16_t, WS_YD);
    bf16_t* MERGED = WSP(bf16_t, WS_MERGED); bf16_t* H = WSP(bf16_t, WS_H); bf16_t* MEMN = WSP(bf16_t, WS_MEMN); bf16_t* KM = WSP(bf16_t, WS_KM); bf16_t* VMT = WSP(bf16_t, WS_VMT);
    bf16_t* QC = WSP(bf16_t, WS_QC); bf16_t* OC = WSP(bf16_t, WS_OC);

    if (IN(0)) { p0_prologue(F); }
    SEAM(0);
    if (IN(1)) {
        const pg8::Gemm g{DM, (size_t)128 * DM * 2};
        pg8::ProjOrder S{XN, WSP(bf16_t, WS_WIN), MEMN, WSP(bf16_t, WS_WCKV), F.G, bid}; pg8::EpiProjAll E{PROJ, VT, KM, VMT};
        pg8::gemm_phase<pg8::EpiProjAll, pg8::ProjOrder, true, true>(lds, g, S, E);
        { const pg8::Gemm g8{DM / 2, (size_t)128 * DM};
          pg8::StaticOrder S8; S8.init(WSP(bf16_t, WS_XN8), WSP(bf16_t, WS_WING8), T, 4096, DM / 2, F.G, bid); pg8::EpiGate E8{WSP(unsigned char, WS_G8)};
          pg8::gemm_phase<pg8::EpiGate, pg8::StaticOrder, true, true, true>(lds, g8, S8, E8); }
    }
    if (IN(1) && IN(2)) conv_filler<8>(F, 1);
    SEAM(1);
    if (IN(2)) {
        { int l_ = threadIdx.x; asm volatile("" : "+v"(l_)); l_ &= 63; float mx0 = 0.f, mx1 = 0.f;
          const int rs = F.G * NWAVES;
          for (int r = F.vcu * NWAVES + F.wave; r < T; r += 4 * rs) {
              u32x4 w0[4], w1[4];
#pragma unroll
              for (int q = 0; q < 4; ++q) { const int rq = r + q * rs; const u32x4* kp = (const u32x4*)(PROJ + (size_t)(rq < T ? rq : r) * NPROJ + PC_KD + 16 * l_); w0[q] = kp[0]; w1[q] = kp[1]; }
#pragma unroll
              for (int q = 0; q < 4; ++q) { const int rq = r + q * rs; float s2 = 0.f;
#pragma unroll
                  for (int e = 0; e < 4; ++e) { const float a0 = bf_lo(w0[q][e]), a1 = bf_hi(w0[q][e]), a2 = bf_lo(w1[q][e]), a3 = bf_hi(w1[q][e]); s2 += (a0 * a0 + a1 * a1) + (a2 * a2 + a3 * a3); }
                  s2 += __shfl_xor(s2, 1); s2 += __shfl_xor(s2, 2);
                  if (rq < T) { if (rq < SEQ) mx0 = fmaxf(mx0, s2); else mx1 = fmaxf(mx1, s2); } } }
          if ((l_ & 3) == 0) { atomicMax(F.ctl + CW_KMAX + (l_ >> 2), __float_as_uint(mx0)); atomicMax(F.ctl + CW_KMAX + 16 + (l_ >> 2), __float_as_uint(mx1)); } }
        asm volatile("s_waitcnt vmcnt(0)" ::: "memory");
        __syncthreads();
        if (threadIdx.x == 0) __hip_atomic_fetch_add(F.ctl + CW_KDONE, 1u, __ATOMIC_RELAXED, __HIP_MEMORY_SCOPE_AGENT);
        for (int n = F.vcu; n < 1024; n += F.G) { const int i = n & 127, bhk = n >> 7; att::swa_unit(lds, PROJ, VT, YA, F.in[4], bhk >> 2, bhk & 3, i); }
        if (threadIdx.x == 0) { while (__hip_atomic_load(F.ctl + CW_KDONE, __ATOMIC_RELAXED, __HIP_MEMORY_SCOPE_AGENT) < (unsigned)F.G) __builtin_amdgcn_s_sleep(4); }
        __syncthreads();
        float lam;
        { int l_ = threadIdx.x; asm volatile("" : "+v"(l_)); l_ &= 63; const float a = F.in[5][l_] * F.in[6][l_], b2 = F.in[7][l_] * F.in[8][l_];
          lam = __expf(wave_sum(a)) - __expf(wave_sum(b2)) + 0.2f; }
        { LAS int* qs = (LAS int*)(lds + LDS_FLAG_OFF + 128); LAS int* cost = qs + 32; LAS int* order = cost + 128;
          const int nq = (F.G % 8 == 0 && F.G >= 8) ? 8 : 1, x0 = (nq == 8) ? F.vcu / (F.G / 8) : 0, per = 1024 / nq;
          for (int qi = 0; qi < 1; ++qi) {
              const int x = (x0 + qi) % nq;
              __syncthreads();
              for (int u = threadIdx.x; u < per && nq == 8; u += NTHR) {
                  const int bh = (x >> 2) * 8 + ((u >> 6) ? 7 - (x & 3) : (x & 3)), i = u & 63;
                  const float s2 = __builtin_amdgcn_exp2f(-(float)((bh & 7) + 1)) * LOG2E; const int cut = (int)(146.0f / (s2 * 64.0f)) + 3;
                  const int c0 = 2 * i + 2; cost[u] = c0 < cut ? c0 : cut; }
              __syncthreads();
              if (nq == 8 && threadIdx.x < 128) { const int me = cost[threadIdx.x]; int r = 0; for (int u = 0; u < 128; ++u) { const int cu = cost[u]; r += (cu > me || (cu == me && u < (int)threadIdx.x)) ? 1 : 0; } order[r] = threadIdx.x; }
              int nxt = 0;
              if (threadIdx.x == 0) qs[0] = (int)atomicAdd(F.ctl + CW_QHEAD + 64 * x, 1u);
              __syncthreads();
              int n = qs[0];
              while (n < per) {
                  if (threadIdx.x == 0) nxt = (int)atomicAdd(F.ctl + CW_QHEAD + 64 * x, 1u);
                  int bh, i;
                  if (nq == 8) { const int u = order[n]; bh = (x >> 2) * 8 + ((u >> 6) ? 7 - (x & 3) : (x & 3)); i = u & 63; } else { bh = n & 15; i = 63 - (n >> 4); }
                  att::diff_unit(lds, PROJ, VT, YD, F.in[9], lam, F.ctl + CW_KMAX, bh >> 3, bh & 7, i);
                  if (threadIdx.x == 0) qs[0] = nxt;
                  __syncthreads();
                  n = qs[0];
              }
          } }
    }
    if (IN(2) && IN(3)) conv_filler<4>(F, 2);
    SEAM(2);
    if (IN(3)) {
        const pg8::Gemm g{1024, (size_t)128 * 1024 * 2};
        pg8::BranchOrder S{YA, YD, WSP(bf16_t, WS_WB), F.G, bid}; pg8::EpiBranchAll E{WSP(unsigned char, WS_G8), MERGED, WSP(unsigned char, WS_M8)};
        pg8::gemm_phase<pg8::EpiBranchAll, pg8::BranchOrder, true, true>(lds, g, S, E);
    }
    SEAM(3);
    if (IN(4)) {
        const pg8::Gemm g{DM / 2, (size_t)128 * DM};
        pg8::StaticOrder S; S.init(WSP(bf16_t, WS_M8), WSP(bf16_t, WS_WO), T, DM, DM / 2, F.G, bid); pg8::EpiResid<false> E{F.in[0], H, 1.0f / 512.0f, (unsigned long long*)(F.ws + WS_CTL + CTL_SS_OFF)};
        pg8::gemm_phase<pg8::EpiResid<false>, pg8::StaticOrder, true, true, true>(lds, g, S, E);
    }
    SEAM(4);
    if (IN(6)) {
        const pg8::Gemm g{DM, (size_t)128 * DM * 2};
        pg8::StaticOrder S; S.init(H, WSP(bf16_t, WS_WCQ), T, 512, DM, F.G, bid); pg8::EpiRowScale E{QC, 512, C2_128, (const unsigned long long*)(F.ws + WS_CTL + CTL_SS_OFF)};
        pg8::gemm_phase<pg8::EpiRowScale, pg8::StaticOrder, true, true>(lds, g, S, E);
    }
    if (IN(6) && IN(7)) conv_filler<8>(F, 6);
    SEAM(6);
    if (IN(7)) {
        for (int n = F.vcu; n < 256; n += F.G) att::cross_unit(lds, QC, KM, VMT, OC, n >> 7, (n >> 5) & 3, n & 31);
    }
    SEAM(7);
    if (IN(8)) {
        const pg8::Gemm g{512, (size_t)128 * 512 * 2};
        pg8::StaticOrder S; S.init(OC, WSP(bf16_t, WS_WCO), T, DM, 512, F.G, bid); pg8::EpiResid<true> E{H, H, 1.0f, nullptr};
        pg8::gemm_phase<pg8::EpiResid<true>, pg8::StaticOrder, true, true>(lds, g, S, E);
    }
    SEAM(8);
    if (IN(9)) { route_r1(F); }
    SEAM(9);
    if (IN(10)) { route_r2(F); conv_filler<16>(F, -1); }
    SEAM(10);
    if (IN(11)) {
        const int ntiles = moe_tile_table(F);
        const pg8::Gemm g{DM / 2, (size_t)DFF * DM};
        pg8::MoeOrder<true> S{WSP(void, WS_XN), WSP(void, WS_WGU), (const LAS int*)(F.lds + LDS_TAB_OFF), ntiles, 16, F.G, F.vcu, (size_t)256 * DM, (size_t)2 * DFF * DM, (size_t)128 * DM, WSP(unsigned short, WS_ROWTOK)};
        pg8::EpiGlu E{F.in[21], WSP(unsigned char, WS_ACT)};
        pg8::gemm_phase<pg8::EpiGlu, pg8::MoeOrder<true>, true, true, true>(lds, g, S, E);
    }
    SEAM(11);
    if (IN(12)) {
        const int ntiles = moe_tile_table(F);
        const pg8::Gemm g{DFF / 2, (size_t)128 * DFF};
        pg8::MoeOrder<false> S{WSP(void, WS_ACT), WSP(void, WS_WD), (const LAS int*)(F.lds + LDS_TAB_OFF), ntiles, 8, F.G, F.vcu, (size_t)256 * DFF, (size_t)DM * DFF, (size_t)256 * DFF, nullptr};
        pg8::EpiDown E{F.in[23], WSP(int, WS_ROWSLOT), WSP(float, WS_ROWW), WSP(unsigned char, WS_MOEOUT)};
        pg8::gemm_phase<pg8::EpiDown, pg8::MoeOrder<false>, true, true, true>(lds, g, S, E);
    }
    SEAM(12);
    if (IN(13)) { final_phase(F); }
#undef IN
#undef SEAM
}

extern "C" void kernel_launch(void* const* d_in, const int* in_sizes, int n_in, void* d_out, int out_size, void* d_ws, size_t ws_size, hipStream_t stream) {
    static int grid = 0;
    if (grid == 0) {
        if (n_in != 25 || out_size != T * DM || ws_size < WS_END) { fprintf(stderr, "kernel_launch: unexpected shapes (n_in %d out %d ws %zu need %zu)\n", n_in, out_size, ws_size, (size_t)WS_END); grid = -1; return; }
        int dev = 0, cus = 0, per_cu = 0;
        if (hipGetDevice(&dev) != hipSuccess || hipDeviceGetAttribute(&cus, hipDeviceAttributeMultiprocessorCount, dev) != hipSuccess) { grid = -1; return; }
        if (hipFuncSetAttribute((const void*)mk_fwd, hipFuncAttributeMaxDynamicSharedMemorySize, LDS_BYTES) != hipSuccess) { fprintf(stderr, "kernel_launch: hipFuncSetAttribute failed\n"); grid = -1; return; }
        if (hipOccupancyMaxActiveBlocksPerMultiprocessor(&per_cu, (const void*)mk_fwd, NTHR, LDS_BYTES) != hipSuccess || per_cu < 1) { fprintf(stderr, "kernel_launch: occupancy query says %d\n", per_cu); (void)hipGetLastError(); }
        grid = cus;
    }
    if (grid < 0) return;
    (void)hipMemsetAsync((char*)d_ws + WS_CTL, 0, CTL_ZERO_BYTES, stream);
    Args a{};
    for (int i = 0; i < 25; ++i) a.in[i] = (const float*)d_in[i];
    a.out = (float*)d_out; a.ws = (unsigned char*)d_ws;
    a.ph_lo = 0; a.ph_hi = NPHASES;
    hipLaunchKernelGGL(mk_fwd, dim3(grid), dim3(NTHR), LDS_BYTES, stream, a);
}
```
